# Optimizing an MI355X kernel written in HIP

```python
import math
import jax, jax.numpy as jnp
from jax import lax
import numpy as np

D_MODEL = 2048
BATCH = 4
SEQ = 2048
DEPTH = 4

N_MIXERS = 4
MIX_WIDTH = D_MODEL
GROUP_W = MIX_WIDTH // N_MIXERS
S5_CH_PER_GROUP = 16
S5_GROUPS = GROUP_W // S5_CH_PER_GROUP
S5_STATE = 64
S5_DT_MIN = 0.001
S5_DT_MAX = 0.1
POOL_WINDOWS = (2, 4, 8, 16)
POOL_CH = GROUP_W // len(POOL_WINDOWS)
CONV_WIDTH = 31
ATT_HEADS = 8
ATT_HEAD_DIM = GROUP_W // ATT_HEADS
DILATED_PATTERNS = ((128, 1), (512, 4), (2048, 16))
ATT_BLOCK = 128
REL_BUCKETS = 32
REL_MAX_DIST = 2048
MEM_LEN = 256
X_HEADS = 4
X_HEAD_DIM = 128
X_WIDTH = X_HEADS * X_HEAD_DIM
D_FF = 4 * D_MODEL
NORM_EPS = 1e-6
NEG_INF = -1e30
IN_WIDTH = GROUP_W + GROUP_W + 2 * GROUP_W + 3 * GROUP_W

kernel_name = 'hymba_style_multimixer_trunk'

F32 = jnp.float32


def rmsnorm(x, g):
    xf = x.astype(F32)
    y = xf * lax.rsqrt(jnp.mean(xf * xf, axis=-1, keepdims=True) + NORM_EPS)
    return (y * g.astype(F32)).astype(x.dtype)


def layernorm(x, g, b):
    xf = x.astype(F32)
    xc = xf - jnp.mean(xf, axis=-1, keepdims=True)
    y = xc * lax.rsqrt(jnp.mean(xc * xc, axis=-1, keepdims=True) + NORM_EPS)
    return (y * g.astype(F32) + b.astype(F32)).astype(x.dtype)


def group_rmsnorm(y, g, out_dtype):
    Bsz, L, _ = y.shape
    yf = y.astype(F32).reshape(Bsz, L, N_MIXERS, GROUP_W)
    yf = yf * lax.rsqrt(jnp.mean(yf * yf, axis=-1, keepdims=True) + NORM_EPS)
    return (yf.reshape(Bsz, L, MIX_WIDTH) * g.astype(F32)).astype(out_dtype)


def _cmul(ar, ai, br, bi):
    return ar * br - ai * bi, ar * bi + ai * br


def s5_mixer(u, lam_re, lam_im, log_dt, b_re, b_im, c_re, c_im, d_skip, w_glu):
    Bsz, L, _ = u.shape
    uf = u.astype(F32).reshape(Bsz, L, S5_GROUPS, S5_CH_PER_GROUP)
    lr = lam_re.astype(F32)
    li = lam_im.astype(F32)
    dt = jnp.exp(log_dt.astype(F32))[:, None]
    mag = jnp.exp(lr * dt)
    ab_r, ab_i = mag * jnp.cos(li * dt), mag * jnp.sin(li * dt)
    den = lr * lr + li * li
    nr, ni = ab_r - 1.0, ab_i
    f_r = (nr * lr + ni * li) / den
    f_i = (ni * lr - nr * li) / den
    bb_r, bb_i = _cmul(f_r[..., None], f_i[..., None], b_re.astype(F32), b_im.astype(F32))
    bu_r = jnp.einsum('gnc,blgc->blgn', bb_r, uf)
    bu_i = jnp.einsum('gnc,blgc->blgn', bb_i, uf)
    a_r = jnp.broadcast_to(ab_r, bu_r.shape)
    a_i = jnp.broadcast_to(ab_i, bu_i.shape)

    def combine(e1, e2):
        a1r, a1i, b1r, b1i = e1
        a2r, a2i, b2r, b2i = e2
        ar, ai = _cmul(a2r, a2i, a1r, a1i)
        br, bi = _cmul(a2r, a2i, b1r, b1i)
        return ar, ai, br + b2r, bi + b2i

    _, _, xr, xi = lax.associative_scan(combine, (a_r, a_i, bu_r, bu_i), axis=1)
    y = jnp.einsum('gcn,blgn->blgc', c_re.astype(F32), xr) - jnp.einsum('gcn,blgn->blgc', c_im.astype(F32), xi)
    y = y.reshape(Bsz, L, GROUP_W) + d_skip.astype(F32) * uf.reshape(Bsz, L, GROUP_W)
    g = jax.nn.gelu(y)
    out = g * jax.nn.sigmoid(jnp.einsum('blc,cd->bld', g, w_glu.astype(F32)))
    return out.astype(u.dtype)


def pool_mixer(u, pool_w, pool_scale):
    Bsz, L, _ = u.shape
    uf = u.astype(F32).reshape(Bsz, L, len(POOL_WINDOWS), POOL_CH)
    cs = jnp.cumsum(uf, axis=1)
    t = jnp.arange(L)
    pooled = []
    for gi, w in enumerate(POOL_WINDOWS):
        c = cs[:, :, gi]
        shifted = jnp.pad(c, ((0, 0), (w, 0), (0, 0)))[:, :L]
        cnt = jnp.minimum(t + 1, w).astype(F32)[None, :, None]
        pooled.append((c - shifted) / cnt - uf[:, :, gi])
    p = jnp.stack(pooled, axis=2)
    y = jnp.einsum('blgc,gcd->blgd', p, pool_w.astype(F32)).reshape(Bsz, L, GROUP_W)
    return (y * pool_scale.astype(F32)).astype(u.dtype)


def conv_mixer(u, w_dw, b_dw, ln_g, ln_b, w_pw):
    val, gate = jnp.split(u, 2, axis=-1)
    h = val * jax.nn.sigmoid(gate)
    h = lax.conv_general_dilated(h, w_dw[:, None, :], window_strides=(1,),
                                 padding=((CONV_WIDTH - 1, 0),),
                                 dimension_numbers=('NWC', 'WIO', 'NWC'),
                                 feature_group_count=GROUP_W) + b_dw
    h = jax.nn.silu(layernorm(h, ln_g, ln_b))
    return jnp.einsum('blc,cd->bld', h, w_pw)


def _t5_bucket(dist):
    n = np.maximum(dist, 0)
    max_exact = REL_BUCKETS // 2
    large = max_exact + (np.log(np.maximum(n, 1) / max_exact) / np.log(REL_MAX_DIST / max_exact)
                         * (REL_BUCKETS - max_exact)).astype(np.int64)
    large = np.minimum(large, REL_BUCKETS - 1)
    return np.where(n < max_exact, n, large).astype(np.int32)


def _dilated_branch(q, k, v, rel_bias, window, dilation):
    Bsz, L, H, E = q.shape
    Ls = L // dilation
    nb = -(-Ls // ATT_BLOCK)
    pad = nb * ATT_BLOCK - Ls

    def to_sub(t):
        t = t.reshape(Bsz, Ls, dilation, H, E).transpose(0, 2, 3, 1, 4)
        return jnp.pad(t, ((0, 0), (0, 0), (0, 0), (0, pad), (0, 0)))

    def band(t):
        t = jnp.pad(t, ((0, 0), (0, 0), (0, 0), (ATT_BLOCK, 0), (0, 0)))
        t = t.reshape(Bsz, dilation, H, nb + 1, ATT_BLOCK, E)
        return jnp.concatenate([t[:, :, :, :-1], t[:, :, :, 1:]], axis=4)

    qb = to_sub(q).reshape(Bsz, dilation, H, nb, ATT_BLOCK, E)
    kb = band(to_sub(k))
    vb = band(to_sub(v))
    s = jnp.einsum('bdhnqe,bdhnke->bdhnqk', qb, kb, preferred_element_type=F32) * (E ** -0.5)
    a_idx = np.arange(ATT_BLOCK)[:, None]
    b_idx = np.arange(2 * ATT_BLOCK)[None, :]
    sub_dist = a_idx + ATT_BLOCK - b_idx
    key_idx = np.arange(nb)[:, None, None] * ATT_BLOCK - ATT_BLOCK + b_idx[None]
    valid = (sub_dist >= 0) & (sub_dist <= window // dilation) & (key_idx >= 0)
    bucket = _t5_bucket(sub_dist * dilation)
    bias = jnp.transpose(rel_bias[jnp.asarray(bucket)], (2, 0, 1)).astype(F32)
    s = s + bias[None, None, :, None]
    s = jnp.where(jnp.asarray(valid)[None, None, None], s, NEG_INF)
    m = jnp.max(s, axis=-1, keepdims=True)
    p = jnp.exp(s - m)
    den = jnp.sum(p, axis=-1, keepdims=True)
    o = jnp.einsum('bdhnqk,bdhnke->bdhnqe', p, vb.astype(F32)) / den
    lse = (m + jnp.log(den))[..., 0]
    o = o.reshape(Bsz, dilation, H, nb * ATT_BLOCK, E)[:, :, :, :Ls]
    o = o.transpose(0, 3, 1, 2, 4).reshape(Bsz, L, H, E)
    lse = lse.reshape(Bsz, dilation, H, nb * ATT_BLOCK)[:, :, :, :Ls]
    lse = lse.transpose(0, 3, 1, 2).reshape(Bsz, L, H)
    return o, lse


def dilated_attention(qkv, rel_bias):
    Bsz, L, _ = qkv.shape
    q, k, v = [t.reshape(Bsz, L, ATT_HEADS, ATT_HEAD_DIM) for t in jnp.split(qkv, 3, axis=-1)]
    outs, lses = [], []
    for window, dilation in DILATED_PATTERNS:
        o, lse = _dilated_branch(q, k, v, rel_bias, window, dilation)
        outs.append(o)
        lses.append(lse)
    wts = jax.nn.softmax(jnp.stack(lses, axis=0), axis=0)
    o = jnp.einsum('pblh,pblhe->blhe', wts, jnp.stack(outs, axis=0))
    return o.reshape(Bsz, L, GROUP_W).astype(qkv.dtype)


def cross_attention(h, mem_n, w_xq, w_xk, w_xv, w_xo):
    Bsz, L, _ = h.shape
    M = mem_n.shape[1]
    q = jnp.einsum('bld,de->ble', h, w_xq).reshape(Bsz, L, X_HEADS, X_HEAD_DIM)
    k = jnp.einsum('bmd,de->bme', mem_n, w_xk).reshape(Bsz, M, X_HEADS, X_HEAD_DIM)
    v = jnp.einsum('bmd,de->bme', mem_n, w_xv).reshape(Bsz, M, X_HEADS, X_HEAD_DIM)
    s = jnp.einsum('blhe,bmhe->bhlm', q, k, preferred_element_type=F32) * (X_HEAD_DIM ** -0.5)
    p = jax.nn.softmax(s, axis=-1)
    o = jnp.einsum('bhlm,bmhe->blhe', p, v.astype(F32)).reshape(Bsz, L, X_WIDTH).astype(h.dtype)
    return jnp.einsum('ble,ed->bld', o, w_xo)


def setup_inputs(seed: int = 0) -> dict:
    key = jax.random.key(seed)
    ks = iter(jax.random.split(key, 48))

    def nrm(shape, scale):
        return jax.random.normal(next(ks), shape, F32) * scale

    def gain(shape):
        return 1.0 + nrm(shape, 0.02)

    x = nrm((BATCH, SEQ, D_MODEL), 1.0)
    mem = nrm((BATCH, MEM_LEN, D_MODEL), 1.0)
    rel_bias = nrm((REL_BUCKETS, ATT_HEADS), 0.2)
    mem_norm_g = gain((D_MODEL,))
    norm_mix_g = gain((DEPTH, D_MODEL))
    w_in = nrm((DEPTH, D_MODEL, IN_WIDTH), D_MODEL ** -0.5)
    s5_lam_re = -0.5 * jnp.exp(nrm((DEPTH, S5_GROUPS, S5_STATE), 0.02))
    s5_lam_im = math.pi * jnp.arange(S5_STATE, dtype=F32) + nrm((DEPTH, S5_GROUPS, S5_STATE), 0.02)
    s5_log_dt = jax.random.uniform(next(ks), (DEPTH, S5_GROUPS), F32,
                                   math.log(S5_DT_MIN), math.log(S5_DT_MAX))
    s5_b_re = nrm((DEPTH, S5_GROUPS, S5_STATE, S5_CH_PER_GROUP), (2 * S5_CH_PER_GROUP) ** -0.5)
    s5_b_im = nrm((DEPTH, S5_GROUPS, S5_STATE, S5_CH_PER_GROUP), (2 * S5_CH_PER_GROUP) ** -0.5)
    s5_c_re = nrm((DEPTH, S5_GROUPS, S5_CH_PER_GROUP, S5_STATE), 0.5)
    s5_c_im = nrm((DEPTH, S5_GROUPS, S5_CH_PER_GROUP, S5_STATE), 0.5)
    s5_d = nrm((DEPTH, GROUP_W), 1.0)
    s5_w_glu = nrm((DEPTH, GROUP_W, GROUP_W), GROUP_W ** -0.5)
    pool_w = nrm((DEPTH, len(POOL_WINDOWS), POOL_CH, POOL_CH), POOL_CH ** -0.5)
    pool_scale = gain((DEPTH, GROUP_W))
    conv_w_dw = nrm((DEPTH, CONV_WIDTH, GROUP_W), CONV_WIDTH ** -0.5)
    conv_b_dw = nrm((DEPTH, GROUP_W), 0.02)
    conv_ln_g = gain((DEPTH, GROUP_W))
    conv_ln_b = nrm((DEPTH, GROUP_W), 0.02)
    conv_w_pw = nrm((DEPTH, GROUP_W, GROUP_W), GROUP_W ** -0.5)
    grp_norm_g = gain((DEPTH, MIX_WIDTH))
    w_out = nrm((DEPTH, MIX_WIDTH, D_MODEL), MIX_WIDTH ** -0.5)
    norm_x_g = gain((DEPTH, D_MODEL))
    w_xq = nrm((DEPTH, D_MODEL, X_WIDTH), D_MODEL ** -0.5)
    w_xk = nrm((DEPTH, D_MODEL, X_WIDTH), D_MODEL ** -0.5)
    w_xv = nrm((DEPTH, D_MODEL, X_WIDTH), D_MODEL ** -0.5)
    w_xo = nrm((DEPTH, X_WIDTH, D_MODEL), X_WIDTH ** -0.5)
    norm_mlp_g = gain((DEPTH, D_MODEL))
    w_up = nrm((DEPTH, D_MODEL, D_FF), D_MODEL ** -0.5)
    w_down = nrm((DEPTH, D_FF, D_MODEL), D_FF ** -0.5)
    norm_final_g = gain((D_MODEL,))
    return {'x': x, 'mem': mem, 'rel_bias': rel_bias, 'mem_norm_g': mem_norm_g,
            'norm_mix_g': norm_mix_g, 'w_in': w_in,
            's5_lam_re': s5_lam_re, 's5_lam_im': s5_lam_im, 's5_log_dt': s5_log_dt,
            's5_b_re': s5_b_re, 's5_b_im': s5_b_im, 's5_c_re': s5_c_re, 's5_c_im': s5_c_im,
            's5_d': s5_d, 's5_w_glu': s5_w_glu,
            'pool_w': pool_w, 'pool_scale': pool_scale,
            'conv_w_dw': conv_w_dw, 'conv_b_dw': conv_b_dw, 'conv_ln_g': conv_ln_g,
            'conv_ln_b': conv_ln_b, 'conv_w_pw': conv_w_pw,
            'grp_norm_g': grp_norm_g, 'w_out': w_out,
            'norm_x_g': norm_x_g, 'w_xq': w_xq, 'w_xk': w_xk, 'w_xv': w_xv, 'w_xo': w_xo,
            'norm_mlp_g': norm_mlp_g, 'w_up': w_up, 'w_down': w_down,
            'norm_final_g': norm_final_g}


def reference(x, mem, rel_bias, mem_norm_g, norm_mix_g, w_in,
              s5_lam_re, s5_lam_im, s5_log_dt, s5_b_re, s5_b_im, s5_c_re, s5_c_im, s5_d, s5_w_glu,
              pool_w, pool_scale, conv_w_dw, conv_b_dw, conv_ln_g, conv_ln_b, conv_w_pw,
              grp_norm_g, w_out, norm_x_g, w_xq, w_xk, w_xv, w_xo,
              norm_mlp_g, w_up, w_down, norm_final_g):
    mem_n = rmsnorm(mem, mem_norm_g)
    h = x
    for l in range(DEPTH):
        xn = rmsnorm(h, norm_mix_g[l])
        proj = jnp.einsum('bld,dc->blc', xn, w_in[l])
        u_a, u_b, u_c, qkv = jnp.split(proj, [GROUP_W, 2 * GROUP_W, 4 * GROUP_W], axis=-1)
        y_a = s5_mixer(u_a, s5_lam_re[l], s5_lam_im[l], s5_log_dt[l], s5_b_re[l], s5_b_im[l],
                       s5_c_re[l], s5_c_im[l], s5_d[l], s5_w_glu[l])
        y_b = pool_mixer(u_b, pool_w[l], pool_scale[l])
        y_c = conv_mixer(u_c, conv_w_dw[l], conv_b_dw[l], conv_ln_g[l], conv_ln_b[l], conv_w_pw[l])
        y_d = dilated_attention(qkv, rel_bias)
        y = group_rmsnorm(jnp.concatenate([y_a, y_b, y_c, y_d], axis=-1), grp_norm_g[l], h.dtype)
        h = h + jnp.einsum('blc,cd->bld', y, w_out[l])
        h = h + cross_attention(rmsnorm(h, norm_x_g[l]), mem_n, w_xq[l], w_xk[l], w_xv[l], w_xo[l])
        hn = rmsnorm(h, norm_mlp_g[l])
        h = h + jnp.einsum('blf,fd->bld', jnp.square(jax.nn.relu(jnp.einsum('bld,df->blf', hn, w_up[l]))), w_down[l])
    return rmsnorm(h, norm_final_g)
```

```cpp
#include <hip/hip_runtime.h>
#include <hip/hip_cooperative_groups.h>
#include <cstdio>
#include <cstdint>
namespace cg = cooperative_groups;

#ifndef N_LAYERS_RUN
#define N_LAYERS_RUN 4
#endif
#ifndef GEMM_REPS
#define GEMM_REPS 1
#endif
#ifndef MIX_REPS
#define MIX_REPS 1
#endif
#ifndef NORM_REPS
#define NORM_REPS 1
#endif
#ifndef P3_REPS
#define P3_REPS 1
#endif
#ifndef P9_REPS
#define P9_REPS 1
#endif
#ifndef SYNC_REPS
#define SYNC_REPS 1
#endif
#define GSYNC() do { for (int _r = 0; _r < SYNC_REPS; ++_r) xcd_barrier(xbar); } while (0)
#ifndef P0_REPS
#define P0_REPS 1
#endif

typedef unsigned short bf16_t;
typedef short bf16x8 __attribute__((ext_vector_type(8)));
typedef short s16x4 __attribute__((ext_vector_type(4)));
typedef float f32x4 __attribute__((ext_vector_type(4)));
typedef unsigned u32x4 __attribute__((ext_vector_type(4)));
typedef unsigned u32x2 __attribute__((ext_vector_type(2)));

constexpr int T = 8192, D = 2048, SEQ = 2048, INW = 3584, DFF = 8192, DEPTH = 4;
constexpr float EPS = 1e-6f;

constexpr size_t SZ_WIN = (size_t)INW * D * 2, SZ_WOUT = (size_t)D * D * 2, SZ_WXQ = (size_t)512 * D * 2, SZ_WXO = (size_t)D * 512 * 2,
                 SZ_WUP = (size_t)DFF * D * 2, SZ_WDN = (size_t)D * DFF * 2, SZ_WSM = (size_t)1536 * 512 * 2;
constexpr size_t WS_WIN = 0;
constexpr size_t WS_WOUT = WS_WIN + 4 * SZ_WIN;
constexpr size_t WS_WXQ = WS_WOUT + 4 * SZ_WOUT;
constexpr size_t WS_WKV = WS_WXQ + 4 * SZ_WXQ;
constexpr size_t WS_WXO = WS_WKV + (size_t)4096 * D * 2;
constexpr size_t WS_WUP = WS_WXO + 4 * SZ_WXO;
constexpr size_t WS_WDN = WS_WUP + 4 * SZ_WUP;
constexpr size_t WS_WSM = WS_WDN + 4 * SZ_WDN;
constexpr size_t WS_H = WS_WSM + 4 * SZ_WSM;
constexpr size_t WS_XN = WS_H + (size_t)T * D * 4;
constexpr size_t WS_PROJ = WS_XN + (size_t)T * D * 2;
constexpr size_t PJ_UA = 0, PJ_UB = (size_t)T * 512, PJ_UC = (size_t)2 * T * 512, PJ_QKV = (size_t)T * 2048;
constexpr size_t WS_GPH = WS_PROJ + (size_t)T * INW * 2;
constexpr size_t WS_YCAT = WS_GPH + (size_t)3 * T * 512 * 2;
constexpr size_t WS_OB = WS_YCAT + (size_t)T * 1536 * 2;
constexpr size_t WS_LSE = WS_OB + (size_t)3 * T * 512 * 2;
constexpr size_t WS_YN = WS_LSE + (size_t)3 * T * 8 * 4;
constexpr size_t WS_QX = WS_YN + (size_t)T * D * 2;
constexpr size_t WS_OX = WS_QX + (size_t)T * 512 * 2;
constexpr size_t WS_KV = WS_OX + (size_t)T * 512 * 2;
constexpr size_t WS_MEMN = WS_KV + (size_t)1024 * 4096 * 2;
constexpr size_t WS_ACT = WS_MEMN + (size_t)1024 * D * 2;
constexpr size_t WS_CARRY = WS_ACT + (size_t)T * DFF * 2;
constexpr size_t WS_DUMMY = WS_CARRY + (size_t)128 * 32 * 64 * 2 * 4;
constexpr size_t WS_BAR = WS_DUMMY + (size_t)T * D * 4;
constexpr size_t WS_SS = WS_BAR + 16384;
constexpr size_t WS_QP = WS_SS + (size_t)13 * T * 32 * 4;
constexpr size_t WS_SSG = WS_QP + (size_t)4 * T * 512 * 4;
constexpr size_t WS_END = WS_SSG + (size_t)T * 32 * 4;

constexpr int LDS_BYTES = 160 * 1024;

struct Params {
    const float* in[33];
    float* out;
    unsigned char* ws;
};

typedef const __attribute__((address_space(4))) Params* PP;
__device__ __forceinline__ PP get_pp() { PP q = (PP)__builtin_amdgcn_kernarg_segment_ptr(); asm volatile("" : "+s"(q)); return q; }
__device__ __forceinline__ int tid_fresh() { int t = threadIdx.x; asm volatile("" : "+v"(t)); return t; }
__device__ __forceinline__ int bid_fresh() { int t = blockIdx.x; asm volatile("" : "+s"(t)); return t; }
__device__ __forceinline__ float bf2f(bf16_t v) { return __uint_as_float(((unsigned)v) << 16); }
__device__ __forceinline__ bf16_t f2bf(float f) { unsigned u = __float_as_uint(f); u += 0x7FFFu + ((u >> 16) & 1u); return (bf16_t)(u >> 16); }
typedef __bf16 hbf16x2 __attribute__((ext_vector_type(2)));
typedef float hf32x2 __attribute__((ext_vector_type(2)));
__device__ __forceinline__ unsigned pk2(float lo, float hi) { const hf32x2 v = {lo, hi}; return __builtin_bit_cast(unsigned, __builtin_convertvector(v, hbf16x2)); }
__device__ __forceinline__ float wave_sum(float v) {
#pragma unroll
    for (int o = 1; o < 64; o <<= 1) v += __shfl_xor(v, o);
    return v;
}
__device__ __forceinline__ float sigmoidf_(float x) { return 1.0f / (1.0f + __expf(-x)); }


#define XB_TMO      128
#define XB_XCNT(j)  (256  + 64 * (j))
#define XB_XSUB(j)  (1280 + 64 * (j))
#define XB_XGEN(j)  (2304 + 64 * (j))
#define XB_TOP      3328
#define XB_TOPGEN   3392
#define XCD_BAR_WORDS 3456
#define XB_SPIN_CAP (1u << 20)
#define LAS __attribute__((address_space(3)))
__device__ __forceinline__ unsigned xb_ld(unsigned* p)              { return __hip_atomic_load(p, __ATOMIC_RELAXED, __HIP_MEMORY_SCOPE_AGENT); }
__device__ __forceinline__ unsigned xb_add(unsigned* p, unsigned v) { return __hip_atomic_fetch_add(p, v, __ATOMIC_RELAXED, __HIP_MEMORY_SCOPE_AGENT); }
__device__ __forceinline__ unsigned xb_xcc_id() { return (unsigned)__builtin_amdgcn_s_getreg((3 << 11) | 20) & 0xFu; }
#define XB_SPIN(cond, bar) do { unsigned _sp = 0; while (cond) { __builtin_amdgcn_s_sleep(1); \
    if ((++_sp & 255u) == 0u) { if (xb_ld(&(bar)[XB_TMO])) break; if (_sp > XB_SPIN_CAP) { atomicAdd(&(bar)[XB_TMO], 1u); break; } } } } while (0)
struct XcdBarrier { unsigned* bar; unsigned x; volatile LAS unsigned* st; };
__device__ __forceinline__ XcdBarrier xcd_barrier_post(unsigned* bar, volatile LAS unsigned* st) {
    XcdBarrier b; b.bar = bar; b.x = xb_xcc_id(); b.st = st;
    if (threadIdx.x == 0) (void)xb_add(&bar[XB_XCNT(b.x)], 1u);
    return b;
}
__device__ __forceinline__ void xcd_barrier_complete(unsigned* bar, unsigned x, unsigned& nloc, unsigned& nx) {
    const unsigned G = gridDim.x * gridDim.y * gridDim.z;
    unsigned sum, cnt, mine, sp = 0u;
    for (;;) {
        sum = 0u; cnt = 0u; mine = 0u;
#pragma unroll
        for (unsigned j = 0; j < 16; ++j) { const unsigned c = xb_ld(&bar[XB_XCNT(j)]); sum += c; cnt += (c > 0u) ? 1u : 0u; mine = (j == x) ? c : mine; }
        if (sum == G) break;
        __builtin_amdgcn_s_sleep(1);
        if ((++sp & 255u) == 0u) { if (xb_ld(&bar[XB_TMO])) break; if (sp > XB_SPIN_CAP) { atomicAdd(&bar[XB_TMO], 1u); break; } }
    }
    nloc = mine > 0u ? mine : 1u; nx = cnt > 0u ? cnt : 1u;
}
__device__ __forceinline__ void xcd_barrier(const XcdBarrier& b) {
    asm volatile("s_waitcnt vmcnt(0)" ::: "memory");
    __syncthreads();
    if (threadIdx.x == 0) {
        unsigned* bar = b.bar;
        __builtin_amdgcn_s_waitcnt(0);
        unsigned nloc = b.st[0], nx = b.st[1];
        if (nloc == 0u) { xcd_barrier_complete(bar, b.x, nloc, nx); b.st[0] = nloc; b.st[1] = nx; }
        const unsigned old = xb_add(&bar[XB_XSUB(b.x)], 1u);
        const unsigned gen = old / nloc;
        if (old + 1u == (gen + 1u) * nloc) {
            __builtin_amdgcn_fence(__ATOMIC_RELEASE, "agent");
            asm volatile("s_waitcnt vmcnt(0)" ::: "memory");
            const unsigned og = xb_add(&bar[XB_TOP], 1u);
            const unsigned tg = og / nx;
            if (og + 1u == (tg + 1u) * nx) xb_add(&bar[XB_TOPGEN], 1u);
            else XB_SPIN(xb_ld(&bar[XB_TOPGEN]) == tg, bar);
            __builtin_amdgcn_fence(__ATOMIC_ACQUIRE, "agent");
            xb_add(&bar[XB_XGEN(b.x)], 1u);
            asm volatile("s_waitcnt vmcnt(0)" ::: "memory");
        } else {
            XB_SPIN(xb_ld(&bar[XB_XGEN(b.x)]) == gen, bar);
            __builtin_amdgcn_fence(__ATOMIC_ACQUIRE, "agent");
            asm volatile("s_waitcnt vmcnt(0)" ::: "memory");
        }
    }
    __syncthreads();
}

namespace pg8 {
#define PG8_LAS __attribute__((address_space(3)))
constexpr int BM = 256, BK = 64, HALF = 128, HTB = HALF * BK * 2, STAGE_BYTES = 8 * HTB, NXCD = 8, WGM = 8;
__host__ __device__ __forceinline__ int lds_byte(int r, int c) { const int st = (r >> 4) * 2 + (c >> 5), rr = r & 15, cc = c & 31, ob = rr * 64 + cc * 2; return st * 1024 + (ob ^ (((ob >> 9) & 1) << 5)); }
__host__ __device__ __forceinline__ void stage_rc(int b, int& R, int& C) { const int st = b / 1024, sb = b % 1024, swz = sb ^ (((sb >> 9) & 1) << 5); R = (st >> 1) * 16 + swz / 64; C = (st & 1) * 32 + (swz % 64) / 2; }
__host__ __device__ __forceinline__ int perm32(int rho) { const int n = rho >> 4, i = rho & 15; return 8 * (i >> 2) + 4 * n + (i & 3); }
struct Unit { int pm, pn; };
struct Gemm { const bf16_t* A; const bf16_t* Bt; int M, N, K; int Kloop; };
struct StaticOrder {
    int nM, nN, nwg, G, c;
    __device__ void init(int M, int N, int G_, int c_) { nM = M / BM; nN = N / BM; nwg = nM * nN; G = G_; c = c_; }
    __device__ bool next(int i, Unit& u) const {
        const long L = (long)i * G + c; if (L >= nwg) return false;
        int wgid = (int)L; { const int q = nwg / NXCD, r = nwg % NXCD, xcd = wgid % NXCD, off = wgid / NXCD; wgid = (xcd < r ? xcd * (q + 1) : r * (q + 1) + (xcd - r) * q) + off; }
        const int nig = WGM * nN, gid = wgid / nig, fm = gid * WGM, gsz = (nM - fm) < WGM ? (nM - fm) : WGM;
        u.pm = fm + ((wgid % nig) % gsz); u.pn = (wgid % nig) / gsz; return true;
    }
    __device__ __forceinline__ size_t a_extra(const Unit&) const { return 0; }
    __device__ __forceinline__ size_t b_extra(const Unit&) const { return 0; }
};
struct SmallOrder {
    int G, c;
    __device__ bool next(int i, Unit& u) const { const int L = i * G + c; if (L >= 192) return false; u.pm = L / 6; u.pn = L % 6; return true; }
    __device__ __forceinline__ size_t a_extra(const Unit& u) const { return (size_t)(u.pn >> 1) * ((size_t)T * 512 * 2); }
    __device__ __forceinline__ size_t b_extra(const Unit&) const { return 0; }
};
struct SplitOrder {
    int G, c;
    __device__ bool next(int i, Unit& u) const { const int L = i * G + c; if (L >= 256) return false; u.pm = L >> 3; u.pn = L & 7; return true; }
    __device__ __forceinline__ size_t a_extra(const Unit& u) const { return (size_t)(u.pn >> 1) * 512 * 2; }
    __device__ __forceinline__ size_t b_extra(const Unit& u) const { return (size_t)(u.pn >> 1) * 512 * 2 - (size_t)(u.pn & ~1) * ((size_t)256 * D * 2); }
};
__device__ __forceinline__ unsigned cvt_pk_bf16(float lo, float hi) { unsigned r; asm volatile("v_cvt_pk_bf16_f32 %0, %1, %2" : "=v"(r) : "v"(lo), "v"(hi)); return r; }

template <int ACT  > struct EpiBf16 {
    static constexpr bool PERM = true;
    bf16_t* O; int ldc; float scale; const float* ss;
    __device__ __forceinline__ void operator()(const f32x4 (&acc)[2][2][4][2], const Unit& u, int wr, int wc, int fr, int fq) const {
        const int row0 = u.pm * BM + wr * 64 + fr, col0 = u.pn * BM + wc * 32 + 8 * fq;
        float rsv[2][4];
        if (ss) {
            f32x4 p0[2][4], p1[2][4];
#pragma unroll
            for (int ai = 0; ai < 2; ++ai)
#pragma unroll
                for (int m = 0; m < 4; ++m) { const float* sp = ss + (size_t)(row0 + ai * HALF + m * 16) * 32 + fq * 8; p0[ai][m] = *(const f32x4*)sp; p1[ai][m] = *(const f32x4*)(sp + 4); }
#pragma unroll
            for (int ai = 0; ai < 2; ++ai)
#pragma unroll
                for (int m = 0; m < 4; ++m) { float t = ((p0[ai][m][0] + p0[ai][m][1]) + (p0[ai][m][2] + p0[ai][m][3])) + ((p1[ai][m][0] + p1[ai][m][1]) + (p1[ai][m][2] + p1[ai][m][3]));
                    t += __shfl_xor(t, 16); t += __shfl_xor(t, 32);
                    rsv[ai][m] = scale / sqrtf(t * (1.0f / D) + EPS); }
        } else {
#pragma unroll
            for (int ai = 0; ai < 2; ++ai)
#pragma unroll
                for (int m = 0; m < 4; ++m) rsv[ai][m] = scale;
        }
#pragma unroll
        for (int ai = 0; ai < 2; ++ai)
#pragma unroll
            for (int m = 0; m < 4; ++m) { const int row = row0 + ai * HALF + m * 16; bf16_t* rowp = O + (size_t)row * ldc + col0;
                const float rs = rsv[ai][m];
#pragma unroll
                for (int bj = 0; bj < 2; ++bj) { f32x4 v0 = acc[ai][bj][m][0] * rs, v1 = acc[ai][bj][m][1] * rs;
                    if (ACT == 1) {
#pragma unroll
                        for (int e = 0; e < 4; ++e) { float a = fmaxf(v0[e], 0.f), b = fmaxf(v1[e], 0.f); v0[e] = a * a; v1[e] = b * b; } }
                    u32x4 o; o.x = cvt_pk_bf16(v0[0], v0[1]); o.y = cvt_pk_bf16(v0[2], v0[3]); o.z = cvt_pk_bf16(v1[0], v1[1]); o.w = cvt_pk_bf16(v1[2], v1[3]);
                    *(u32x4*)(rowp + bj * HALF) = o; } }
    }
};
struct EpiWin {
    static constexpr bool PERM = true;
    bf16_t* P; const float* ss;
    __device__ __forceinline__ void operator()(const f32x4 (&acc)[2][2][4][2], const Unit& u, int wr, int wc, int fr, int fq) const {
        const int row0 = u.pm * BM + wr * 64 + fr;
        float rsv[2][4];
        {
            f32x4 p0[2][4], p1[2][4];
#pragma unroll
            for (int ai = 0; ai < 2; ++ai)
#pragma unroll
                for (int m = 0; m < 4; ++m) { const float* sp = ss + (size_t)(row0 + ai * HALF + m * 16) * 32 + fq * 8; p0[ai][m] = *(const f32x4*)sp; p1[ai][m] = *(const f32x4*)(sp + 4); }
#pragma unroll
            for (int ai = 0; ai < 2; ++ai)
#pragma unroll
                for (int m = 0; m < 4; ++m) { float t = ((p0[ai][m][0] + p0[ai][m][1]) + (p0[ai][m][2] + p0[ai][m][3])) + ((p1[ai][m][0] + p1[ai][m][1]) + (p1[ai][m][2] + p1[ai][m][3]));
                    t += __shfl_xor(t, 16); t += __shfl_xor(t, 32);
                    rsv[ai][m] = 1.0f / sqrtf(t * (1.0f / D) + EPS); }
        }
#pragma unroll
        for (int ai = 0; ai < 2; ++ai)
#pragma unroll
            for (int m = 0; m < 4; ++m) { const int row = row0 + ai * HALF + m * 16; const float rs = rsv[ai][m];
#pragma unroll
                for (int bj = 0; bj < 2; ++bj) { const f32x4 v0 = acc[ai][bj][m][0] * rs, v1 = acc[ai][bj][m][1] * rs;
                    u32x4 o; o.x = cvt_pk_bf16(v0[0], v0[1]); o.y = cvt_pk_bf16(v0[2], v0[3]); o.z = cvt_pk_bf16(v1[0], v1[1]); o.w = cvt_pk_bf16(v1[2], v1[3]);
                    bf16_t* dst;
                    if (u.pn < 4) { const int colg = u.pn * BM + bj * HALF + wc * 32 + 8 * fq; dst = P + (size_t)(colg >> 9) * ((size_t)T * 512) + (size_t)row * 512 + (colg & 511); }
                    else if (u.pn < 8) { const int colc = (u.pn - 4) * BM + bj * HALF + wc * 32 + 8 * fq; dst = P + PJ_UC + (size_t)row * 1024 + colc; }
                    else { const int which = (u.pn - 8) >> 1, hd = ((u.pn - 8) & 1) * 4 + 2 * bj + (wc >> 1), dim = 32 * (wc & 1) + 8 * fq, bb = row >> 11, ll = row & 2047;
                        dst = P + PJ_QKV + ((size_t)(((which * 4 + bb) * 8 + hd) * SEQ + ll)) * 64 + dim; }
                    *(u32x4*)dst = o; } }
    }
};
template <int MB  > struct EpiRes {
    static constexpr bool PERM = false;
    const float* Hin; float* Hout; bf16_t* Hb; float* ss; const float* ssin;
    __device__ __forceinline__ void operator()(const f32x4 (&acc)[2][2][4][2], const Unit& u, int wr, int wc, int fr, int fq) const {
        const int row0 = u.pm * BM + wr * 64 + fr, col0 = u.pn * BM + wc * 32 + 4 * fq;
        float rsc[2][4];
        if (ssin) {
#pragma unroll
            for (int ai = 0; ai < 2; ++ai) {
                f32x4 q0[4], q1[4];
#pragma unroll
                for (int m = 0; m < 4; ++m) { const float* sp = ssin + (size_t)(row0 + ai * HALF + m * 16) * 32 + fq * 8; q0[m] = *(const f32x4*)sp; q1[m] = *(const f32x4*)(sp + 4); }
#pragma unroll
                for (int m = 0; m < 4; ++m) { float t = ((q0[m][0] + q0[m][1]) + (q0[m][2] + q0[m][3])) + ((q1[m][0] + q1[m][1]) + (q1[m][2] + q1[m][3]));
                    t += __shfl_xor(t, 16); t += __shfl_xor(t, 32); rsc[ai][m] = 1.0f / (t * (1.0f / D) + EPS); }
                asm volatile("" ::: "memory");
            }
        } else {
#pragma unroll
            for (int ai = 0; ai < 2; ++ai)
#pragma unroll
                for (int m = 0; m < 4; ++m) rsc[ai][m] = 1.0f;
        }
#pragma unroll
        for (int ai = 0; ai < 2; ++ai)
#pragma unroll
        for (int mh = 0; mh < 4; mh += MB) {
            f32x4 hv[MB][2][2];
#pragma unroll
            for (int m = 0; m < MB; ++m)
#pragma unroll
                for (int bj = 0; bj < 2; ++bj)
#pragma unroll
                    for (int n = 0; n < 2; ++n) hv[m][bj][n] = *(const f32x4*)(Hin + (size_t)(row0 + ai * HALF + (mh + m) * 16) * D + col0 + bj * HALF + n * 16);
#pragma unroll
            for (int m = 0; m < MB; ++m) { const int row = row0 + ai * HALF + (mh + m) * 16; const size_t off = (size_t)row * D + col0; float sq = 0.f;
                const float rs1 = rsc[ai][mh + m];
#pragma unroll
                for (int bj = 0; bj < 2; ++bj)
#pragma unroll
                    for (int n = 0; n < 2; ++n) { const size_t idx = off + bj * HALF + n * 16; const f32x4 o = hv[m][bj][n] + acc[ai][bj][mh + m][n] * rs1;
                        *(f32x4*)(Hout + idx) = o; sq += o[0] * o[0] + o[1] * o[1] + o[2] * o[2] + o[3] * o[3];
                        if (Hb) { u32x2 w; w.x = cvt_pk_bf16(o[0], o[1]); w.y = cvt_pk_bf16(o[2], o[3]); *(u32x2*)(Hb + idx) = w; } }
                if (ss) { sq += __shfl_xor(sq, 16); sq += __shfl_xor(sq, 32); if (fq == 0) ss[(size_t)row * 32 + u.pn * 4 + wc] = sq; } }
        }
    }
    __device__ __forceinline__ void gs(const f32x4 (&acc)[2][2][4][2], const Unit& u, int wr, int wc, int fr, int fq, const PG8_LAS float* rtab) const {
        const int row0 = u.pm * BM + wr * 64 + fr, col0 = u.pn * BM + wc * 32 + 4 * fq;
#pragma unroll
        for (int ai = 0; ai < 2; ++ai)
#pragma unroll
        for (int mh = 0; mh < 4; mh += MB) {
            f32x4 hv[MB][2][2];
#pragma unroll
            for (int m = 0; m < MB; ++m)
#pragma unroll
                for (int bj = 0; bj < 2; ++bj)
#pragma unroll
                    for (int n = 0; n < 2; ++n) hv[m][bj][n] = *(const f32x4*)(Hin + (size_t)(row0 + ai * HALF + (mh + m) * 16) * D + col0 + bj * HALF + n * 16);
#pragma unroll
            for (int m = 0; m < MB; ++m) { const int rl = ai * HALF + wr * 64 + (mh + m) * 16 + fr, row = u.pm * BM + rl; const size_t off = (size_t)row * D + col0; float sq = 0.f;
                const float rs1 = rtab[3 * 256 + rl];
#pragma unroll
                for (int bj = 0; bj < 2; ++bj)
#pragma unroll
                    for (int n = 0; n < 2; ++n) { const size_t idx = off + bj * HALF + n * 16; const f32x4 o = hv[m][bj][n] + acc[ai][bj][mh + m][n] * rs1;
                        *(f32x4*)(Hout + idx) = o; sq += o[0] * o[0] + o[1] * o[1] + o[2] * o[2] + o[3] * o[3];
                        if (Hb) { u32x2 w; w.x = cvt_pk_bf16(o[0], o[1]); w.y = cvt_pk_bf16(o[2], o[3]); *(u32x2*)(Hb + idx) = w; } }
                if (ss) { sq += __shfl_xor(sq, 16); sq += __shfl_xor(sq, 32); if (fq == 0) ss[(size_t)row * 32 + u.pn * 4 + wc] = sq; } }
        }
    }
};
struct EpiPart {
    static constexpr bool PERM = false;
    float* Q;
    __device__ __forceinline__ void operator()(const f32x4 (&acc)[2][2][4][2], const Unit& u, int wr, int wc, int fr, int fq) const {
        const int row0 = u.pm * BM + wr * 64 + fr, col0 = (u.pn & 1) * BM + wc * 32 + 4 * fq;
        float* base = Q + (size_t)(u.pn >> 1) * ((size_t)T * 512);
#pragma unroll
        for (int ai = 0; ai < 2; ++ai)
#pragma unroll
            for (int m = 0; m < 4; ++m) { float* rowp = base + (size_t)(row0 + ai * HALF + m * 16) * 512 + col0;
#pragma unroll
                for (int bj = 0; bj < 2; ++bj)
#pragma unroll
                    for (int n = 0; n < 2; ++n) *(f32x4*)(rowp + bj * HALF + n * 16) = acc[ai][bj][m][n]; }
    }
};
struct EpiSmall {
    static constexpr bool PERM = true;
    bf16_t* Y; const bf16_t* Gm; const float* pscale; float* ssg;
    __device__ __forceinline__ void operator()(const f32x4 (&acc)[2][2][4][2], const Unit& u, int wr, int wc, int fr, int fq) const {
        const int kind = u.pn >> 1;
        const int row0 = u.pm * BM + wr * 64 + fr, colk = (u.pn & 1) * BM + wc * 32 + 8 * fq;
        f32x4 ps[2][2];
        if (kind == 1) {
#pragma unroll
            for (int bj = 0; bj < 2; ++bj) { ps[bj][0] = *(const f32x4*)(pscale + colk + bj * HALF); ps[bj][1] = *(const f32x4*)(pscale + colk + bj * HALF + 4); } }
#pragma unroll
        for (int ai = 0; ai < 2; ++ai) {
            u32x4 gv[4][2];
            if (kind == 0) {
#pragma unroll
                for (int m = 0; m < 4; ++m)
#pragma unroll
                    for (int bj = 0; bj < 2; ++bj) gv[m][bj] = *(const u32x4*)(Gm + (size_t)(row0 + ai * HALF + m * 16) * 512 + colk + bj * HALF); }
#pragma unroll
            for (int m = 0; m < 4; ++m) { const int row = row0 + ai * HALF + m * 16; float sq = 0.f;
#pragma unroll
                for (int bj = 0; bj < 2; ++bj) { f32x4 v0 = acc[ai][bj][m][0], v1 = acc[ai][bj][m][1]; const int c = colk + bj * HALF;
                    if (kind == 0) { const u32x4 g4 = gv[m][bj];
                        float g[8]; g[0] = __uint_as_float(g4.x << 16); g[1] = __uint_as_float(g4.x & 0xffff0000u); g[2] = __uint_as_float(g4.y << 16); g[3] = __uint_as_float(g4.y & 0xffff0000u);
                        g[4] = __uint_as_float(g4.z << 16); g[5] = __uint_as_float(g4.z & 0xffff0000u); g[6] = __uint_as_float(g4.w << 16); g[7] = __uint_as_float(g4.w & 0xffff0000u);
#pragma unroll
                        for (int e = 0; e < 4; ++e) { v0[e] = g[e] * sigmoidf_(v0[e]); v1[e] = g[4 + e] * sigmoidf_(v1[e]); } }
                    else if (kind == 1) { v0 = v0 * ps[bj][0]; v1 = v1 * ps[bj][1]; }
                    sq += (v0[0] * v0[0] + v0[1] * v0[1]) + (v0[2] * v0[2] + v0[3] * v0[3]) + (v1[0] * v1[0] + v1[1] * v1[1]) + (v1[2] * v1[2] + v1[3] * v1[3]);
                    u32x4 o; o.x = cvt_pk_bf16(v0[0], v0[1]); o.y = cvt_pk_bf16(v0[2], v0[3]); o.z = cvt_pk_bf16(v1[0], v1[1]); o.w = cvt_pk_bf16(v1[2], v1[3]);
                    *(u32x4*)(Y + (size_t)row * D + kind * 512 + c) = o; }
                sq += __shfl_xor(sq, 16); sq += __shfl_xor(sq, 32);
                if (fq == 0) ssg[(size_t)row * 32 + kind * 8 + (u.pn & 1) * 4 + wc] = sq; }
        }
    }
};

struct WinKvOrder {
    StaticOrder so; size_t a_delta, b_delta;
    __device__ bool next(int i, Unit& u) const {
        if (so.next(i, u)) return true;
        const int L = i * so.G + so.c - so.nwg; if (L >= 64) return false;
        u.pm = L & 3; u.pn = 14 + (L >> 2); return true;
    }
    __device__ __forceinline__ size_t a_extra(const Unit& u) const { return u.pn >= 14 ? a_delta : 0; }
    __device__ __forceinline__ size_t b_extra(const Unit& u) const { return u.pn >= 14 ? b_delta - (size_t)14 * ((size_t)256 * D * 2) : 0; }
};
struct EpiWinKv {
    static constexpr bool PERM = true;
    EpiWin win; EpiBf16<0> kv;
    __device__ __forceinline__ void operator()(const f32x4 (&acc)[2][2][4][2], const Unit& u, int wr, int wc, int fr, int fq) const {
        if (u.pn >= 14) { Unit v; v.pm = u.pm; v.pn = u.pn - 14; kv(acc, v, wr, wc, fr, fq); } else win(acc, u, wr, wc, fr, fq);
    }
};
template <class Epi, class Sched, bool ALIGN_EPI = true, bool SP2 = true, bool GS = false>
__device__ __forceinline__ void gemm_phase(PG8_LAS unsigned char* lds, const Gemm g, const Sched& S, const Epi& E, const float* gs_ss = nullptr) {
    const int tid = tid_fresh(), wid = __builtin_amdgcn_readfirstlane(tid >> 6), lane = tid & 63, wr = wid >> 2, wc = wid & 3, fr = lane & 15, fq = lane >> 4;
    const int K = g.K, nt = g.Kloop / BK;
    unsigned voffA[2], voffB[2];
#pragma unroll
    for (int i = 0; i < 2; ++i) { int R, C; stage_rc(tid * 16 + i * 8192, R, C); const int Rb = Epi::PERM ? ((R & ~31) + perm32(R & 31)) : R;
        voffA[i] = (unsigned)(R * K + C) * 2u; voffB[i] = (unsigned)(Rb * K + C) * 2u; }
    const size_t kstep = (size_t)(BK * 2);
    const size_t hstep = (size_t)HALF * K * 2;
    const size_t tstep = 2 * hstep;
    const unsigned ldsw = (unsigned)wid * 1024u;
    const int aoff = lds_byte(wr * 64 + fr, fq * 8), boff = lds_byte(wc * 32 + fr, fq * 8);
#define PG8_GS_BUILD(uu, par) do { if constexpr (GS) { const int _row = tid >> 1, _g0 = (tid & 1) * 2; \
        const float* _sp = gs_ss + ((size_t)((uu).pm * BM + _row)) * 32 + _g0 * 8; \
        const f32x4 _a0 = *(const f32x4*)_sp, _a1 = *(const f32x4*)(_sp + 4), _b0 = *(const f32x4*)(_sp + 8), _b1 = *(const f32x4*)(_sp + 12); \
        const float _s0 = ((_a0[0] + _a0[1]) + (_a0[2] + _a0[3])) + ((_a1[0] + _a1[1]) + (_a1[2] + _a1[3])), _s1 = ((_b0[0] + _b0[1]) + (_b0[2] + _b0[3])) + ((_b1[0] + _b1[1]) + (_b1[2] + _b1[3])); \
        PG8_LAS float* _t = (PG8_LAS float*)(lds + STAGE_BYTES + (par) * 4096); \
        _t[_g0 * 256 + _row] = 1.0f / sqrtf(_s0 * (1.0f / 512.0f) + EPS); _t[(_g0 + 1) * 256 + _row] = 1.0f / sqrtf(_s1 * (1.0f / 512.0f) + EPS); } } while (0)
#define PG8_GS_SCALE(gb, par) do { if constexpr (GS) { const PG8_LAS float* _t = (const PG8_LAS float*)(lds + STAGE_BYTES + (par) * 4096); \
        _Pragma("unroll") for (int _ai = 0; _ai < 2; ++_ai) _Pragma("unroll") for (int _m = 0; _m < 4; ++_m) { const int _rl = _ai * HALF + wr * 64 + _m * 16 + fr; \
            const float _f = _t[(gb) * 256 + _rl] / _t[((gb) + 1) * 256 + _rl]; \
            _Pragma("unroll") for (int _bj = 0; _bj < 2; ++_bj) _Pragma("unroll") for (int _n = 0; _n < 2; ++_n) acc[_ai][_bj][_m][_n] = acc[_ai][_bj][_m][_n] * _f; } } } while (0)
#define PG8_SA(b, h) (((b) * 2 + (h)) * HTB)
#define PG8_SB(b, h) ((4 + (b) * 2 + (h)) * HTB)
#define PG8_STAGE(bufoff, gbase, voff) do { _Pragma("unroll") for (int _i = 0; _i < 2; ++_i) \
        __builtin_amdgcn_global_load_lds((const unsigned*)((const char*)(gbase) + (voff)[_i]), (PG8_LAS unsigned*)(lds + (bufoff) + ldsw + _i * 8192), 16, 0, 0); } while (0)
#define PG8_LDA(dst, b, h) do { _Pragma("unroll") for (int m = 0; m < 4; ++m) _Pragma("unroll") for (int k = 0; k < 2; ++k) dst[m][k] = *(const PG8_LAS bf16x8*)(lds + PG8_SA(b, h) + aoff + m * 2048 + k * 1024); } while (0)
#define PG8_LDB(dst, b, h) do { _Pragma("unroll") for (int n = 0; n < 2; ++n) _Pragma("unroll") for (int k = 0; k < 2; ++k) dst[n][k] = *(const PG8_LAS bf16x8*)(lds + PG8_SB(b, h) + boff + n * 2048 + k * 1024); } while (0)
#define PG8_MMA(ai, bj, At, Bt) do { __builtin_amdgcn_s_setprio(1); _Pragma("unroll") for (int m = 0; m < 4; ++m) _Pragma("unroll") for (int n = 0; n < 2; ++n) _Pragma("unroll") for (int k = 0; k < 2; ++k) \
        acc[ai][bj][m][n] = __builtin_amdgcn_mfma_f32_16x16x32_bf16(Bt[n][k], At[m][k], acc[ai][bj][m][n], 0, 0, 0); __builtin_amdgcn_s_setprio(0); } while (0)
#define PG8_WAIT_V(n) asm volatile("s_waitcnt vmcnt(" #n ")" ::: "memory")
#define PG8_WAIT_L(n) asm volatile("s_waitcnt lgkmcnt(" #n ")" ::: "memory")
#define PG8_BAR __builtin_amdgcn_s_barrier()
#define PG8_SCHED __builtin_amdgcn_sched_barrier(0)
    Unit cur, nxt; int ui = 0;
    if (!S.next(0, cur)) return;
    f32x4 acc[2][2][4][2];
#pragma unroll
    for (int a = 0; a < 2; ++a)
#pragma unroll
        for (int b = 0; b < 2; ++b)
#pragma unroll
            for (int m = 0; m < 4; ++m)
#pragma unroll
                for (int n = 0; n < 2; ++n) acc[a][b][m][n] = (f32x4){0.f, 0.f, 0.f, 0.f};
    bf16x8 At[4][2], B0[2][2], B1[2][2];
    const char* cA = (const char*)g.A + S.a_extra(cur) + (size_t)cur.pm * tstep; const char* cB = (const char*)g.Bt + S.b_extra(cur) + (size_t)cur.pn * tstep;
    int gpar = 0;
    PG8_GS_BUILD(cur, 0);
    if constexpr (SP2) {
        PG8_STAGE(PG8_SB(0, 0), cB, voffB); PG8_STAGE(PG8_SB(0, 1), cB + hstep, voffB); PG8_STAGE(PG8_SA(0, 0), cA, voffA); PG8_STAGE(PG8_SA(0, 1), cA + hstep, voffA);
        if (wr == 1) PG8_BAR;
        PG8_WAIT_V(2); PG8_BAR;
        PG8_STAGE(PG8_SB(1, 0), cB + kstep, voffB); PG8_STAGE(PG8_SA(1, 0), cA + kstep, voffA); PG8_STAGE(PG8_SB(1, 1), cB + hstep + kstep, voffB);
        PG8_WAIT_V(6); PG8_BAR;
    } else {
        PG8_STAGE(PG8_SB(0, 0), cB, voffB); PG8_STAGE(PG8_SA(0, 0), cA, voffA); PG8_STAGE(PG8_SB(0, 1), cB + hstep, voffB); PG8_STAGE(PG8_SA(0, 1), cA + hstep, voffA);
        if (wr == 1) PG8_BAR;
        PG8_WAIT_V(4); PG8_BAR;
        PG8_STAGE(PG8_SB(1, 0), cB + kstep, voffB); PG8_STAGE(PG8_SA(1, 0), cA + kstep, voffA); PG8_STAGE(PG8_SB(1, 1), cB + hstep + kstep, voffB);
        PG8_WAIT_V(6); PG8_BAR;
    }
    for (;;) {
        const bool has_next = S.next(ui + 1, nxt);
        const char* nA = has_next ? (const char*)g.A + S.a_extra(nxt) + (size_t)nxt.pm * tstep : cA; const char* nB = has_next ? (const char*)g.Bt + S.b_extra(nxt) + (size_t)nxt.pn * tstep : cB;
        for (int t = 0; t < nt; t += 2) {
            const bool last = (t == nt - 2);
            const char* a1 = cA + (size_t)(t + 1) * kstep;
            const char* a2 = last ? nA : cA + (size_t)(t + 2) * kstep; const char* b2 = last ? nB : cB + (size_t)(t + 2) * kstep;
            const char* a3 = a2 + kstep; const char* b3 = b2 + kstep;
            if constexpr (SP2) {
            PG8_LDB(B0, 0, 0); PG8_LDB(B1, 0, 1); PG8_SCHED; PG8_LDA(At, 0, 0); PG8_STAGE(PG8_SA(1, 1), a1 + hstep, voffA);
            PG8_WAIT_V(8); PG8_WAIT_L(0); PG8_BAR; PG8_MMA(0, 0, At, B0); PG8_MMA(0, 1, At, B1); PG8_BAR; PG8_SCHED;
            PG8_LDA(At, 0, 1); PG8_STAGE(PG8_SB(0, 0), b2, voffB); PG8_STAGE(PG8_SB(0, 1), b2 + hstep, voffB); PG8_STAGE(PG8_SA(0, 0), a2, voffA);
            PG8_WAIT_V(8); PG8_WAIT_L(0); PG8_BAR; PG8_MMA(1, 0, At, B0); PG8_MMA(1, 1, At, B1); PG8_BAR; PG8_SCHED;
            PG8_LDB(B0, 1, 0); PG8_LDB(B1, 1, 1); PG8_SCHED; PG8_LDA(At, 1, 0); PG8_STAGE(PG8_SA(0, 1), a2 + hstep, voffA);
            PG8_WAIT_V(8); PG8_WAIT_L(0); PG8_BAR; PG8_MMA(0, 0, At, B0); PG8_MMA(0, 1, At, B1); PG8_BAR; PG8_SCHED;
            PG8_LDA(At, 1, 1); PG8_STAGE(PG8_SB(1, 0), b3, voffB); PG8_STAGE(PG8_SB(1, 1), b3 + hstep, voffB); PG8_STAGE(PG8_SA(1, 0), a3, voffA);
            PG8_WAIT_V(8); PG8_WAIT_L(0); PG8_BAR; PG8_MMA(1, 0, At, B0); PG8_MMA(1, 1, At, B1); PG8_BAR; PG8_SCHED;
            } else {
            PG8_LDB(B0, 0, 0); PG8_SCHED; PG8_LDA(At, 0, 0); PG8_STAGE(PG8_SA(1, 1), a1 + hstep, voffA);
            PG8_WAIT_L(8); PG8_BAR; PG8_WAIT_L(0); PG8_MMA(0, 0, At, B0); PG8_BAR; PG8_SCHED;
            PG8_LDB(B1, 0, 1); PG8_STAGE(PG8_SB(0, 0), b2, voffB);
            PG8_BAR; PG8_WAIT_L(0); PG8_MMA(0, 1, At, B1); PG8_BAR;
            PG8_LDA(At, 0, 1); PG8_STAGE(PG8_SA(0, 0), a2, voffA);
            PG8_BAR; PG8_WAIT_L(0); PG8_MMA(1, 0, At, B0); PG8_BAR; PG8_SCHED;
            PG8_STAGE(PG8_SB(0, 1), b2 + hstep, voffB);
            PG8_WAIT_V(6); PG8_BAR; PG8_MMA(1, 1, At, B1); PG8_BAR;
            PG8_LDB(B0, 1, 0); PG8_SCHED; PG8_LDA(At, 1, 0); PG8_STAGE(PG8_SA(0, 1), a2 + hstep, voffA);
            PG8_WAIT_L(8); PG8_BAR; PG8_WAIT_L(0); PG8_MMA(0, 0, At, B0); PG8_BAR; PG8_SCHED;
            PG8_LDB(B1, 1, 1); PG8_STAGE(PG8_SB(1, 0), b3, voffB);
            PG8_BAR; PG8_WAIT_L(0); PG8_MMA(0, 1, At, B1); PG8_BAR;
            PG8_LDA(At, 1, 1); PG8_STAGE(PG8_SA(1, 0), a3, voffA);
            PG8_BAR; PG8_WAIT_L(0); PG8_MMA(1, 0, At, B0); PG8_BAR; PG8_SCHED;
            PG8_STAGE(PG8_SB(1, 1), b3 + hstep, voffB);
            PG8_WAIT_V(6); PG8_BAR; PG8_MMA(1, 1, At, B1); PG8_BAR;
                    }
            if constexpr (GS) { if ((t & 7) == 6 && !last) { PG8_GS_SCALE(t >> 3, gpar); } }
        }
        if constexpr (ALIGN_EPI) { if (wr == 0) PG8_BAR; }
        if constexpr (GS) E.gs(acc, cur, wr, wc, fr, fq, (const PG8_LAS float*)(lds + STAGE_BYTES + gpar * 4096)); else E(acc, cur, wr, wc, fr, fq);
        if (!has_next) break;
#pragma unroll
        for (int a = 0; a < 2; ++a)
#pragma unroll
            for (int b = 0; b < 2; ++b)
#pragma unroll
                for (int m = 0; m < 4; ++m)
#pragma unroll
                    for (int n = 0; n < 2; ++n) acc[a][b][m][n] = (f32x4){0.f, 0.f, 0.f, 0.f};
        cur = nxt; cA = nA; cB = nB; ++ui;
        if constexpr (GS) { gpar ^= 1; PG8_GS_BUILD(cur, gpar); }
        if constexpr (ALIGN_EPI) { if (wr == 1) PG8_BAR; }
    }
    PG8_WAIT_V(0);
    if constexpr (!ALIGN_EPI) { if (wr == 0) PG8_BAR; }
    PG8_BAR;
#undef PG8_GS_BUILD
#undef PG8_GS_SCALE
#undef PG8_SA
#undef PG8_SB
#undef PG8_STAGE
#undef PG8_LDA
#undef PG8_LDB
#undef PG8_MMA
#undef PG8_WAIT_V
#undef PG8_WAIT_L
#undef PG8_BAR
#undef PG8_SCHED
}
}

template <class Epi>
__device__ __forceinline__ void run_gemm(unsigned char* shm, const bf16_t* A, const bf16_t* Bt, int M, int N, int K, const Epi& E) {
    pg8::StaticOrder S; S.init(M, N, (int)gridDim.x, (int)bid_fresh());
    pg8::Gemm g{A, Bt, M, N, K, K};
    pg8::gemm_phase<Epi, pg8::StaticOrder>((PG8_LAS unsigned char*)shm, g, S, E);
}

__device__ __forceinline__ void tconv_tile(const float* src, int N, int kb, int nb, bf16_t* dst, int ldd, float* tile, const float* kscale = nullptr) {
    const int tid = tid_fresh();
#pragma unroll
    for (int p = 0; p < 2; ++p) {
        const int r = (tid >> 4) + p * 32, c4 = tid & 15;
        f32x4 v = *(const f32x4*)(src + (size_t)(kb * 64 + r) * N + nb * 64 + c4 * 4);
        if (kscale) v = v * kscale[kb * 64 + r];
        float* t = tile + r * 65 + c4 * 4; t[0] = v[0]; t[1] = v[1]; t[2] = v[2]; t[3] = v[3];
    }
    __syncthreads();
    const int n = tid >> 3, k8 = tid & 7;
    const float* s = tile + (k8 * 8) * 65 + n;
    u32x4 o; o.x = pk2(s[0], s[65]); o.y = pk2(s[2 * 65], s[3 * 65]); o.z = pk2(s[4 * 65], s[5 * 65]); o.w = pk2(s[6 * 65], s[7 * 65]);
    *(u32x4*)(dst + (size_t)(nb * 64 + n) * ldd + kb * 64 + k8 * 8) = o;
    __syncthreads();
}

__device__ __forceinline__ void tconv_tile_w(const float* src, int N, int kb, int nb, bf16_t* dst, int ldd, float* tile, const float* kscale = nullptr) {
    const int tid = tid_fresh();
    f32x4 v[8];
#pragma unroll
    for (int p = 0; p < 8; ++p) { const int idx = tid + 512 * p, r = idx >> 6, c4 = idx & 63;
        v[p] = __builtin_nontemporal_load((const f32x4*)(src + (size_t)(kb * 64 + r) * N + nb * 256 + c4 * 4)); }
    if (kscale) {
#pragma unroll
        for (int p = 0; p < 8; ++p) v[p] = v[p] * kscale[kb * 64 + ((tid + 512 * p) >> 6)];
    }
#pragma unroll
    for (int p = 0; p < 8; ++p) { const int idx = tid + 512 * p, r = idx >> 6, c4 = idx & 63;
        float* t = tile + r * 257 + c4 * 4; t[0] = v[p][0]; t[1] = v[p][1]; t[2] = v[p][2]; t[3] = v[p][3]; }
    __syncthreads();
#pragma unroll
    for (int q = 0; q < 4; ++q) { const int id = tid + 512 * q, n = id >> 3, k8 = id & 7;
        const float* s = tile + (k8 * 8) * 257 + n;
        u32x4 o; o.x = pk2(s[0], s[257]); o.y = pk2(s[2 * 257], s[3 * 257]); o.z = pk2(s[4 * 257], s[5 * 257]); o.w = pk2(s[6 * 257], s[7 * 257]);
        *(u32x4*)(dst + (size_t)(nb * 256 + n) * ldd + kb * 64 + k8 * 8) = o; }
    __syncthreads();
}

__device__ __forceinline__ void rms_row_bf16(const float* x, const float* g, bf16_t* o, int lane) {
    f32x4 v[8]; float ss = 0.f;
#pragma unroll
    for (int j = 0; j < 8; ++j) { v[j] = ((const f32x4*)x)[lane + 64 * j]; ss += v[j][0] * v[j][0] + v[j][1] * v[j][1] + v[j][2] * v[j][2] + v[j][3] * v[j][3]; }
    ss = wave_sum(ss);
    const float rs = 1.0f / sqrtf(ss * (1.0f / D) + EPS);
#pragma unroll
    for (int j = 0; j < 8; ++j) { const f32x4 gg = ((const f32x4*)g)[lane + 64 * j];
        u32x2 w; w.x = pk2(v[j][0] * rs * gg[0], v[j][1] * rs * gg[1]); w.y = pk2(v[j][2] * rs * gg[2], v[j][3] * rs * gg[3]);
        ((u32x2*)o)[lane + 64 * j] = w; }
}
__device__ __forceinline__ void rms_row_f32(const float* x, const float* g, float* o, int lane) {
    f32x4 v[8]; float ss = 0.f;
#pragma unroll
    for (int j = 0; j < 8; ++j) { v[j] = ((const f32x4*)x)[lane + 64 * j]; ss += v[j][0] * v[j][0] + v[j][1] * v[j][1] + v[j][2] * v[j][2] + v[j][3] * v[j][3]; }
    ss = wave_sum(ss);
    const float rs = 1.0f / sqrtf(ss * (1.0f / D) + EPS);
#pragma unroll
    for (int j = 0; j < 8; ++j) { const f32x4 gg = ((const f32x4*)g)[lane + 64 * j]; ((f32x4*)o)[lane + 64 * j] = v[j] * rs * gg; }
}

__device__ __forceinline__ void phase_rms(const float* h, const float* g, bf16_t* xn, int nrows) {
    const int lane = tid_fresh() & 63, gw = bid_fresh() * 8 + (tid_fresh() >> 6), NGW = gridDim.x * 8;
    for (int r = gw; r < nrows; r += NGW) rms_row_bf16(h + (size_t)r * D, g, xn + (size_t)r * D, lane);
}

__device__ __forceinline__ void phase0(PP p, unsigned char* shm) {
    unsigned char* ws = p->ws;
    float* tile = (float*)shm;
    constexpr int C_IN = 32 * 14, C_OUT = 32 * 8, C_XQ = 32 * 2, C_XO = 8 * 8, C_UP = 32 * 32, C_DN = 128 * 8, C_GLU = 8 * 2, C_POOL = 16, C_PW = 8 * 2;
    constexpr int C_LAYER = C_IN + C_OUT + 3 * C_XQ + C_XO + C_UP + C_DN + C_GLU + C_POOL + C_PW;
    for (int it = bid_fresh(); it < DEPTH * C_LAYER; it += gridDim.x) {
        const int l = it / C_LAYER; int r = it % C_LAYER;
        if (r < C_IN) { tconv_tile_w(p->in[5] + (size_t)l * D * INW, INW, r / 14, r % 14, (bf16_t*)(ws + WS_WIN) + (size_t)l * INW * D, D, tile, p->in[4] + (size_t)l * D); continue; } r -= C_IN;
        if (r < C_OUT) { tconv_tile_w(p->in[23] + (size_t)l * D * D, D, r / 8, r % 8, (bf16_t*)(ws + WS_WOUT) + (size_t)l * D * D, D, tile, p->in[22] + (size_t)l * D); continue; } r -= C_OUT;
        if (r < C_XQ) { tconv_tile_w(p->in[25] + (size_t)l * D * 512, 512, r / 2, r % 2, (bf16_t*)(ws + WS_WXQ) + (size_t)l * 512 * D, D, tile, p->in[24] + (size_t)l * D); continue; } r -= C_XQ;
        if (r < C_XQ) { tconv_tile_w(p->in[26] + (size_t)l * D * 512, 512, r / 2, r % 2, (bf16_t*)(ws + WS_WKV) + (size_t)(l * 1024) * D, D, tile); continue; } r -= C_XQ;
        if (r < C_XQ) { tconv_tile_w(p->in[27] + (size_t)l * D * 512, 512, r / 2, r % 2, (bf16_t*)(ws + WS_WKV) + (size_t)(l * 1024 + 512) * D, D, tile); continue; } r -= C_XQ;
        if (r < C_XO) { tconv_tile_w(p->in[28] + (size_t)l * 512 * D, D, r / 8, r % 8, (bf16_t*)(ws + WS_WXO) + (size_t)l * D * 512, 512, tile); continue; } r -= C_XO;
        if (r < C_UP) { tconv_tile_w(p->in[30] + (size_t)l * D * DFF, DFF, r / 32, r % 32, (bf16_t*)(ws + WS_WUP) + (size_t)l * DFF * D, D, tile, p->in[29] + (size_t)l * D); continue; } r -= C_UP;
        if (r < C_DN) { tconv_tile_w(p->in[31] + (size_t)l * DFF * D, D, r / 8, r % 8, (bf16_t*)(ws + WS_WDN) + (size_t)l * D * DFF, DFF, tile); continue; } r -= C_DN;
        bf16_t* wsm = (bf16_t*)(ws + WS_WSM) + (size_t)l * 1536 * 512;
        if (r < C_GLU) { tconv_tile_w(p->in[14] + (size_t)l * 512 * 512, 512, r / 2, r % 2, wsm, 512, tile); continue; } r -= C_GLU;
        if (r < C_POOL) { const int gi = r >> 2, q = r & 3; tconv_tile(p->in[15] + (size_t)(l * 4 + gi) * 128 * 128, 128, q >> 1, q & 1, wsm + (size_t)(512 + gi * 128) * 512 + gi * 128, 512, tile); continue; } r -= C_POOL;
        tconv_tile_w(p->in[21] + (size_t)l * 512 * 512, 512, r / 2, r % 2, wsm + (size_t)1024 * 512, 512, tile);
    }
    {
        const int gt = bid_fresh() * 512 + tid_fresh(), NT = gridDim.x * 512;
        for (int i = gt; i < DEPTH * 512 * 64; i += NT) {
            const int l = i / (512 * 64), rr = (i / 64) % 512, ch = i % 64;
            if ((rr >> 7) != (ch >> 4)) { bf16_t* wsm = (bf16_t*)(ws + WS_WSM) + (size_t)l * 1536 * 512; *(u32x4*)(wsm + (size_t)(512 + rr) * 512 + ch * 8) = (u32x4){0u, 0u, 0u, 0u}; }
        }
    }
    phase_rms(p->in[1], p->in[3], (bf16_t*)(ws + WS_MEMN), 1024);
    {
        const int lane = tid_fresh() & 63, gw = bid_fresh() * 8 + (tid_fresh() >> 6), NGW = gridDim.x * 8;
        float* ssb = (float*)(ws + WS_SS);
        for (int r = gw; r < T; r += NGW) {
            const float* x = p->in[0] + (size_t)r * D; bf16_t* o = (bf16_t*)(ws + WS_XN) + (size_t)r * D; float sq = 0.f;
#pragma unroll
            for (int j = 0; j < 8; ++j) { const f32x4 v = ((const f32x4*)x)[lane + 64 * j]; sq += v[0] * v[0] + v[1] * v[1] + v[2] * v[2] + v[3] * v[3];
                u32x2 w; w.x = pk2(v[0], v[1]); w.y = pk2(v[2], v[3]); ((u32x2*)o)[lane + 64 * j] = w; }
            sq = wave_sum(sq);
            if (lane < 32) ssb[(size_t)r * 32 + lane] = (lane == 0) ? sq : 0.f;
        }
    }
}

constexpr int VS = 268;
template <int HD, bool DIL>
__device__ __forceinline__ void attn_compute(const bf16_t* Ks, const bf16_t* Vt, const bf16x8 (&qf)[HD / 32], int a, int quad, int fr,
                                             const float* biasT, int kmin, f32x4 (&oacc)[HD / 16], float& mx_out, float& den_out) {
    f32x4 s[16];
#pragma unroll
    for (int nt = 0; nt < 16; ++nt) {
        s[nt] = (f32x4){0.f, 0.f, 0.f, 0.f};
#pragma unroll
        for (int ks = 0; ks < HD / 32; ++ks) {
            const bf16x8 kf = *(const bf16x8*)(Ks + (16 * nt + fr) * (HD + 8) + quad * 8 + 32 * ks);
            s[nt] = __builtin_amdgcn_mfma_f32_16x16x32_bf16(kf, qf[ks], s[nt], 0, 0, 0);
        }
    }
    float mx = -3.0e38f;
    const float* tb = DIL ? (biasT + (127 - a + 4 * quad)) : nullptr;
#pragma unroll
    for (int nt = 0; nt < 16; ++nt)
#pragma unroll
        for (int j = 0; j < 4; ++j) {
            float v = s[nt][j];
            if (DIL) {
                v = v * 0.18033688011112042f + tb[16 * nt + j];
                if (nt < 8) v = kmin ? -1.0e30f : v;
            }
            s[nt][j] = v; mx = fmaxf(mx, v);
        }
    mx = fmaxf(mx, __shfl_xor(mx, 16)); mx = fmaxf(mx, __shfl_xor(mx, 32));
    float sum = 0.f;
#pragma unroll
    for (int nt = 0; nt < 16; ++nt)
#pragma unroll
        for (int j = 0; j < 4; ++j) { const float pv = __builtin_amdgcn_exp2f(s[nt][j] - mx); s[nt][j] = pv; sum += pv; }
    sum += __shfl_xor(sum, 16); sum += __shfl_xor(sum, 32);
#pragma unroll
    for (int dt = 0; dt < HD / 16; ++dt) oacc[dt] = (f32x4){0.f, 0.f, 0.f, 0.f};
#pragma unroll
    for (int k2 = 0; k2 < 8; ++k2) {
        u32x4 pp; pp.x = pk2(s[2 * k2][0], s[2 * k2][1]); pp.y = pk2(s[2 * k2][2], s[2 * k2][3]); pp.z = pk2(s[2 * k2 + 1][0], s[2 * k2 + 1][1]); pp.w = pk2(s[2 * k2 + 1][2], s[2 * k2 + 1][3]);
        const bf16x8 pf = __builtin_bit_cast(bf16x8, pp);
#pragma unroll
        for (int dt = 0; dt < HD / 16; ++dt) {
            const bf16_t* vp = Vt + (16 * dt + fr) * VS + 32 * k2 + quad * 4;
            const u32x2 lo = *(const u32x2*)vp, hi = *(const u32x2*)(vp + 16);
            u32x4 vv; vv.x = lo.x; vv.y = lo.y; vv.z = hi.x; vv.w = hi.y;
            oacc[dt] = __builtin_amdgcn_mfma_f32_16x16x32_bf16(__builtin_bit_cast(bf16x8, vv), pf, oacc[dt], 0, 0, 0);
        }
    }
    mx_out = mx; den_out = sum;
}

__device__ __forceinline__ void attn_band64(const bf16_t* Ks, const bf16_t* Vt, const bf16x8 (&qf)[2], int a, int w, int quad, int fr,
                                            const float* biasT, int kmin, f32x4 (&oacc)[4], float& mx_out, float& den_out) {
    f32x4 s[10];
#pragma unroll
    for (int i = 0; i < 10; ++i) {
        const int nt = (w + i) > 15 ? 15 : (w + i);
        s[i] = (f32x4){0.f, 0.f, 0.f, 0.f};
#pragma unroll
        for (int ks = 0; ks < 2; ++ks) {
            const bf16x8 kf = *(const bf16x8*)(Ks + (16 * nt + fr) * 72 + quad * 8 + 32 * ks);
            s[i] = __builtin_amdgcn_mfma_f32_16x16x32_bf16(kf, qf[ks], s[i], 0, 0, 0);
        }
    }
    float mx = -3.0e38f;
    const float* tb = biasT + (127 - a + 4 * quad + 16 * w);
#pragma unroll
    for (int i = 0; i < 10; ++i) {
        const bool dead = (kmin != 0) && ((w + i) < 8);
#pragma unroll
        for (int j = 0; j < 4; ++j) {
            float v = s[i][j] * 0.18033688011112042f + tb[16 * i + j];
            v = dead ? -1.0e30f : v;
            s[i][j] = v; mx = fmaxf(mx, v);
        }
    }
    mx = fmaxf(mx, __shfl_xor(mx, 16)); mx = fmaxf(mx, __shfl_xor(mx, 32));
    float sum = 0.f;
#pragma unroll
    for (int i = 0; i < 10; ++i)
#pragma unroll
        for (int j = 0; j < 4; ++j) { const float pv = __builtin_amdgcn_exp2f(s[i][j] - mx); s[i][j] = pv; sum += pv; }
    sum += __shfl_xor(sum, 16); sum += __shfl_xor(sum, 32);
#pragma unroll
    for (int dt = 0; dt < 4; ++dt) oacc[dt] = (f32x4){0.f, 0.f, 0.f, 0.f};
#pragma unroll
    for (int k2 = 0; k2 < 5; ++k2) {
        u32x4 pp; pp.x = pk2(s[2 * k2][0], s[2 * k2][1]); pp.y = pk2(s[2 * k2][2], s[2 * k2][3]); pp.z = pk2(s[2 * k2 + 1][0], s[2 * k2 + 1][1]); pp.w = pk2(s[2 * k2 + 1][2], s[2 * k2 + 1][3]);
        const bf16x8 pf = __builtin_bit_cast(bf16x8, pp);
        const int t0 = w + 2 * k2, t1 = (t0 + 1) > 15 ? 15 : (t0 + 1);
#pragma unroll
        for (int dt = 0; dt < 4; ++dt) {
            const bf16_t* vp = Vt + (16 * dt + fr) * VS + quad * 4;
            const u32x2 lo = *(const u32x2*)(vp + 16 * t0), hi = *(const u32x2*)(vp + 16 * t1);
            u32x4 vv; vv.x = lo.x; vv.y = lo.y; vv.z = hi.x; vv.w = hi.y;
            oacc[dt] = __builtin_amdgcn_mfma_f32_16x16x32_bf16(__builtin_bit_cast(bf16x8, vv), pf, oacc[dt], 0, 0, 0);
        }
    }
    mx_out = mx; den_out = sum;
}

__device__ __forceinline__ void vt_store_pair(bf16_t* Vt, int dim0, int bi, const u32x4 a, const u32x4 b) {
    unsigned* vd = (unsigned*)(Vt + dim0 * VS + bi);
    constexpr int RS = VS / 2;
    vd[0 * RS] = (a.x & 0xffffu) | (b.x << 16); vd[1 * RS] = (a.x >> 16) | (b.x & 0xffff0000u);
    vd[2 * RS] = (a.y & 0xffffu) | (b.y << 16); vd[3 * RS] = (a.y >> 16) | (b.y & 0xffff0000u);
    vd[4 * RS] = (a.z & 0xffffu) | (b.z << 16); vd[5 * RS] = (a.z >> 16) | (b.z & 0xffff0000u);
    vd[6 * RS] = (a.w & 0xffffu) | (b.w << 16); vd[7 * RS] = (a.w >> 16) | (b.w & 0xffff0000u);
}
__device__ __forceinline__ int t5_bucket(int n) {
    if (n < 16) return n;
    int b = 16;
    b += (n >= 22); b += (n >= 30); b += (n >= 40); b += (n >= 54); b += (n >= 73); b += (n >= 99); b += (n >= 134); b += (n >= 182);
    b += (n >= 246); b += (n >= 332); b += (n >= 450); b += (n >= 609); b += (n >= 825); b += (n >= 1117); b += (n >= 1513);
    return b;
}

constexpr int AT_KS = 0, AT_VT = 69632, AT_BIAS = 137216;
constexpr int DA_KS = 0, DA_VT = 36864, DA_BIAS = 36864 + 64 * VS * 2, DA_BUF = 73728;

struct DilUnit { int br, b, h, d, r, n; };
__device__ __forceinline__ DilUnit dil_decode(int u0) {
    const int u = (u0 & 7) * 192 + (u0 >> 3);
    DilUnit q; q.br = u / 512; const int rem = u % 512; q.b = rem / 128; q.h = (rem / 16) % 8; const int rn = rem % 16;
    q.d = (q.br == 0) ? 1 : (q.br == 1 ? 4 : 16); const int nbk = 16 / q.d; q.r = rn / nbk; q.n = rn % nbk; return q;
}
struct DilRegs { u32x4 kv[4], vv[4]; float bias; bf16x8 qf[2]; };
__device__ __forceinline__ void dil_issue(PP p, const DilUnit& q, DilRegs& R, int tid) {
    const bf16_t* proj = (const bf16_t*)(p->ws + WS_PROJ);
#pragma unroll
    for (int i = 0; i < 4; ++i) {
        const int bi = 2 * (tid >> 3) + (i & 1) + 128 * (i >> 1), ch = tid & 7, sp = 128 * (q.n - 1) + bi;
        R.kv[i] = (u32x4){0u, 0u, 0u, 0u}; R.vv[i] = R.kv[i];
        if (sp >= 0) { const size_t hp = ((size_t)((q.b * 8 + q.h) * SEQ + sp * q.d + q.r)) * 64 + ch * 8; R.kv[i] = *(const u32x4*)(proj + PJ_QKV + (size_t)1 * 4 * 8 * SEQ * 64 + hp); R.vv[i] = *(const u32x4*)(proj + PJ_QKV + (size_t)2 * 4 * 8 * SEQ * 64 + hp); }
    }
    { const int w = tid >> 6, lane = tid & 63, fr = lane & 15, quad = lane >> 4, a = 16 * w + fr;
      const size_t rowq = (size_t)(q.b * SEQ + (128 * q.n + a) * q.d + q.r);
      const bf16_t* qp = proj + PJ_QKV + ((size_t)((q.b * 8 + q.h) * SEQ) + (rowq - (size_t)q.b * SEQ)) * 64 + quad * 8;
      R.qf[0] = *(const bf16x8*)qp; R.qf[1] = *(const bf16x8*)(qp + 32); }
    R.bias = -1.0e30f;
    if (tid < 383) { const int sd = 255 - tid; if (sd >= 0 && sd <= 128) R.bias = p->in[2][t5_bucket(sd * q.d) * 8 + q.h] * 1.4426950408889634f; }
}
__device__ __forceinline__ void dil_stage(const DilRegs& R, unsigned char* buf, int tid) {
    bf16_t* Ks = (bf16_t*)(buf + DA_KS); bf16_t* Vt = (bf16_t*)(buf + DA_VT); float* biasT = (float*)(buf + DA_BIAS);
#pragma unroll
    for (int i = 0; i < 4; ++i) { const int bi = 2 * (tid >> 3) + (i & 1) + 128 * (i >> 1), ch = tid & 7; *(u32x4*)(Ks + bi * 72 + ch * 8) = R.kv[i]; }
#pragma unroll
    for (int i = 0; i < 4; i += 2) { const int bi = 2 * (tid >> 3) + 128 * (i >> 1), ch = tid & 7; vt_store_pair(Vt, ch * 8, bi, R.vv[i], R.vv[i + 1]); }
    if (tid < 383) biasT[tid] = R.bias;
}
__device__ __forceinline__ void dil_compute(PP p, const DilUnit& q, const unsigned char* buf, int tid, const bf16x8 (&qf)[2]) {
    const bf16_t* Ks = (const bf16_t*)(buf + DA_KS); const bf16_t* Vt = (const bf16_t*)(buf + DA_VT); const float* biasT = (const float*)(buf + DA_BIAS);
    const int w = tid >> 6, lane = tid & 63, fr = lane & 15, quad = lane >> 4;
    const int a = 16 * w + fr;
    const size_t rowq = (size_t)(q.b * SEQ + (128 * q.n + a) * q.d + q.r);
    f32x4 oacc[4]; float mx, den;
    attn_band64(Ks, Vt, qf, a, w, quad, fr, biasT, (q.n == 0) ? 128 : 0, oacc, mx, den);
    const float inv = 1.0f / den;
    bf16_t* ob = (bf16_t*)(p->ws + WS_OB) + ((size_t)q.br * T + rowq) * 512 + q.h * 64 + quad * 4;
#pragma unroll
    for (int dt = 0; dt < 4; ++dt) { u32x2 o; o.x = pk2(oacc[dt][0] * inv, oacc[dt][1] * inv); o.y = pk2(oacc[dt][2] * inv, oacc[dt][3] * inv); *(u32x2*)(ob + 16 * dt) = o; }
    if (quad == 0) ((float*)(p->ws + WS_LSE))[((size_t)q.br * T + rowq) * 8 + q.h] = mx * 0.6931471805599453f + __logf(den);
}
__device__ __forceinline__ void dil_attn_units(unsigned char* shm, int first, int stride) {
    const int tid = tid_fresh();
    if (first >= 1536) return;
    bf16x8 qcur[2];
    { PP p = get_pp(); DilRegs R; const DilUnit q = dil_decode(first); dil_issue(p, q, R, tid); dil_stage(R, shm, tid); qcur[0] = R.qf[0]; qcur[1] = R.qf[1]; }
    __syncthreads();
    int par = 0;
    for (int u = first; u < 1536; u += stride) {
        PP p = get_pp();
        const bool more = (u + stride) < 1536;
        DilRegs R; DilUnit qn = dil_decode(more ? u + stride : u);
        if (more) dil_issue(p, qn, R, tid);
        const DilUnit q = dil_decode(u);
        dil_compute(p, q, shm + par * DA_BUF, tid, qcur);
        if (more) { dil_stage(R, shm + (par ^ 1) * DA_BUF, tid); qcur[0] = R.qf[0]; qcur[1] = R.qf[1]; }
        __syncthreads();
        par ^= 1;
    }
}

__device__ __forceinline__ void cross_attn_unit(PP p, unsigned char* shm, int u, int l) {
    const bf16_t* kvb = (const bf16_t*)(p->ws + WS_KV);
    bf16_t* Ks = (bf16_t*)(shm + AT_KS); bf16_t* Vt = (bf16_t*)(shm + AT_VT);
    const int tid = tid_fresh(), w = tid >> 6, lane = tid & 63, fr = lane & 15, quad = lane >> 4;
    const int b = u / 64, xh = (u / 16) % 4, qt = u % 16;
    const size_t rowq = (size_t)(b * SEQ + qt * 128 + 16 * w + fr);
    float qs;
    { const float* sp = (const float*)(p->ws + WS_SS) + ((size_t)(1 + 3 * l) * T + rowq) * 32 + quad * 8;
      const f32x4 a0 = *(const f32x4*)sp, a1 = *(const f32x4*)(sp + 4);
      float t = ((a0[0] + a0[1]) + (a0[2] + a0[3])) + ((a1[0] + a1[1]) + (a1[2] + a1[3]));
      t += __shfl_xor(t, 16); t += __shfl_xor(t, 32);
      qs = (0.08838834764831845f * 1.4426950408889634f) / sqrtf(t * (1.0f / D) + EPS); }
    bf16x8 qf[4];
    const float* qp = (const float*)(p->ws + WS_QP) + rowq * 512 + xh * 128 + quad * 8;
#pragma unroll
    for (int ks = 0; ks < 4; ++ks) {
        f32x4 s0 = *(const f32x4*)(qp + 32 * ks), s1 = *(const f32x4*)(qp + 32 * ks + 4);
#pragma unroll
        for (int sp = 1; sp < 4; ++sp) { s0 += *(const f32x4*)(qp + (size_t)sp * T * 512 + 32 * ks); s1 += *(const f32x4*)(qp + (size_t)sp * T * 512 + 32 * ks + 4); }
        u32x4 pk; pk.x = pk2(s0[0] * qs, s0[1] * qs); pk.y = pk2(s0[2] * qs, s0[3] * qs); pk.z = pk2(s1[0] * qs, s1[1] * qs); pk.w = pk2(s1[2] * qs, s1[3] * qs);
        qf[ks] = __builtin_bit_cast(bf16x8, pk);
    }
    {
        u32x4 kq[8], vq[8];
#pragma unroll
        for (int i = 0; i < 8; ++i) { const int m = 2 * (tid >> 4) + (i & 1) + 64 * (i >> 1), ch = tid & 15;
            const bf16_t* rowp = kvb + (size_t)(b * 256 + m) * 4096 + l * 1024 + xh * 128 + ch * 8; kq[i] = *(const u32x4*)rowp; vq[i] = *(const u32x4*)(rowp + 512); }
#pragma unroll
        for (int i = 0; i < 8; ++i) { const int m = 2 * (tid >> 4) + (i & 1) + 64 * (i >> 1), ch = tid & 15; *(u32x4*)(Ks + m * 136 + ch * 8) = kq[i]; }
#pragma unroll
        for (int i = 0; i < 8; i += 2) { const int m = 2 * (tid >> 4) + 64 * (i >> 1), ch = tid & 15; vt_store_pair(Vt, ch * 8, m, vq[i], vq[i + 1]); }
    }
    __syncthreads();
    f32x4 oacc[8]; float mx, den;
    attn_compute<128, false>(Ks, Vt, qf, 0, quad, fr, nullptr, 0, oacc, mx, den);
    const float inv = 1.0f / den;
    bf16_t* ox = (bf16_t*)(p->ws + WS_OX) + rowq * 512 + xh * 128 + quad * 4;
#pragma unroll
    for (int dt = 0; dt < 8; ++dt) { u32x2 o; o.x = pk2(oacc[dt][0] * inv, oacc[dt][1] * inv); o.y = pk2(oacc[dt][2] * inv, oacc[dt][3] * inv); *(u32x2*)(ox + 16 * dt) = o; }
    __syncthreads();
}

typedef float f32x2 __attribute__((ext_vector_type(2)));
struct S5Lane { float ar, ai; f32x2 bb[16]; };
__device__ __forceinline__ void s5_lane_params(PP p, int l, int g, int n, S5Lane& q) {
    const int gi = (l * 32 + g) * 64 + n;
    const float lr = p->in[6][gi], li = p->in[7][gi], dt = expf(p->in[8][l * 32 + g]);
    const float mag = expf(lr * dt);
    float sn, cs; sincosf(li * dt, &sn, &cs);
    q.ar = mag * cs; q.ai = mag * sn;
    const float den = lr * lr + li * li, nr = q.ar - 1.0f, ni = q.ai;
    const float fr_ = (nr * lr + ni * li) / den, fi_ = (ni * lr - nr * li) / den;
    const f32x4* bre = (const f32x4*)(p->in[9] + (size_t)gi * 16); const f32x4* bim = (const f32x4*)(p->in[10] + (size_t)gi * 16);
#pragma unroll
    for (int c4 = 0; c4 < 4; ++c4) { const f32x4 br = bre[c4], bi = bim[c4];
#pragma unroll
        for (int e = 0; e < 4; ++e) { q.bb[c4 * 4 + e] = (f32x2){fr_ * br[e] - fi_ * bi[e], fr_ * bi[e] + fi_ * br[e]}; } }
}
__device__ __forceinline__ void s5_load_u(const bf16_t* proj, int b, int l0, int g, float* ub, int lane) {
    const bf16_t* src = proj + PJ_UA + (size_t)(b * SEQ + l0 + lane) * 512 + g * 16;
    const u32x4 a = *(const u32x4*)src, c = *(const u32x4*)(src + 8);
    f32x4* d = (f32x4*)(ub + lane * 16);
    d[0] = (f32x4){__uint_as_float(a.x << 16), __uint_as_float(a.x & 0xffff0000u), __uint_as_float(a.y << 16), __uint_as_float(a.y & 0xffff0000u)};
    d[1] = (f32x4){__uint_as_float(a.z << 16), __uint_as_float(a.z & 0xffff0000u), __uint_as_float(a.w << 16), __uint_as_float(a.w & 0xffff0000u)};
    d[2] = (f32x4){__uint_as_float(c.x << 16), __uint_as_float(c.x & 0xffff0000u), __uint_as_float(c.y << 16), __uint_as_float(c.y & 0xffff0000u)};
    d[3] = (f32x4){__uint_as_float(c.z << 16), __uint_as_float(c.z & 0xffff0000u), __uint_as_float(c.w << 16), __uint_as_float(c.w & 0xffff0000u)};
}
__device__ __forceinline__ void s5_step(const S5Lane& q, const float* urow, f32x2& x) {
    const f32x4* u4 = (const f32x4*)urow;
    f32x2 b0 = (f32x2){0.f, 0.f}, b1 = b0;
#pragma unroll
    for (int c4 = 0; c4 < 4; ++c4) { const f32x4 uv = u4[c4];
        b0 += q.bb[c4 * 4 + 0] * uv[0]; b1 += q.bb[c4 * 4 + 1] * uv[1]; b0 += q.bb[c4 * 4 + 2] * uv[2]; b1 += q.bb[c4 * 4 + 3] * uv[3]; }
    const f32x2 rot = (f32x2){-x.y, x.x};
    x = (x * q.ar + rot * q.ai) + (b0 + b1);
}
constexpr int S5_BBL = 0, S5_BUL = 4096, S5_XS = 4096 + 65536;
struct S5Frag { bf16x8 bfr[8]; };
__device__ __forceinline__ void s5_write_bbl(const S5Lane& q, bf16_t* bbL, int lane) {
    u32x4 re0, re1, im0, im1;
    re0.x = pk2(q.bb[0].x, q.bb[1].x); re0.y = pk2(q.bb[2].x, q.bb[3].x); re0.z = pk2(q.bb[4].x, q.bb[5].x); re0.w = pk2(q.bb[6].x, q.bb[7].x);
    re1.x = pk2(q.bb[8].x, q.bb[9].x); re1.y = pk2(q.bb[10].x, q.bb[11].x); re1.z = pk2(q.bb[12].x, q.bb[13].x); re1.w = pk2(q.bb[14].x, q.bb[15].x);
    im0.x = pk2(q.bb[0].y, q.bb[1].y); im0.y = pk2(q.bb[2].y, q.bb[3].y); im0.z = pk2(q.bb[4].y, q.bb[5].y); im0.w = pk2(q.bb[6].y, q.bb[7].y);
    im1.x = pk2(q.bb[8].y, q.bb[9].y); im1.y = pk2(q.bb[10].y, q.bb[11].y); im1.z = pk2(q.bb[12].y, q.bb[13].y); im1.w = pk2(q.bb[14].y, q.bb[15].y);
    *(u32x4*)(bbL + lane * 16) = re0; *(u32x4*)(bbL + lane * 16 + 8) = re1;
    *(u32x4*)(bbL + (64 + lane) * 16) = im0; *(u32x4*)(bbL + (64 + lane) * 16 + 8) = im1;
}
__device__ __forceinline__ void s5_load_frags(const bf16_t* bbL, S5Frag& f, int lane) {
    const int jj = lane & 15, quad = lane >> 4;
#pragma unroll
    for (int nt = 0; nt < 8; ++nt) { u32x4 v = (u32x4){0u, 0u, 0u, 0u}; if (quad < 2) v = *(const u32x4*)(bbL + (16 * nt + jj) * 16 + quad * 8); f.bfr[nt] = __builtin_bit_cast(bf16x8, v); }
}
__device__ __forceinline__ bf16x8 s5_ufrag(const bf16_t* proj, size_t row, int g, int lane) {
    const int tt = lane & 15, quad = lane >> 4;
    u32x4 v = (u32x4){0u, 0u, 0u, 0u};
    if (quad < 2) v = *(const u32x4*)(proj + PJ_UA + (row + tt) * 512 + g * 16 + quad * 8);
    return __builtin_bit_cast(bf16x8, v);
}
__device__ __forceinline__ void s5_bu16(const S5Frag& f, const bf16x8 uf, float* buL, int lane) {
    const int jj = lane & 15, quad = lane >> 4;
#pragma unroll
    for (int nt = 0; nt < 4; ++nt) {
        const f32x4 z = (f32x4){0.f, 0.f, 0.f, 0.f};
        const f32x4 dre = __builtin_amdgcn_mfma_f32_16x16x32_bf16(uf, f.bfr[nt], z, 0, 0, 0);
        const f32x4 dim = __builtin_amdgcn_mfma_f32_16x16x32_bf16(uf, f.bfr[nt + 4], z, 0, 0, 0);
#pragma unroll
        for (int r = 0; r < 4; ++r) *(f32x2*)(buL + ((4 * quad + r) * 64 + 16 * nt + jj) * 2) = (f32x2){dre[r], dim[r]};
    }
}
__device__ __forceinline__ void s5_rec(const S5Lane& q, f32x2 bu, f32x2& x) { const f32x2 rot = (f32x2){-x.y, x.x}; x = (x * q.ar + rot * q.ai) + bu; }

__device__ __forceinline__ void s5_pass1_item(PP p, unsigned char* shm, int item, int l) {
    const int tid = tid_fresh(), w = tid >> 6, lane = tid & 63;
    const int b = item / 128, g = (item / 4) % 32, jg = item % 4, j = jg * 8 + w;
    const bf16_t* proj = (const bf16_t*)(p->ws + WS_PROJ);
    bf16_t* bbL = (bf16_t*)(shm + S5_BBL); float* buL = (float*)(shm + S5_BUL) + w * 2048;
    S5Lane q; s5_lane_params(p, l, g, lane, q);
    const size_t row0 = (size_t)b * SEQ + j * 64;
    bf16x8 uf[4];
#pragma unroll
    for (int sc = 0; sc < 4; ++sc) uf[sc] = s5_ufrag(proj, row0 + sc * 16, g, lane);
    s5_write_bbl(q, bbL, lane);
    __syncthreads();
    S5Frag f; s5_load_frags(bbL, f, lane);
    f32x2 x = (f32x2){0.f, 0.f};
#pragma unroll
    for (int sc = 0; sc < 4; ++sc) {
        s5_bu16(f, uf[sc], buL, lane);
        __syncthreads();
#pragma unroll
        for (int t = 0; t < 16; ++t) s5_rec(q, *(const f32x2*)(buL + (t * 64 + lane) * 2), x);
        __syncthreads();
    }
    *(f32x2*)((float*)(p->ws + WS_CARRY) + ((size_t)((b * 32 + g) * 32 + j) * 64 + lane) * 2) = x;
}
__device__ __forceinline__ void s5_pass2_item(PP p, unsigned char* shm, int item, int l) {
    const int tid = tid_fresh(), w = tid >> 6, lane = tid & 63;
    const int b = item / 128, g = (item / 4) % 32, jg = item % 4, j = jg * 8 + w;
    const bf16_t* proj = (const bf16_t*)(p->ws + WS_PROJ);
    bf16_t* bbL = (bf16_t*)(shm + S5_BBL); float* buL = (float*)(shm + S5_BUL) + w * 2048; float* xs = (float*)(shm + S5_XS) + w * (16 * 132);
    const int cc = lane & 15, quad = lane >> 4;
    float cmr[32];
    { const float* src = ((quad < 2) ? p->in[11] : p->in[12]) + ((size_t)(l * 32 + g) * 16 + cc) * 64 + (quad & 1) * 32;
      const float sgn = (quad < 2) ? 1.0f : -1.0f;
#pragma unroll
      for (int i = 0; i < 8; ++i) { const f32x4 v = *(const f32x4*)(src + 4 * i); cmr[4 * i] = v[0] * sgn; cmr[4 * i + 1] = v[1] * sgn; cmr[4 * i + 2] = v[2] * sgn; cmr[4 * i + 3] = v[3] * sgn; } }
    S5Lane q; s5_lane_params(p, l, g, lane, q);
    const size_t row0 = (size_t)b * SEQ + j * 64;
    bf16x8 uf[4];
#pragma unroll
    for (int sc = 0; sc < 4; ++sc) uf[sc] = s5_ufrag(proj, row0 + sc * 16, g, lane);
    s5_write_bbl(q, bbL, lane);
    float pr = q.ar, pi = q.ai;
#pragma unroll
    for (int s = 0; s < 6; ++s) { const float nr = pr * pr - pi * pi, ni = 2.f * pr * pi; pr = nr; pi = ni; }
    f32x2 x = (f32x2){0.f, 0.f};
    const f32x2* carry = (const f32x2*)((const float*)(p->ws + WS_CARRY) + ((size_t)((b * 32 + g) * 32) * 64 + lane) * 2);
    for (int i0 = 0; i0 < j; i0 += 8) {
        f32x2 sv[8];
#pragma unroll
        for (int e = 0; e < 8; ++e) sv[e] = (i0 + e < j) ? carry[(size_t)(i0 + e) * 64] : (f32x2){0.f, 0.f};
#pragma unroll
        for (int e = 0; e < 8; ++e) if (i0 + e < j) { const f32x2 rot = (f32x2){-x.y, x.x}; x = (x * pr + rot * pi) + sv[e]; }
    }
    __syncthreads();
    S5Frag f; s5_load_frags(bbL, f, lane);
    const float dsk = p->in[13][(size_t)l * 512 + g * 16 + cc];
    bf16_t* Gout = (bf16_t*)(p->ws + WS_GPH);
    for (int sc = 0; sc < 4; ++sc) {
        s5_bu16(f, uf[sc], buL, lane);
        __syncthreads();
#pragma unroll
        for (int t = 0; t < 16; ++t) { s5_rec(q, *(const f32x2*)(buL + (t * 64 + lane) * 2), x); xs[t * 132 + lane] = x.x; xs[t * 132 + 64 + lane] = x.y; }
        __syncthreads();
        f32x4 y0 = (f32x4){0.f, 0.f, 0.f, 0.f}, y1 = y0;
        const f32x4* xrow = (const f32x4*)(xs + cc * 132 + quad * 32);
#pragma unroll
        for (int i = 0; i < 8; ++i) { const f32x4 xv = xrow[i];
            y0 = __builtin_amdgcn_mfma_f32_16x16x4f32(xv[0], cmr[4 * i + 0], y0, 0, 0, 0);
            y1 = __builtin_amdgcn_mfma_f32_16x16x4f32(xv[1], cmr[4 * i + 1], y1, 0, 0, 0);
            y0 = __builtin_amdgcn_mfma_f32_16x16x4f32(xv[2], cmr[4 * i + 2], y0, 0, 0, 0);
            y1 = __builtin_amdgcn_mfma_f32_16x16x4f32(xv[3], cmr[4 * i + 3], y1, 0, 0, 0); }
        const f32x4 y = y0 + y1;
#pragma unroll
        for (int r = 0; r < 4; ++r) { const int tl = sc * 16 + quad * 4 + r;
            const float v = y[r] + dsk * bf2f(proj[PJ_UA + (row0 + tl) * 512 + g * 16 + cc]);
            const float z = 0.7978845608028654f * (v + 0.044715f * v * v * v);
            const float th = 1.0f - 2.0f / (__expf(2.0f * z) + 1.0f);
            Gout[(row0 + tl) * 512 + g * 16 + cc] = f2bf(0.5f * v * (1.0f + th)); }
        __syncthreads();
    }
}

__device__ __forceinline__ void pool_item(PP p, unsigned char* shm, int item) {
    const bf16_t* proj = (const bf16_t*)(p->ws + WS_PROJ);
    bf16_t* P = (bf16_t*)(p->ws + WS_GPH) + (size_t)T * 512;
    float* ut = (float*)shm;
    const int tid = tid_fresh(), ch = tid, gi = ch >> 7, w = 2 << gi;
    const int row0 = item * 32, b = row0 / SEQ, l0 = row0 % SEQ;
#pragma unroll
    for (int i = 0; i < 6; ++i) {
        const int ci = tid + i * 512, rr = ci >> 6, c8 = ci & 63, ll = l0 - 16 + rr;
        u32x4 v = (u32x4){0u, 0u, 0u, 0u};
        if (ll >= 0) v = *(const u32x4*)(proj + PJ_UB + (size_t)(b * SEQ + ll) * 512 + c8 * 8);
        f32x4* d = (f32x4*)(ut + rr * 512 + c8 * 8);
        d[0] = (f32x4){__uint_as_float(v.x << 16), __uint_as_float(v.x & 0xffff0000u), __uint_as_float(v.y << 16), __uint_as_float(v.y & 0xffff0000u)};
        d[1] = (f32x4){__uint_as_float(v.z << 16), __uint_as_float(v.z & 0xffff0000u), __uint_as_float(v.w << 16), __uint_as_float(v.w & 0xffff0000u)};
    }
    __syncthreads();
    float sum = 0.f;
    for (int s = 1; s <= w; ++s) sum += ut[(16 - s) * 512 + ch];
    for (int t = 0; t < 32; ++t) {
        const int l = l0 + t;
        const float cur = ut[(16 + t) * 512 + ch];
        sum += cur - ut[(16 + t - w) * 512 + ch];
        const int cnt = (l + 1 < w) ? (l + 1) : w;
        P[(size_t)(row0 + t) * 512 + ch] = f2bf(sum / (float)cnt - cur);
    }
    __syncthreads();
}
constexpr int CV_HG = 0, CV_CV = 46 * 512 * 4;
__device__ __forceinline__ void conv_item(PP p, unsigned char* shm, int item, int l) {
    const bf16_t* proj = (const bf16_t*)(p->ws + WS_PROJ);
    bf16_t* HC = (bf16_t*)(p->ws + WS_GPH) + (size_t)2 * T * 512;
    float* hg = (float*)(shm + CV_HG); float* cv = (float*)(shm + CV_CV);
    const int tid = tid_fresh(), c = tid, row0 = item * 16, b = row0 / SEQ, l0 = row0 % SEQ;
#pragma unroll
    for (int i = 0; i < 6; ++i) {
        const int ci = tid + i * 512, rr = ci >> 6, c8 = ci & 63, ll = l0 - 30 + rr;
        if (rr < 46) {
            u32x4 v = (u32x4){0u, 0u, 0u, 0u}, gt = v;
            if (ll >= 0) { const bf16_t* rp = proj + PJ_UC + (size_t)(b * SEQ + ll) * 1024 + c8 * 8; v = *(const u32x4*)rp; gt = *(const u32x4*)(rp + 512); }
            float vf[8], gf[8];
            vf[0] = __uint_as_float(v.x << 16); vf[1] = __uint_as_float(v.x & 0xffff0000u); vf[2] = __uint_as_float(v.y << 16); vf[3] = __uint_as_float(v.y & 0xffff0000u);
            vf[4] = __uint_as_float(v.z << 16); vf[5] = __uint_as_float(v.z & 0xffff0000u); vf[6] = __uint_as_float(v.w << 16); vf[7] = __uint_as_float(v.w & 0xffff0000u);
            gf[0] = __uint_as_float(gt.x << 16); gf[1] = __uint_as_float(gt.x & 0xffff0000u); gf[2] = __uint_as_float(gt.y << 16); gf[3] = __uint_as_float(gt.y & 0xffff0000u);
            gf[4] = __uint_as_float(gt.z << 16); gf[5] = __uint_as_float(gt.z & 0xffff0000u); gf[6] = __uint_as_float(gt.w << 16); gf[7] = __uint_as_float(gt.w & 0xffff0000u);
            f32x4* d = (f32x4*)(hg + rr * 512 + c8 * 8);
            d[0] = (f32x4){vf[0] * sigmoidf_(gf[0]), vf[1] * sigmoidf_(gf[1]), vf[2] * sigmoidf_(gf[2]), vf[3] * sigmoidf_(gf[3])};
            d[1] = (f32x4){vf[4] * sigmoidf_(gf[4]), vf[5] * sigmoidf_(gf[5]), vf[6] * sigmoidf_(gf[6]), vf[7] * sigmoidf_(gf[7])};
        }
    }
    float wdw[31];
#pragma unroll
    for (int j = 0; j < 31; ++j) wdw[j] = p->in[17][((size_t)l * 31 + j) * 512 + c];
    const float bias = p->in[18][(size_t)l * 512 + c];
    __syncthreads();
    for (int t = 0; t < 16; ++t) {
        float acc = bias, acc2 = 0.f;
#pragma unroll
        for (int j = 0; j < 30; j += 2) { acc += wdw[j] * hg[(t + j) * 512 + c]; acc2 += wdw[j + 1] * hg[(t + j + 1) * 512 + c]; }
        acc += wdw[30] * hg[(t + 30) * 512 + c];
        cv[t * 512 + c] = acc + acc2;
    }
    __syncthreads();
    const int w = c >> 6, lane = c & 63;
    for (int tk = 0; tk < 2; ++tk) {
        const int t = w * 2 + tk;
        const f32x4 v0 = *(const f32x4*)(cv + t * 512 + lane * 8), v1 = *(const f32x4*)(cv + t * 512 + lane * 8 + 4);
        float s = v0[0] + v0[1] + v0[2] + v0[3] + v1[0] + v1[1] + v1[2] + v1[3];
        const float mean = wave_sum(s) * (1.0f / 512.0f);
        const f32x4 d0 = v0 - mean, d1 = v1 - mean;
        float s2 = d0[0] * d0[0] + d0[1] * d0[1] + d0[2] * d0[2] + d0[3] * d0[3] + d1[0] * d1[0] + d1[1] * d1[1] + d1[2] * d1[2] + d1[3] * d1[3];
        const float rstd = 1.0f / sqrtf(wave_sum(s2) * (1.0f / 512.0f) + EPS);
        const f32x4 g0 = *(const f32x4*)(p->in[19] + (size_t)l * 512 + lane * 8), g1 = *(const f32x4*)(p->in[19] + (size_t)l * 512 + lane * 8 + 4);
        const f32x4 b0 = *(const f32x4*)(p->in[20] + (size_t)l * 512 + lane * 8), b1 = *(const f32x4*)(p->in[20] + (size_t)l * 512 + lane * 8 + 4);
        float o[8];
#pragma unroll
        for (int e = 0; e < 4; ++e) { const float y0 = d0[e] * rstd * g0[e] + b0[e], y1 = d1[e] * rstd * g1[e] + b1[e]; o[e] = y0 * sigmoidf_(y0); o[4 + e] = y1 * sigmoidf_(y1); }
        u32x4 ov; ov.x = pk2(o[0], o[1]); ov.y = pk2(o[2], o[3]); ov.z = pk2(o[4], o[5]); ov.w = pk2(o[6], o[7]);
        *(u32x4*)(HC + (size_t)(row0 + t) * 512 + lane * 8) = ov;
    }
    __syncthreads();
}

__device__ __forceinline__ void unpack8(const u32x4 v, float (&f)[8]) {
    f[0] = __uint_as_float(v.x << 16); f[1] = __uint_as_float(v.x & 0xffff0000u); f[2] = __uint_as_float(v.y << 16); f[3] = __uint_as_float(v.y & 0xffff0000u);
    f[4] = __uint_as_float(v.z << 16); f[5] = __uint_as_float(v.z & 0xffff0000u); f[6] = __uint_as_float(v.w << 16); f[7] = __uint_as_float(v.w & 0xffff0000u);
}
struct CbTok { u32x4 ob[3]; float ls[3]; };
__device__ __forceinline__ void cb_load(CbTok& k, const bf16_t* ob, const float* lse, int t, int lane) {
#pragma unroll
    for (int g = 0; g < 3; ++g) { k.ob[g] = *(const u32x4*)(ob + ((size_t)g * T + t) * 512 + lane * 8); k.ls[g] = lse[((size_t)g * T + t) * 8 + (lane >> 3)]; }
}
__device__ __forceinline__ void phase_combine(PP p) {
    const int lane = tid_fresh() & 63, gw = bid_fresh() * 8 + (tid_fresh() >> 6), NGW = gridDim.x * 8;
    const bf16_t* ob = (const bf16_t*)(p->ws + WS_OB); const float* lse = (const float*)(p->ws + WS_LSE);
    bf16_t* y = (bf16_t*)(p->ws + WS_YN); float* ssg = (float*)(p->ws + WS_SSG);
    CbTok cur, nxt;
    if (gw < T) cb_load(cur, ob, lse, gw, lane);
    for (int t = gw; t < T; t += NGW) {
        const bool more = (t + NGW) < T;
        if (more) cb_load(nxt, ob, lse, t + NGW, lane);
        const float lm = fmaxf(cur.ls[0], fmaxf(cur.ls[1], cur.ls[2]));
        const float e0 = __expf(cur.ls[0] - lm), e1 = __expf(cur.ls[1] - lm), e2 = __expf(cur.ls[2] - lm), ei = 1.0f / (e0 + e1 + e2);
        float o0[8], o1[8], o2[8], v[8];
        unpack8(cur.ob[0], o0); unpack8(cur.ob[1], o1); unpack8(cur.ob[2], o2);
        float sq = 0.f;
#pragma unroll
        for (int e = 0; e < 8; ++e) { v[e] = (e0 * o0[e] + e1 * o1[e] + e2 * o2[e]) * ei; sq += v[e] * v[e]; }
        sq = wave_sum(sq);
        u32x4 ov; ov.x = pk2(v[0], v[1]); ov.y = pk2(v[2], v[3]); ov.z = pk2(v[4], v[5]); ov.w = pk2(v[6], v[7]);
        *(u32x4*)(y + (size_t)t * D + 1536 + lane * 8) = ov;
        if (lane < 8) ssg[(size_t)t * 32 + 24 + lane] = (lane == 0) ? sq : 0.f;
        if (more) cur = nxt;
    }
}

__global__ void __launch_bounds__(512, 2) hymba_fwd(Params p_unused) {
    extern __shared__ __attribute__((aligned(16))) unsigned char shm[];
    cg::grid_group grid = cg::this_grid();
    volatile LAS unsigned* xst = (volatile LAS unsigned*)(LAS unsigned char*)(shm + LDS_BYTES - 16);
    if (threadIdx.x == 0) { xst[0] = 0u; xst[1] = 0u; }
    __syncthreads();
    XcdBarrier xbar;
    { PP p = get_pp(); unsigned* barw = (unsigned*)(p->ws + WS_BAR); xbar = xcd_barrier_post(barw, xst);
      if (p->ws == nullptr) grid.sync(); }

    for (int rep = 0; rep < P0_REPS; ++rep) phase0(get_pp(), shm);
    GSYNC();

    for (int l = 0; l < N_LAYERS_RUN; ++l) {
        if (l == 0) { PP p = get_pp(); unsigned char* ws = p->ws;
          pg8::WinKvOrder S; S.so.init(T, INW, (int)gridDim.x, (int)bid_fresh()); S.a_delta = WS_MEMN - WS_XN; S.b_delta = WS_WKV - WS_WIN;
          pg8::Gemm g{(const bf16_t*)(ws + WS_XN), (const bf16_t*)(ws + WS_WIN), T, INW, D, D};
          pg8::EpiWinKv E{{(bf16_t*)(ws + WS_PROJ), (const float*)(ws + WS_SS)}, {(bf16_t*)(ws + WS_KV), 4096, 1.0f, nullptr}};
          pg8::gemm_phase<pg8::EpiWinKv, pg8::WinKvOrder>((PG8_LAS unsigned char*)shm, g, S, E); }
        else { PP p = get_pp(); unsigned char* ws = p->ws;
          pg8::EpiWin E{(bf16_t*)(ws + WS_PROJ), (const float*)(ws + WS_SS) + (size_t)(3 * l) * T * 32};
          run_gemm(shm, (const bf16_t*)(ws + WS_XN), (const bf16_t*)(ws + WS_WIN) + (size_t)l * INW * D, T, INW, D, E); }
        GSYNC();
        for (int rep = 0; rep < MIX_REPS; ++rep) {
            dil_attn_units(shm, bid_fresh(), (int)gridDim.x);
            int it0 = bid_fresh(); while (it0 < 1536) it0 += gridDim.x;
            for (int it = it0; it < 1536 + 512 + 256 + 512; it += gridDim.x) {
                PP p = get_pp();
                if (it < 2048) s5_pass1_item(p, shm, it - 1536, l);
                else if (it < 2304) pool_item(p, shm, it - 2048);
                else conv_item(p, shm, it - 2304, l);
            }
        }
        GSYNC();
        for (int rep = 0; rep < P3_REPS; ++rep) for (int it = bid_fresh(); it < 512; it += gridDim.x) s5_pass2_item(get_pp(), shm, it, l);
        for (int rep = 0; rep < NORM_REPS; ++rep) phase_combine(get_pp());
        GSYNC();
        { PP p = get_pp(); unsigned char* ws = p->ws;
          pg8::SmallOrder S{(int)gridDim.x, (int)bid_fresh()};
          pg8::Gemm g{(const bf16_t*)(ws + WS_GPH), (const bf16_t*)(ws + WS_WSM) + (size_t)l * 1536 * 512, T, 1536, 512, 512};
          pg8::EpiSmall E{(bf16_t*)(ws + WS_YN), (const bf16_t*)(ws + WS_GPH), p->in[16] + (size_t)l * 512, (float*)(ws + WS_SSG)};
          pg8::gemm_phase<pg8::EpiSmall, pg8::SmallOrder>((PG8_LAS unsigned char*)shm, g, S, E); }
        GSYNC();
        { PP p = get_pp(); unsigned char* ws = p->ws; float* hbuf = (float*)(ws + WS_H);
          pg8::EpiRes<4> E{(l == 0) ? p->in[0] : hbuf, hbuf, (bf16_t*)(ws + WS_XN), (float*)(ws + WS_SS) + (size_t)(1 + 3 * l) * T * 32, nullptr};
          pg8::StaticOrder S; S.init(T, D, (int)gridDim.x, (int)bid_fresh());
          pg8::Gemm g{(const bf16_t*)(ws + WS_YN), (const bf16_t*)(ws + WS_WOUT) + (size_t)l * D * D, T, D, D, D};
          pg8::gemm_phase<pg8::EpiRes<4>, pg8::StaticOrder, true, true, true>((PG8_LAS unsigned char*)shm, g, S, E, (const float*)(ws + WS_SSG)); }
        GSYNC();
        { PP p = get_pp(); unsigned char* ws = p->ws;
          pg8::SplitOrder S{(int)gridDim.x, (int)bid_fresh()};
          pg8::Gemm g{(const bf16_t*)(ws + WS_XN), (const bf16_t*)(ws + WS_WXQ) + (size_t)l * 512 * D, T, 512, D, 512};
          pg8::EpiPart E{(float*)(ws + WS_QP)};
          pg8::gemm_phase<pg8::EpiPart, pg8::SplitOrder>((PG8_LAS unsigned char*)shm, g, S, E); }
        GSYNC();
        for (int rep = 0; rep < P9_REPS; ++rep) for (int it = bid_fresh(); it < 256; it += gridDim.x) cross_attn_unit(get_pp(), shm, it, l);
        GSYNC();
        { PP p = get_pp(); unsigned char* ws = p->ws; float* hbuf = (float*)(ws + WS_H);
          pg8::EpiRes<4> E{hbuf, hbuf, (bf16_t*)(ws + WS_XN), (float*)(ws + WS_SS) + (size_t)(2 + 3 * l) * T * 32, nullptr};
          run_gemm(shm, (const bf16_t*)(ws + WS_OX), (const bf16_t*)(ws + WS_WXO) + (size_t)l * D * 512, T, D, 512, E); }
        GSYNC();
        { PP p = get_pp(); unsigned char* ws = p->ws;
          pg8::EpiBf16<1> E{(bf16_t*)(ws + WS_ACT), DFF, 1.0f, nullptr};
          run_gemm(shm, (const bf16_t*)(ws + WS_XN), (const bf16_t*)(ws + WS_WUP) + (size_t)l * DFF * D, T, DFF, D, E); }
        GSYNC();
        { PP p = get_pp(); unsigned char* ws = p->ws; float* hbuf = (float*)(ws + WS_H);
          pg8::EpiRes<2> E{hbuf, hbuf, (bf16_t*)(ws + WS_XN), (float*)(ws + WS_SS) + (size_t)(3 + 3 * l) * T * 32, (const float*)(ws + WS_SS) + (size_t)(2 + 3 * l) * T * 32};
          run_gemm(shm, (const bf16_t*)(ws + WS_ACT), (const bf16_t*)(ws + WS_WDN) + (size_t)l * D * DFF, T, D, DFF, E); }
        GSYNC();
    }
    {
        PP p = get_pp(); const float* hbuf = (const float*)(p->ws + WS_H); const float* gf = p->in[32]; float* outp = p->out;
        const int lane = tid_fresh() & 63, gw = bid_fresh() * 8 + (tid_fresh() >> 6), NGW = gridDim.x * 8;
        for (int r = gw; r < T; r += NGW) rms_row_f32(hbuf + (size_t)r * D, gf, outp + (size_t)r * D, lane);
    }
}

extern "C" void kernel_launch(void* const* d_in, const int* in_sizes, int n_in, void* d_out, int out_size, void* d_ws, size_t ws_size, hipStream_t stream) {
    static int grid_blocks = 0;
    if (grid_blocks == 0) {
        if (n_in != 33 || ws_size < WS_END) { fprintf(stderr, "kernel_launch: unexpected n_in %d or ws_size %zu (need %zu)\n", n_in, ws_size, (size_t)WS_END); grid_blocks = -1; return; }
        int dev = 0, cus = 0, per_cu = 0;
        (void)hipGetDevice(&dev);
        (void)hipDeviceGetAttribute(&cus, hipDeviceAttributeMultiprocessorCount, dev);
        if (hipFuncSetAttribute((const void*)hymba_fwd, hipFuncAttributeMaxDynamicSharedMemorySize, LDS_BYTES) != hipSuccess) { fprintf(stderr, "kernel_launch: hipFuncSetAttribute failed\n"); }
        if (hipOccupancyMaxActiveBlocksPerMultiprocessor(&per_cu, (const void*)hymba_fwd, 512, LDS_BYTES) != hipSuccess || per_cu < 1) { fprintf(stderr, "kernel_launch: occupancy query says %d\n", per_cu); per_cu = 1; }
        (void)hipGetLastError();
        grid_blocks = cus * 1;
    }
    if (grid_blocks < 0) return;
    (void)hipMemsetAsync((unsigned char*)d_ws + WS_BAR, 0, 16384, stream);
    Params p{};
    for (int i = 0; i < 33; ++i) p.in[i] = (const float*)d_in[i];
    p.out = (float*)d_out; p.ws = (unsigned char*)d_ws;
    void* args[] = {&p};
    hipError_t e = hipLaunchCooperativeKernel((const void*)hymba_fwd, dim3(grid_blocks), dim3(512), args, LDS_BYTES, stream);
    if (e != hipSuccess) fprintf(stderr, "cooperative launch failed: %s (grid %d)\n", hipGetErrorString(e), grid_blocks);
}
```

```cpp
#include <hip/hip_runtime.h>
#include <hip/hip_cooperative_groups.h>
#include <cstdio>
#include <cstdint>
namespace cg = cooperative_groups;

#ifndef N_LAYERS_RUN
#define N_LAYERS_RUN 4
#endif
#ifndef GEMM_REPS
#define GEMM_REPS 1
#endif
#ifndef MIX_REPS
#define MIX_REPS 1
#endif
#ifndef NORM_REPS
#define NORM_REPS 1
#endif
#ifndef P3_REPS
#define P3_REPS 1
#endif
#ifndef P9_REPS
#define P9_REPS 1
#endif
#ifndef SYNC_REPS
#define SYNC_REPS 1
#endif
#define GSYNC() do { for (int _r = 0; _r < SYNC_REPS; ++_r) xcd_barrier(xbar); } while (0)
#ifndef P0_REPS
#define P0_REPS 1
#endif

typedef unsigned short bf16_t;
typedef short bf16x8 __attribute__((ext_vector_type(8)));
typedef short s16x4 __attribute__((ext_vector_type(4)));
typedef float f32x4 __attribute__((ext_vector_type(4)));
typedef unsigned u32x4 __attribute__((ext_vector_type(4)));
typedef unsigned u32x2 __attribute__((ext_vector_type(2)));

constexpr int T = 8192, D = 2048, SEQ = 2048, INW = 3584, DFF = 8192, DEPTH = 4;
constexpr float EPS = 1e-6f;

constexpr size_t SZ_WIN = (size_t)INW * D * 2, SZ_WOUT = (size_t)D * D * 2, SZ_WXQ = (size_t)512 * D * 2, SZ_WXO = (size_t)D * 512 * 2,
                 SZ_WUP = (size_t)DFF * D * 2, SZ_WDN = (size_t)D * DFF * 2, SZ_WSM = (size_t)1536 * 512 * 2;
constexpr size_t WS_WIN = 0;
constexpr size_t WS_WOUT = WS_WIN + 4 * SZ_WIN;
constexpr size_t WS_WXQ = WS_WOUT + 4 * SZ_WOUT;
constexpr size_t WS_WKV = WS_WXQ + 4 * SZ_WXQ;
constexpr size_t WS_WXO = WS_WKV + (size_t)4096 * D * 2;
constexpr size_t WS_WUP = WS_WXO + 4 * SZ_WXO;
constexpr size_t WS_WDN = WS_WUP + 4 * SZ_WUP;
constexpr size_t WS_WSM = WS_WDN + 4 * SZ_WDN;
constexpr size_t WS_H = WS_WSM + 4 * SZ_WSM;
constexpr size_t WS_XN = WS_H + (size_t)T * D * 4;
constexpr size_t WS_PROJ = WS_XN + (size_t)T * D * 2;
constexpr size_t PJ_UA = 0, PJ_UB = (size_t)T * 512, PJ_UC = (size_t)2 * T * 512, PJ_QKV = (size_t)T * 2048;
constexpr size_t WS_GPH = WS_PROJ + (size_t)T * INW * 2;
constexpr size_t WS_YCAT = WS_GPH + (size_t)3 * T * 512 * 2;
constexpr size_t WS_OB = WS_YCAT + (size_t)T * 1536 * 2;
constexpr size_t WS_LSE = WS_OB + (size_t)3 * T * 512 * 2;
constexpr size_t WS_YN = WS_LSE + (size_t)3 * T * 8 * 4;
constexpr size_t WS_QX = WS_YN + (size_t)T * D * 2;
constexpr size_t WS_OX = WS_QX + (size_t)T * 512 * 2;
constexpr size_t WS_KV = WS_OX + (size_t)T * 512 * 2;
constexpr size_t WS_MEMN = WS_KV + (size_t)1024 * 4096 * 2;
constexpr size_t WS_ACT = WS_MEMN + (size_t)1024 * D * 2;
constexpr size_t WS_CARRY = WS_ACT + (size_t)T * DFF * 2;
constexpr size_t WS_DUMMY = WS_CARRY + (size_t)128 * 32 * 64 * 2 * 4;
constexpr size_t WS_BAR = WS_DUMMY + (size_t)T * D * 4;
constexpr size_t WS_SS = WS_BAR + 16384;
constexpr size_t WS_QP = WS_SS + (size_t)13 * T * 32 * 4;
constexpr size_t WS_SSG = WS_QP + (size_t)4 * T * 512 * 4;
constexpr size_t WS_END = WS_SSG + (size_t)T * 32 * 4;

constexpr int LDS_BYTES = 160 * 1024;

struct Params {
    const float* in[33];
    float* out;
    unsigned char* ws;
};

typedef const __attribute__((address_space(4))) Params* PP;
__device__ __forceinline__ PP get_pp() { PP q = (PP)__builtin_amdgcn_kernarg_segment_ptr(); asm volatile("" : "+s"(q)); return q; }
__device__ __forceinline__ int tid_fresh() { int t = threadIdx.x; asm volatile("" : "+v"(t)); return t; }
__device__ __forceinline__ int bid_fresh() { int t = blockIdx.x; asm volatile("" : "+s"(t)); return t; }
__device__ __forceinline__ float bf2f(bf16_t v) { return __uint_as_float(((unsigned)v) << 16); }
__device__ __forceinline__ bf16_t f2bf(float f) { unsigned u = __float_as_uint(f); u += 0x7FFFu + ((u >> 16) & 1u); return (bf16_t)(u >> 16); }
typedef __bf16 hbf16x2 __attribute__((ext_vector_type(2)));
typedef float hf32x2 __attribute__((ext_vector_type(2)));
__device__ __forceinline__ unsigned pk2(float lo, float hi) { const hf32x2 v = {lo, hi}; return __builtin_bit_cast(unsigned, __builtin_convertvector(v, hbf16x2)); }
__device__ __forceinline__ float wave_sum(float v) {
#pragma unroll
    for (int o = 1; o < 64; o <<= 1) v += __shfl_xor(v, o);
    return v;
}
__device__ __forceinline__ float sigmoidf_(float x) { return 1.0f / (1.0f + __expf(-x)); }


#define XB_TMO      128
#define XB_XCNT(j)  (256  + 64 * (j))
#define XB_XSUB(j)  (1280 + 64 * (j))
#define XB_XGEN(j)  (2304 + 64 * (j))
#define XB_TOP      3328
#define XB_TOPGEN   3392
#define XCD_BAR_WORDS 3456
#define XB_SPIN_CAP (1u << 20)
#define LAS __attribute__((address_space(3)))
__device__ __forceinline__ unsigned xb_ld(unsigned* p)              { return __hip_atomic_load(p, __ATOMIC_RELAXED, __HIP_MEMORY_SCOPE_AGENT); }
__device__ __forceinline__ unsigned xb_add(unsigned* p, unsigned v) { return __hip_atomic_fetch_add(p, v, __ATOMIC_RELAXED, __HIP_MEMORY_SCOPE_AGENT); }
__device__ __forceinline__ unsigned xb_xcc_id() { return (unsigned)__builtin_amdgcn_s_getreg((3 << 11) | 20) & 0xFu; }
#define XB_SPIN(cond, bar) do { unsigned _sp = 0; while (cond) { __builtin_amdgcn_s_sleep(1); \
    if ((++_sp & 255u) == 0u) { if (xb_ld(&(bar)[XB_TMO])) break; if (_sp > XB_SPIN_CAP) { atomicAdd(&(bar)[XB_TMO], 1u); break; } } } } while (0)
struct XcdBarrier { unsigned* bar; unsigned x; volatile LAS unsigned* st; };
__device__ __forceinline__ XcdBarrier xcd_barrier_post(unsigned* bar, volatile LAS unsigned* st) {
    XcdBarrier b; b.bar = bar; b.x = xb_xcc_id(); b.st = st;
    if (threadIdx.x == 0) (void)xb_add(&bar[XB_XCNT(b.x)], 1u);
    return b;
}
__device__ __forceinline__ void xcd_barrier_complete(unsigned* bar, unsigned x, unsigned& nloc, unsigned& nx) {
    const unsigned G = gridDim.x * gridDim.y * gridDim.z;
    unsigned sum, cnt, mine, sp = 0u;
    for (;;) {
        sum = 0u; cnt = 0u; mine = 0u;
#pragma unroll
        for (unsigned j = 0; j < 16; ++j) { const unsigned c = xb_ld(&bar[XB_XCNT(j)]); sum += c; cnt += (c > 0u) ? 1u : 0u; mine = (j == x) ? c : mine; }
        if (sum == G) break;
        __builtin_amdgcn_s_sleep(1);
        if ((++sp & 255u) == 0u) { if (xb_ld(&bar[XB_TMO])) break; if (sp > XB_SPIN_CAP) { atomicAdd(&bar[XB_TMO], 1u); break; } }
    }
    nloc = mine > 0u ? mine : 1u; nx = cnt > 0u ? cnt : 1u;
}
__device__ __forceinline__ void xcd_barrier(const XcdBarrier& b) {
    asm volatile("s_waitcnt vmcnt(0)" ::: "memory");
    __syncthreads();
    if (threadIdx.x == 0) {
        unsigned* bar = b.bar;
        __builtin_amdgcn_s_waitcnt(0);
        unsigned nloc = b.st[0], nx = b.st[1];
        if (nloc == 0u) { xcd_barrier_complete(bar, b.x, nloc, nx); b.st[0] = nloc; b.st[1] = nx; }
        const unsigned old = xb_add(&bar[XB_XSUB(b.x)], 1u);
        const unsigned gen = old / nloc;
        if (old + 1u == (gen + 1u) * nloc) {
            __builtin_amdgcn_fence(__ATOMIC_RELEASE, "agent");
            asm volatile("s_waitcnt vmcnt(0)" ::: "memory");
            const unsigned og = xb_add(&bar[XB_TOP], 1u);
            const unsigned tg = og / nx;
            if (og + 1u == (tg + 1u) * nx) xb_add(&bar[XB_TOPGEN], 1u);
            else XB_SPIN(xb_ld(&bar[XB_TOPGEN]) == tg, bar);
            __builtin_amdgcn_fence(__ATOMIC_ACQUIRE, "agent");
            xb_add(&bar[XB_XGEN(b.x)], 1u);
            asm volatile("s_waitcnt vmcnt(0)" ::: "memory");
        } else {
            XB_SPIN(xb_ld(&bar[XB_XGEN(b.x)]) == gen, bar);
            __builtin_amdgcn_fence(__ATOMIC_ACQUIRE, "agent");
            asm volatile("s_waitcnt vmcnt(0)" ::: "memory");
        }
    }
    __syncthreads();
}

namespace pg8 {
#define PG8_LAS __attribute__((address_space(3)))
constexpr int BM = 256, BK = 64, HALF = 128, HTB = HALF * BK * 2, STAGE_BYTES = 8 * HTB, NXCD = 8, WGM = 8;
__host__ __device__ __forceinline__ int lds_byte(int r, int c) { const int st = (r >> 4) * 2 + (c >> 5), rr = r & 15, cc = c & 31, ob = rr * 64 + cc * 2; return st * 1024 + (ob ^ (((ob >> 9) & 1) << 5)); }
__host__ __device__ __forceinline__ void stage_rc(int b, int& R, int& C) { const int st = b / 1024, sb = b % 1024, swz = sb ^ (((sb >> 9) & 1) << 5); R = (st >> 1) * 16 + swz / 64; C = (st & 1) * 32 + (swz % 64) / 2; }
__host__ __device__ __forceinline__ int perm32(int rho) { const int n = rho >> 4, i = rho & 15; return 8 * (i >> 2) + 4 * n + (i & 3); }
struct Unit { int pm, pn; };
struct Gemm { const bf16_t* A; const bf16_t* Bt; int M, N, K; int Kloop; };
struct StaticOrder {
    int nM, nN, nwg, G, c;
    __device__ void init(int M, int N, int G_, int c_) { nM = M / BM; nN = N / BM; nwg = nM * nN; G = G_; c = c_; }
    __device__ bool next(int i, Unit& u) const {
        const long L = (long)i * G + c; if (L >= nwg) return false;
        int wgid = (int)L; { const int q = nwg / NXCD, r = nwg % NXCD, xcd = wgid % NXCD, off = wgid / NXCD; wgid = (xcd < r ? xcd * (q + 1) : r * (q + 1) + (xcd - r) * q) + off; }
        const int nig = WGM * nN, gid = wgid / nig, fm = gid * WGM, gsz = (nM - fm) < WGM ? (nM - fm) : WGM;
        u.pm = fm + ((wgid % nig) % gsz); u.pn = (wgid % nig) / gsz; return true;
    }
    __device__ __forceinline__ size_t a_extra(const Unit&) const { return 0; }
    __device__ __forceinline__ size_t b_extra(const Unit&) const { return 0; }
};
struct SmallOrder {
    int G, c;
    __device__ bool next(int i, Unit& u) const { const int L = i * G + c; if (L >= 192) return false; u.pm = L / 6; u.pn = L % 6; return true; }
    __device__ __forceinline__ size_t a_extra(const Unit& u) const { return (size_t)(u.pn >> 1) * ((size_t)T * 512 * 2); }
    __device__ __forceinline__ size_t b_extra(const Unit&) const { return 0; }
};
struct SplitOrder {
    int G, c;
    __device__ bool next(int i, Unit& u) const { const int L = i * G + c; if (L >= 256) return false; u.pm = L >> 3; u.pn = L & 7; return true; }
    __device__ __forceinline__ size_t a_extra(const Unit& u) const { return (size_t)(u.pn >> 1) * 512 * 2; }
    __device__ __forceinline__ size_t b_extra(const Unit& u) const { return (size_t)(u.pn >> 1) * 512 * 2 - (size_t)(u.pn & ~1) * ((size_t)256 * D * 2); }
};
__device__ __forceinline__ unsigned cvt_pk_bf16(float lo, float hi) { unsigned r; asm volatile("v_cvt_pk_bf16_f32 %0, %1, %2" : "=v"(r) : "v"(lo), "v"(hi)); return r; }

template <int ACT  > struct EpiBf16 {
    static constexpr bool PERM = true;
    bf16_t* O; int ldc; float scale; const float* ss;
    __device__ __forceinline__ void operator()(const f32x4 (&acc)[2][2][4][2], const Unit& u, int wr, int wc, int fr, int fq) const {
        const int row0 = u.pm * BM + wr * 64 + fr, col0 = u.pn * BM + wc * 32 + 8 * fq;
        float rsv[2][4];
        if (ss) {
            f32x4 p0[2][4], p1[2][4];
#pragma unroll
            for (int ai = 0; ai < 2; ++ai)
#pragma unroll
                for (int m = 0; m < 4; ++m) { const float* sp = ss + (size_t)(row0 + ai * HALF + m * 16) * 32 + fq * 8; p0[ai][m] = *(const f32x4*)sp; p1[ai][m] = *(const f32x4*)(sp + 4); }
#pragma unroll
            for (int ai = 0; ai < 2; ++ai)
#pragma unroll
                for (int m = 0; m < 4; ++m) { float t = ((p0[ai][m][0] + p0[ai][m][1]) + (p0[ai][m][2] + p0[ai][m][3])) + ((p1[ai][m][0] + p1[ai][m][1]) + (p1[ai][m][2] + p1[ai][m][3]));
                    t += __shfl_xor(t, 16); t += __shfl_xor(t, 32);
                    rsv[ai][m] = scale / sqrtf(t * (1.0f / D) + EPS); }
        } else {
#pragma unroll
            for (int ai = 0; ai < 2; ++ai)
#pragma unroll
                for (int m = 0; m < 4; ++m) rsv[ai][m] = scale;
        }
#pragma unroll
        for (int ai = 0; ai < 2; ++ai)
#pragma unroll
            for (int m = 0; m < 4; ++m) { const int row = row0 + ai * HALF + m * 16; bf16_t* rowp = O + (size_t)row * ldc + col0;
                const float rs = rsv[ai][m];
#pragma unroll
                for (int bj = 0; bj < 2; ++bj) { f32x4 v0 = acc[ai][bj][m][0] * rs, v1 = acc[ai][bj][m][1] * rs;
                    if (ACT == 1) {
#pragma unroll
                        for (int e = 0; e < 4; ++e) { float a = fmaxf(v0[e], 0.f), b = fmaxf(v1[e], 0.f); v0[e] = a * a; v1[e] = b * b; } }
                    u32x4 o; o.x = cvt_pk_bf16(v0[0], v0[1]); o.y = cvt_pk_bf16(v0[2], v0[3]); o.z = cvt_pk_bf16(v1[0], v1[1]); o.w = cvt_pk_bf16(v1[2], v1[3]);
                    *(u32x4*)(rowp + bj * HALF) = o; } }
    }
};
struct EpiWin {
    static constexpr bool PERM = true;
    bf16_t* P; const float* ss;
    __device__ __forceinline__ void operator()(const f32x4 (&acc)[2][2][4][2], const Unit& u, int wr, int wc, int fr, int fq) const {
        const int row0 = u.pm * BM + wr * 64 + fr;
        float rsv[2][4];
        {
            f32x4 p0[2][4], p1[2][4];
#pragma unroll
            for (int ai = 0; ai < 2; ++ai)
#pragma unroll
                for (int m = 0; m < 4; ++m) { const float* sp = ss + (size_t)(row0 + ai * HALF + m * 16) * 32 + fq * 8; p0[ai][m] = *(const f32x4*)sp; p1[ai][m] = *(const f32x4*)(sp + 4); }
#pragma unroll
            for (int ai = 0; ai < 2; ++ai)
#pragma unroll
                for (int m = 0; m < 4; ++m) { float t = ((p0[ai][m][0] + p0[ai][m][1]) + (p0[ai][m][2] + p0[ai][m][3])) + ((p1[ai][m][0] + p1[ai][m][1]) + (p1[ai][m][2] + p1[ai][m][3]));
                    t += __shfl_xor(t, 16); t += __shfl_xor(t, 32);
                    rsv[ai][m] = 1.0f / sqrtf(t * (1.0f / D) + EPS); }
        }
#pragma unroll
        for (int ai = 0; ai < 2; ++ai)
#pragma unroll
            for (int m = 0; m < 4; ++m) { const int row = row0 + ai * HALF + m * 16; const float rs = rsv[ai][m];
#pragma unroll
                for (int bj = 0; bj < 2; ++bj) { const f32x4 v0 = acc[ai][bj][m][0] * rs, v1 = acc[ai][bj][m][1] * rs;
                    u32x4 o; o.x = cvt_pk_bf16(v0[0], v0[1]); o.y = cvt_pk_bf16(v0[2], v0[3]); o.z = cvt_pk_bf16(v1[0], v1[1]); o.w = cvt_pk_bf16(v1[2], v1[3]);
                    bf16_t* dst;
                    if (u.pn < 4) { const int colg = u.pn * BM + bj * HALF + wc * 32 + 8 * fq; dst = P + (size_t)(colg >> 9) * ((size_t)T * 512) + (size_t)row * 512 + (colg & 511); }
                    else if (u.pn < 8) { const int colc = (u.pn - 4) * BM + bj * HALF + wc * 32 + 8 * fq; dst = P + PJ_UC + (size_t)row * 1024 + colc; }
                    else { const int which = (u.pn - 8) >> 1, hd = ((u.pn - 8) & 1) * 4 + 2 * bj + (wc >> 1), dim = 32 * (wc & 1) + 8 * fq, bb = row >> 11, ll = row & 2047;
                        dst = P + PJ_QKV + ((size_t)(((which * 4 + bb) * 8 + hd) * SEQ + ll)) * 64 + dim; }
                    *(u32x4*)dst = o; } }
    }
};
template <int MB  > struct EpiRes {
    static constexpr bool PERM = false;
    const float* Hin; float* Hout; bf16_t* Hb; float* ss; const float* ssin;
    __device__ __forceinline__ void operator()(const f32x4 (&acc)[2][2][4][2], const Unit& u, int wr, int wc, int fr, int fq) const {
        const int row0 = u.pm * BM + wr * 64 + fr, col0 = u.pn * BM + wc * 32 + 4 * fq;
        float rsc[2][4];
        if (ssin) {
#pragma unroll
            for (int ai = 0; ai < 2; ++ai) {
                f32x4 q0[4], q1[4];
#pragma unroll
                for (int m = 0; m < 4; ++m) { const float* sp = ssin + (size_t)(row0 + ai * HALF + m * 16) * 32 + fq * 8; q0[m] = *(const f32x4*)sp; q1[m] = *(const f32x4*)(sp + 4); }
#pragma unroll
                for (int m = 0; m < 4; ++m) { float t = ((q0[m][0] + q0[m][1]) + (q0[m][2] + q0[m][3])) + ((q1[m][0] + q1[m][1]) + (q1[m][2] + q1[m][3]));
                    t += __shfl_xor(t, 16); t += __shfl_xor(t, 32); rsc[ai][m] = 1.0f / (t * (1.0f / D) + EPS); }
                asm volatile("" ::: "memory");
            }
        } else {
#pragma unroll
            for (int ai = 0; ai < 2; ++ai)
#pragma unroll
                for (int m = 0; m < 4; ++m) rsc[ai][m] = 1.0f;
        }
#pragma unroll
        for (int ai = 0; ai < 2; ++ai)
#pragma unroll
        for (int mh = 0; mh < 4; mh += MB) {
            f32x4 hv[MB][2][2];
#pragma unroll
            for (int m = 0; m < MB; ++m)
#pragma unroll
                for (int bj = 0; bj < 2; ++bj)
#pragma unroll
                    for (int n = 0; n < 2; ++n) hv[m][bj][n] = *(const f32x4*)(Hin + (size_t)(row0 + ai * HALF + (mh + m) * 16) * D + col0 + bj * HALF + n * 16);
#pragma unroll
            for (int m = 0; m < MB; ++m) { const int row = row0 + ai * HALF + (mh + m) * 16; const size_t off = (size_t)row * D + col0; float sq = 0.f;
                const float rs1 = rsc[ai][mh + m];
#pragma unroll
                for (int bj = 0; bj < 2; ++bj)
#pragma unroll
                    for (int n = 0; n < 2; ++n) { const size_t idx = off + bj * HALF + n * 16; const f32x4 o = hv[m][bj][n] + acc[ai][bj][mh + m][n] * rs1;
                        *(f32x4*)(Hout + idx) = o; sq += o[0] * o[0] + o[1] * o[1] + o[2] * o[2] + o[3] * o[3];
                        if (Hb) { u32x2 w; w.x = cvt_pk_bf16(o[0], o[1]); w.y = cvt_pk_bf16(o[2], o[3]); *(u32x2*)(Hb + idx) = w; } }
                if (ss) { sq += __shfl_xor(sq, 16); sq += __shfl_xor(sq, 32); if (fq == 0) ss[(size_t)row * 32 + u.pn * 4 + wc] = sq; } }
        }
    }
    __device__ __forceinline__ void gs(const f32x4 (&acc)[2][2][4][2], const Unit& u, int wr, int wc, int fr, int fq, const PG8_LAS float* rtab) const {
        const int row0 = u.pm * BM + wr * 64 + fr, col0 = u.pn * BM + wc * 32 + 4 * fq;
#pragma unroll
        for (int ai = 0; ai < 2; ++ai)
#pragma unroll
        for (int mh = 0; mh < 4; mh += MB) {
            f32x4 hv[MB][2][2];
#pragma unroll
            for (int m = 0; m < MB; ++m)
#pragma unroll
                for (int bj = 0; bj < 2; ++bj)
#pragma unroll
                    for (int n = 0; n < 2; ++n) hv[m][bj][n] = *(const f32x4*)(Hin + (size_t)(row0 + ai * HALF + (mh + m) * 16) * D + col0 + bj * HALF + n * 16);
#pragma unroll
            for (int m = 0; m < MB; ++m) { const int rl = ai * HALF + wr * 64 + (mh + m) * 16 + fr, row = u.pm * BM + rl; const size_t off = (size_t)row * D + col0; float sq = 0.f;
                const float rs1 = rtab[3 * 256 + rl];
#pragma unroll
                for (int bj = 0; bj < 2; ++bj)
#pragma unroll
                    for (int n = 0; n < 2; ++n) { const size_t idx = off + bj * HALF + n * 16; const f32x4 o = hv[m][bj][n] + acc[ai][bj][mh + m][n] * rs1;
                        *(f32x4*)(Hout + idx) = o; sq += o[0] * o[0] + o[1] * o[1] + o[2] * o[2] + o[3] * o[3];
                        if (Hb) { u32x2 w; w.x = cvt_pk_bf16(o[0], o[1]); w.y = cvt_pk_bf16(o[2], o[3]); *(u32x2*)(Hb + idx) = w; } }
                if (ss) { sq += __shfl_xor(sq, 16); sq += __shfl_xor(sq, 32); if (fq == 0) ss[(size_t)row * 32 + u.pn * 4 + wc] = sq; } }
        }
    }
};
template <int MB  , bool F32IN> struct EpiRes2 {
    static constexpr bool PERM = true;
    const float* Xin; bf16_t* Hb; bf16_t* Hl; float* ss; const float* ssin;
    __device__ __forceinline__ void core(const f32x4 (&acc)[2][2][4][2], const Unit& u, int wr, int wc, int fr, int fq, const float (&rsc)[2][4]) const {
        const int row0 = u.pm * BM + wr * 64 + fr, col0 = u.pn * BM + wc * 32 + 8 * fq;
#pragma unroll
        for (int ai = 0; ai < 2; ++ai)
#pragma unroll
        for (int mh = 0; mh < 4; mh += MB) {
            u32x4 va[MB][2], vb[MB][2];
            f32x4 xa[MB][2], xb[MB][2];
#pragma unroll
            for (int m = 0; m < MB; ++m)
#pragma unroll
                for (int bj = 0; bj < 2; ++bj) { const size_t idx = (size_t)(row0 + ai * HALF + (mh + m) * 16) * D + col0 + bj * HALF;
                    if (F32IN) { xa[m][bj] = *(const f32x4*)(Xin + idx); xb[m][bj] = *(const f32x4*)(Xin + idx + 4); }
                    else { va[m][bj] = *(const u32x4*)(Hb + idx); vb[m][bj] = *(const u32x4*)(Hl + idx); } }
#pragma unroll
            for (int m = 0; m < MB; ++m) { const int row = row0 + ai * HALF + (mh + m) * 16; float sq = 0.f;
                const float rs1 = rsc[ai][mh + m];
#pragma unroll
                for (int bj = 0; bj < 2; ++bj) { const size_t idx = (size_t)row * D + col0 + bj * HALF;
                    float h[8];
                    if (F32IN) { h[0] = xa[m][bj][0]; h[1] = xa[m][bj][1]; h[2] = xa[m][bj][2]; h[3] = xa[m][bj][3]; h[4] = xb[m][bj][0]; h[5] = xb[m][bj][1]; h[6] = xb[m][bj][2]; h[7] = xb[m][bj][3]; }
                    else { const u32x4 a = va[m][bj], b = vb[m][bj];
                        h[0] = __uint_as_float(a.x << 16) + __uint_as_float(b.x << 16); h[1] = __uint_as_float(a.x & 0xffff0000u) + __uint_as_float(b.x & 0xffff0000u);
                        h[2] = __uint_as_float(a.y << 16) + __uint_as_float(b.y << 16); h[3] = __uint_as_float(a.y & 0xffff0000u) + __uint_as_float(b.y & 0xffff0000u);
                        h[4] = __uint_as_float(a.z << 16) + __uint_as_float(b.z << 16); h[5] = __uint_as_float(a.z & 0xffff0000u) + __uint_as_float(b.z & 0xffff0000u);
                        h[6] = __uint_as_float(a.w << 16) + __uint_as_float(b.w << 16); h[7] = __uint_as_float(a.w & 0xffff0000u) + __uint_as_float(b.w & 0xffff0000u); }
                    float o[8];
#pragma unroll
                    for (int e = 0; e < 8; ++e) { o[e] = h[e] + acc[ai][bj][mh + m][e >> 2][e & 3] * rs1; sq += o[e] * o[e]; }
                    u32x4 hi; hi.x = cvt_pk_bf16(o[0], o[1]); hi.y = cvt_pk_bf16(o[2], o[3]); hi.z = cvt_pk_bf16(o[4], o[5]); hi.w = cvt_pk_bf16(o[6], o[7]);
                    u32x4 lo;
                    lo.x = cvt_pk_bf16(o[0] - __uint_as_float(hi.x << 16), o[1] - __uint_as_float(hi.x & 0xffff0000u));
                    lo.y = cvt_pk_bf16(o[2] - __uint_as_float(hi.y << 16), o[3] - __uint_as_float(hi.y & 0xffff0000u));
                    lo.z = cvt_pk_bf16(o[4] - __uint_as_float(hi.z << 16), o[5] - __uint_as_float(hi.z & 0xffff0000u));
                    lo.w = cvt_pk_bf16(o[6] - __uint_as_float(hi.w << 16), o[7] - __uint_as_float(hi.w & 0xffff0000u));
                    *(u32x4*)(Hb + idx) = hi; *(u32x4*)(Hl + idx) = lo; }
                sq += __shfl_xor(sq, 16); sq += __shfl_xor(sq, 32); if (fq == 0) ss[(size_t)row * 32 + u.pn * 4 + wc] = sq; }
        }
    }
    __device__ __forceinline__ void operator()(const f32x4 (&acc)[2][2][4][2], const Unit& u, int wr, int wc, int fr, int fq) const {
        const int row0 = u.pm * BM + wr * 64 + fr;
        float rsc[2][4];
        if (ssin) {
#pragma unroll
            for (int ai = 0; ai < 2; ++ai) {
                f32x4 q0[4], q1[4];
#pragma unroll
                for (int m = 0; m < 4; ++m) { const float* sp = ssin + (size_t)(row0 + ai * HALF + m * 16) * 32 + fq * 8; q0[m] = *(const f32x4*)sp; q1[m] = *(const f32x4*)(sp + 4); }
#pragma unroll
                for (int m = 0; m < 4; ++m) { float t = ((q0[m][0] + q0[m][1]) + (q0[m][2] + q0[m][3])) + ((q1[m][0] + q1[m][1]) + (q1[m][2] + q1[m][3]));
                    t += __shfl_xor(t, 16); t += __shfl_xor(t, 32); rsc[ai][m] = 1.0f / (t * (1.0f / D) + EPS); }
                asm volatile("" ::: "memory");
            }
        } else {
#pragma unroll
            for (int ai = 0; ai < 2; ++ai)
#pragma unroll
                for (int m = 0; m < 4; ++m) rsc[ai][m] = 1.0f;
        }
        core(acc, u, wr, wc, fr, fq, rsc);
    }
    __device__ __forceinline__ void gs(const f32x4 (&acc)[2][2][4][2], const Unit& u, int wr, int wc, int fr, int fq, const PG8_LAS float* rtab) const {
        float rsc[2][4];
#pragma unroll
        for (int ai = 0; ai < 2; ++ai)
#pragma unroll
            for (int m = 0; m < 4; ++m) rsc[ai][m] = rtab[3 * 256 + ai * HALF + wr * 64 + m * 16 + fr];
        core(acc, u, wr, wc, fr, fq, rsc);
    }
};
struct EpiPart {
    static constexpr bool PERM = false;
    float* Q;
    __device__ __forceinline__ void operator()(const f32x4 (&acc)[2][2][4][2], const Unit& u, int wr, int wc, int fr, int fq) const {
        const int row0 = u.pm * BM + wr * 64 + fr, col0 = (u.pn & 1) * BM + wc * 32 + 4 * fq;
        float* base = Q + (size_t)(u.pn >> 1) * ((size_t)T * 512);
#pragma unroll
        for (int ai = 0; ai < 2; ++ai)
#pragma unroll
            for (int m = 0; m < 4; ++m) { float* rowp = base + (size_t)(row0 + ai * HALF + m * 16) * 512 + col0;
#pragma unroll
                for (int bj = 0; bj < 2; ++bj)
#pragma unroll
                    for (int n = 0; n < 2; ++n) *(f32x4*)(rowp + bj * HALF + n * 16) = acc[ai][bj][m][n]; }
    }
};
struct EpiSmall {
    static constexpr bool PERM = true;
    bf16_t* Y; const bf16_t* Gm; const float* pscale; float* ssg;
    __device__ __forceinline__ void operator()(const f32x4 (&acc)[2][2][4][2], const Unit& u, int wr, int wc, int fr, int fq) const {
        const int kind = u.pn >> 1;
        const int row0 = u.pm * BM + wr * 64 + fr, colk = (u.pn & 1) * BM + wc * 32 + 8 * fq;
        f32x4 ps[2][2];
        if (kind == 1) {
#pragma unroll
            for (int bj = 0; bj < 2; ++bj) { ps[bj][0] = *(const f32x4*)(pscale + colk + bj * HALF); ps[bj][1] = *(const f32x4*)(pscale + colk + bj * HALF + 4); } }
#pragma unroll
        for (int ai = 0; ai < 2; ++ai) {
            u32x4 gv[4][2];
            if (kind == 0) {
#pragma unroll
                for (int m = 0; m < 4; ++m)
#pragma unroll
                    for (int bj = 0; bj < 2; ++bj) gv[m][bj] = *(const u32x4*)(Gm + (size_t)(row0 + ai * HALF + m * 16) * 512 + colk + bj * HALF); }
#pragma unroll
            for (int m = 0; m < 4; ++m) { const int row = row0 + ai * HALF + m * 16; float sq = 0.f;
#pragma unroll
                for (int bj = 0; bj < 2; ++bj) { f32x4 v0 = acc[ai][bj][m][0], v1 = acc[ai][bj][m][1]; const int c = colk + bj * HALF;
                    if (kind == 0) { const u32x4 g4 = gv[m][bj];
                        float g[8]; g[0] = __uint_as_float(g4.x << 16); g[1] = __uint_as_float(g4.x & 0xffff0000u); g[2] = __uint_as_float(g4.y << 16); g[3] = __uint_as_float(g4.y & 0xffff0000u);
                        g[4] = __uint_as_float(g4.z << 16); g[5] = __uint_as_float(g4.z & 0xffff0000u); g[6] = __uint_as_float(g4.w << 16); g[7] = __uint_as_float(g4.w & 0xffff0000u);
#pragma unroll
                        for (int e = 0; e < 4; ++e) { v0[e] = g[e] * sigmoidf_(v0[e]); v1[e] = g[4 + e] * sigmoidf_(v1[e]); } }
                    else if (kind == 1) { v0 = v0 * ps[bj][0]; v1 = v1 * ps[bj][1]; }
                    sq += (v0[0] * v0[0] + v0[1] * v0[1]) + (v0[2] * v0[2] + v0[3] * v0[3]) + (v1[0] * v1[0] + v1[1] * v1[1]) + (v1[2] * v1[2] + v1[3] * v1[3]);
                    u32x4 o; o.x = cvt_pk_bf16(v0[0], v0[1]); o.y = cvt_pk_bf16(v0[2], v0[3]); o.z = cvt_pk_bf16(v1[0], v1[1]); o.w = cvt_pk_bf16(v1[2], v1[3]);
                    *(u32x4*)(Y + (size_t)row * D + kind * 512 + c) = o; }
                sq += __shfl_xor(sq, 16); sq += __shfl_xor(sq, 32);
                if (fq == 0) ssg[(size_t)row * 32 + kind * 8 + (u.pn & 1) * 4 + wc] = sq; }
        }
    }
};

struct WinKvOrder {
    StaticOrder so; size_t a_delta, b_delta;
    __device__ bool next(int i, Unit& u) const {
        if (so.next(i, u)) return true;
        const int L = i * so.G + so.c - so.nwg; if (L >= 64) return false;
        u.pm = L & 3; u.pn = 14 + (L >> 2); return true;
    }
    __device__ __forceinline__ size_t a_extra(const Unit& u) const { return u.pn >= 14 ? a_delta : 0; }
    __device__ __forceinline__ size_t b_extra(const Unit& u) const { return u.pn >= 14 ? b_delta - (size_t)14 * ((size_t)256 * D * 2) : 0; }
};
struct EpiWinKv {
    static constexpr bool PERM = true;
    EpiWin win; EpiBf16<0> kv;
    __device__ __forceinline__ void operator()(const f32x4 (&acc)[2][2][4][2], const Unit& u, int wr, int wc, int fr, int fq) const {
        if (u.pn >= 14) { Unit v; v.pm = u.pm; v.pn = u.pn - 14; kv(acc, v, wr, wc, fr, fq); } else win(acc, u, wr, wc, fr, fq);
    }
};
template <class Epi, class Sched, bool ALIGN_EPI = true, bool SP2 = true, bool GS = false>
__device__ __forceinline__ void gemm_phase(PG8_LAS unsigned char* lds, const Gemm g, const Sched& S, const Epi& E, const float* gs_ss = nullptr) {
    const int tid = tid_fresh(), wid = __builtin_amdgcn_readfirstlane(tid >> 6), lane = tid & 63, wr = wid >> 2, wc = wid & 3, fr = lane & 15, fq = lane >> 4;
    const int K = g.K, nt = g.Kloop / BK;
    unsigned voffA[2], voffB[2];
#pragma unroll
    for (int i = 0; i < 2; ++i) { int R, C; stage_rc(tid * 16 + i * 8192, R, C); const int Rb = Epi::PERM ? ((R & ~31) + perm32(R & 31)) : R;
        voffA[i] = (unsigned)(R * K + C) * 2u; voffB[i] = (unsigned)(Rb * K + C) * 2u; }
    const size_t kstep = (size_t)(BK * 2);
    const size_t hstep = (size_t)HALF * K * 2;
    const size_t tstep = 2 * hstep;
    const unsigned ldsw = (unsigned)wid * 1024u;
    const int aoff = lds_byte(wr * 64 + fr, fq * 8), boff = lds_byte(wc * 32 + fr, fq * 8);
#define PG8_GS_BUILD(uu, par) do { if constexpr (GS) { const int _row = tid >> 1, _g0 = (tid & 1) * 2; \
        const float* _sp = gs_ss + ((size_t)((uu).pm * BM + _row)) * 32 + _g0 * 8; \
        const f32x4 _a0 = *(const f32x4*)_sp, _a1 = *(const f32x4*)(_sp + 4), _b0 = *(const f32x4*)(_sp + 8), _b1 = *(const f32x4*)(_sp + 12); \
        const float _s0 = ((_a0[0] + _a0[1]) + (_a0[2] + _a0[3])) + ((_a1[0] + _a1[1]) + (_a1[2] + _a1[3])), _s1 = ((_b0[0] + _b0[1]) + (_b0[2] + _b0[3])) + ((_b1[0] + _b1[1]) + (_b1[2] + _b1[3])); \
        PG8_LAS float* _t = (PG8_LAS float*)(lds + STAGE_BYTES + (par) * 4096); \
        _t[_g0 * 256 + _row] = 1.0f / sqrtf(_s0 * (1.0f / 512.0f) + EPS); _t[(_g0 + 1) * 256 + _row] = 1.0f / sqrtf(_s1 * (1.0f / 512.0f) + EPS); } } while (0)
#define PG8_GS_SCALE(gb, par) do { if constexpr (GS) { const PG8_LAS float* _t = (const PG8_LAS float*)(lds + STAGE_BYTES + (par) * 4096); \
        _Pragma("unroll") for (int _ai = 0; _ai < 2; ++_ai) _Pragma("unroll") for (int _m = 0; _m < 4; ++_m) { const int _rl = _ai * HALF + wr * 64 + _m * 16 + fr; \
            const float _f = _t[(gb) * 256 + _rl] / _t[((gb) + 1) * 256 + _rl]; \
            _Pragma("unroll") for (int _bj = 0; _bj < 2; ++_bj) _Pragma("unroll") for (int _n = 0; _n < 2; ++_n) acc[_ai][_bj][_m][_n] = acc[_ai][_bj][_m][_n] * _f; } } } while (0)
#define PG8_SA(b, h) (((b) * 2 + (h)) * HTB)
#define PG8_SB(b, h) ((4 + (b) * 2 + (h)) * HTB)
#define PG8_STAGE(bufoff, gbase, voff) do { _Pragma("unroll") for (int _i = 0; _i < 2; ++_i) \
        __builtin_amdgcn_global_load_lds((const unsigned*)((const char*)(gbase) + (voff)[_i]), (PG8_LAS unsigned*)(lds + (bufoff) + ldsw + _i * 8192), 16, 0, 0); } while (0)
#define PG8_LDA(dst, b, h) do { _Pragma("unroll") for (int m = 0; m < 4; ++m) _Pragma("unroll") for (int k = 0; k < 2; ++k) dst[m][k] = *(const PG8_LAS bf16x8*)(lds + PG8_SA(b, h) + aoff + m * 2048 + k * 1024); } while (0)
#define PG8_LDB(dst, b, h) do { _Pragma("unroll") for (int n = 0; n < 2; ++n) _Pragma("unroll") for (int k = 0; k < 2; ++k) dst[n][k] = *(const PG8_LAS bf16x8*)(lds + PG8_SB(b, h) + boff + n * 2048 + k * 1024); } while (0)
#define PG8_MMA(ai, bj, At, Bt) do { __builtin_amdgcn_s_setprio(1); _Pragma("unroll") for (int m = 0; m < 4; ++m) _Pragma("unroll") for (int n = 0; n < 2; ++n) _Pragma("unroll") for (int k = 0; k < 2; ++k) \
        acc[ai][bj][m][n] = __builtin_amdgcn_mfma_f32_16x16x32_bf16(Bt[n][k], At[m][k], acc[ai][bj][m][n], 0, 0, 0); __builtin_amdgcn_s_setprio(0); } while (0)
#define PG8_WAIT_V(n) asm volatile("s_waitcnt vmcnt(" #n ")" ::: "memory")
#define PG8_WAIT_L(n) asm volatile("s_waitcnt lgkmcnt(" #n ")" ::: "memory")
#define PG8_BAR __builtin_amdgcn_s_barrier()
#define PG8_SCHED __builtin_amdgcn_sched_barrier(0)
    Unit cur, nxt; int ui = 0;
    if (!S.next(0, cur)) return;
    f32x4 acc[2][2][4][2];
#pragma unroll
    for (int a = 0; a < 2; ++a)
#pragma unroll
        for (int b = 0; b < 2; ++b)
#pragma unroll
            for (int m = 0; m < 4; ++m)
#pragma unroll
                for (int n = 0; n < 2; ++n) acc[a][b][m][n] = (f32x4){0.f, 0.f, 0.f, 0.f};
    bf16x8 At[4][2], B0[2][2], B1[2][2];
    const char* cA = (const char*)g.A + S.a_extra(cur) + (size_t)cur.pm * tstep; const char* cB = (const char*)g.Bt + S.b_extra(cur) + (size_t)cur.pn * tstep;
    int gpar = 0;
    PG8_GS_BUILD(cur, 0);
    if constexpr (SP2) {
        PG8_STAGE(PG8_SB(0, 0), cB, voffB); PG8_STAGE(PG8_SB(0, 1), cB + hstep, voffB); PG8_STAGE(PG8_SA(0, 0), cA, voffA); PG8_STAGE(PG8_SA(0, 1), cA + hstep, voffA);
        if (wr == 1) PG8_BAR;
        PG8_WAIT_V(2); PG8_BAR;
        PG8_STAGE(PG8_SB(1, 0), cB + kstep, voffB); PG8_STAGE(PG8_SA(1, 0), cA + kstep, voffA); PG8_STAGE(PG8_SB(1, 1), cB + hstep + kstep, voffB);
        PG8_WAIT_V(6); PG8_BAR;
    } else {
        PG8_STAGE(PG8_SB(0, 0), cB, voffB); PG8_STAGE(PG8_SA(0, 0), cA, voffA); PG8_STAGE(PG8_SB(0, 1), cB + hstep, voffB); PG8_STAGE(PG8_SA(0, 1), cA + hstep, voffA);
        if (wr == 1) PG8_BAR;
        PG8_WAIT_V(4); PG8_BAR;
        PG8_STAGE(PG8_SB(1, 0), cB + kstep, voffB); PG8_STAGE(PG8_SA(1, 0), cA + kstep, voffA); PG8_STAGE(PG8_SB(1, 1), cB + hstep + kstep, voffB);
        PG8_WAIT_V(6); PG8_BAR;
    }
    for (;;) {
        const bool has_next = S.next(ui + 1, nxt);
        const char* nA = has_next ? (const char*)g.A + S.a_extra(nxt) + (size_t)nxt.pm * tstep : cA; const char* nB = has_next ? (const char*)g.Bt + S.b_extra(nxt) + (size_t)nxt.pn * tstep : cB;
        for (int t = 0; t < nt; t += 2) {
            const bool last = (t == nt - 2);
            const char* a1 = cA + (size_t)(t + 1) * kstep;
            const char* a2 = last ? nA : cA + (size_t)(t + 2) * kstep; const char* b2 = last ? nB : cB + (size_t)(t + 2) * kstep;
            const char* a3 = a2 + kstep; const char* b3 = b2 + kstep;
            if constexpr (SP2) {
            PG8_LDB(B0, 0, 0); PG8_LDB(B1, 0, 1); PG8_SCHED; PG8_LDA(At, 0, 0); PG8_STAGE(PG8_SA(1, 1), a1 + hstep, voffA);
            PG8_WAIT_V(8); PG8_WAIT_L(0); PG8_BAR; PG8_MMA(0, 0, At, B0); PG8_MMA(0, 1, At, B1); PG8_BAR; PG8_SCHED;
            PG8_LDA(At, 0, 1); PG8_STAGE(PG8_SB(0, 0), b2, voffB); PG8_STAGE(PG8_SB(0, 1), b2 + hstep, voffB); PG8_STAGE(PG8_SA(0, 0), a2, voffA);
            PG8_WAIT_V(8); PG8_WAIT_L(0); PG8_BAR; PG8_MMA(1, 0, At, B0); PG8_MMA(1, 1, At, B1); PG8_BAR; PG8_SCHED;
            PG8_LDB(B0, 1, 0); PG8_LDB(B1, 1, 1); PG8_SCHED; PG8_LDA(At, 1, 0); PG8_STAGE(PG8_SA(0, 1), a2 + hstep, voffA);
            PG8_WAIT_V(8); PG8_WAIT_L(0); PG8_BAR; PG8_MMA(0, 0, At, B0); PG8_MMA(0, 1, At, B1); PG8_BAR; PG8_SCHED;
            PG8_LDA(At, 1, 1); PG8_STAGE(PG8_SB(1, 0), b3, voffB); PG8_STAGE(PG8_SB(1, 1), b3 + hstep, voffB); PG8_STAGE(PG8_SA(1, 0), a3, voffA);
            PG8_WAIT_V(8); PG8_WAIT_L(0); PG8_BAR; PG8_MMA(1, 0, At, B0); PG8_MMA(1, 1, At, B1); PG8_BAR; PG8_SCHED;
            } else {
            PG8_LDB(B0, 0, 0); PG8_SCHED; PG8_LDA(At, 0, 0); PG8_STAGE(PG8_SA(1, 1), a1 + hstep, voffA);
            PG8_WAIT_L(8); PG8_BAR; PG8_WAIT_L(0); PG8_MMA(0, 0, At, B0); PG8_BAR; PG8_SCHED;
            PG8_LDB(B1, 0, 1); PG8_STAGE(PG8_SB(0, 0), b2, voffB);
            PG8_BAR; PG8_WAIT_L(0); PG8_MMA(0, 1, At, B1); PG8_BAR;
            PG8_LDA(At, 0, 1); PG8_STAGE(PG8_SA(0, 0), a2, voffA);
            PG8_BAR; PG8_WAIT_L(0); PG8_MMA(1, 0, At, B0); PG8_BAR; PG8_SCHED;
            PG8_STAGE(PG8_SB(0, 1), b2 + hstep, voffB);
            PG8_WAIT_V(6); PG8_BAR; PG8_MMA(1, 1, At, B1); PG8_BAR;
            PG8_LDB(B0, 1, 0); PG8_SCHED; PG8_LDA(At, 1, 0); PG8_STAGE(PG8_SA(0, 1), a2 + hstep, voffA);
            PG8_WAIT_L(8); PG8_BAR; PG8_WAIT_L(0); PG8_MMA(0, 0, At, B0); PG8_BAR; PG8_SCHED;
            PG8_LDB(B1, 1, 1); PG8_STAGE(PG8_SB(1, 0), b3, voffB);
            PG8_BAR; PG8_WAIT_L(0); PG8_MMA(0, 1, At, B1); PG8_BAR;
            PG8_LDA(At, 1, 1); PG8_STAGE(PG8_SA(1, 0), a3, voffA);
            PG8_BAR; PG8_WAIT_L(0); PG8_MMA(1, 0, At, B0); PG8_BAR; PG8_SCHED;
            PG8_STAGE(PG8_SB(1, 1), b3 + hstep, voffB);
            PG8_WAIT_V(6); PG8_BAR; PG8_MMA(1, 1, At, B1); PG8_BAR;
                    }
            if constexpr (GS) { if ((t & 7) == 6 && !last) { PG8_GS_SCALE(t >> 3, gpar); } }
        }
        if constexpr (ALIGN_EPI) { if (wr == 0) PG8_BAR; }
        if constexpr (GS) E.gs(acc, cur, wr, wc, fr, fq, (const PG8_LAS float*)(lds + STAGE_BYTES + gpar * 4096)); else E(acc, cur, wr, wc, fr, fq);
        if (!has_next) break;
#pragma unroll
        for (int a = 0; a < 2; ++a)
#pragma unroll
            for (int b = 0; b < 2; ++b)
#pragma unroll
                for (int m = 0; m < 4; ++m)
#pragma unroll
                    for (int n = 0; n < 2; ++n) acc[a][b][m][n] = (f32x4){0.f, 0.f, 0.f, 0.f};
        cur = nxt; cA = nA; cB = nB; ++ui;
        if constexpr (GS) { gpar ^= 1; PG8_GS_BUILD(cur, gpar); }
        if constexpr (ALIGN_EPI) { if (wr == 1) PG8_BAR; }
    }
    PG8_WAIT_V(0);
    if constexpr (!ALIGN_EPI) { if (wr == 0) PG8_BAR; }
    PG8_BAR;
#undef PG8_GS_BUILD
#undef PG8_GS_SCALE
#undef PG8_SA
#undef PG8_SB
#undef PG8_STAGE
#undef PG8_LDA
#undef PG8_LDB
#undef PG8_MMA
#undef PG8_WAIT_V
#undef PG8_WAIT_L
#undef PG8_BAR
#undef PG8_SCHED
}
}

template <class Epi>
__device__ __forceinline__ void run_gemm(unsigned char* shm, const bf16_t* A, const bf16_t* Bt, int M, int N, int K, const Epi& E) {
    pg8::StaticOrder S; S.init(M, N, (int)gridDim.x, (int)bid_fresh());
    pg8::Gemm g{A, Bt, M, N, K, K};
    pg8::gemm_phase<Epi, pg8::StaticOrder>((PG8_LAS unsigned char*)shm, g, S, E);
}

__device__ __forceinline__ void tconv_tile(const float* src, int N, int kb, int nb, bf16_t* dst, int ldd, float* tile, const float* kscale = nullptr) {
    const int tid = tid_fresh();
#pragma unroll
    for (int p = 0; p < 2; ++p) {
        const int r = (tid >> 4) + p * 32, c4 = tid & 15;
        f32x4 v = *(const f32x4*)(src + (size_t)(kb * 64 + r) * N + nb * 64 + c4 * 4);
        if (kscale) v = v * kscale[kb * 64 + r];
        float* t = tile + r * 65 + c4 * 4; t[0] = v[0]; t[1] = v[1]; t[2] = v[2]; t[3] = v[3];
    }
    __syncthreads();
    const int n = tid >> 3, k8 = tid & 7;
    const float* s = tile + (k8 * 8) * 65 + n;
    u32x4 o; o.x = pk2(s[0], s[65]); o.y = pk2(s[2 * 65], s[3 * 65]); o.z = pk2(s[4 * 65], s[5 * 65]); o.w = pk2(s[6 * 65], s[7 * 65]);
    *(u32x4*)(dst + (size_t)(nb * 64 + n) * ldd + kb * 64 + k8 * 8) = o;
    __syncthreads();
}

__device__ __forceinline__ void tconv_tile_w(const float* src, int N, int kb, int nb, bf16_t* dst, int ldd, float* tile, const float* kscale = nullptr) {
    const int tid = tid_fresh();
    f32x4 v[8];
#pragma unroll
    for (int p = 0; p < 8; ++p) { const int idx = tid + 512 * p, r = idx >> 6, c4 = idx & 63;
        v[p] = __builtin_nontemporal_load((const f32x4*)(src + (size_t)(kb * 64 + r) * N + nb * 256 + c4 * 4)); }
    if (kscale) {
#pragma unroll
        for (int p = 0; p < 8; ++p) v[p] = v[p] * kscale[kb * 64 + ((tid + 512 * p) >> 6)];
    }
#pragma unroll
    for (int p = 0; p < 8; ++p) { const int idx = tid + 512 * p, r = idx >> 6, c4 = idx & 63;
        float* t = tile + r * 257 + c4 * 4; t[0] = v[p][0]; t[1] = v[p][1]; t[2] = v[p][2]; t[3] = v[p][3]; }
    __syncthreads();
#pragma unroll
    for (int q = 0; q < 4; ++q) { const int id = tid + 512 * q, n = id >> 3, k8 = id & 7;
        const float* s = tile + (k8 * 8) * 257 + n;
        u32x4 o; o.x = pk2(s[0], s[257]); o.y = pk2(s[2 * 257], s[3 * 257]); o.z = pk2(s[4 * 257], s[5 * 257]); o.w = pk2(s[6 * 257], s[7 * 257]);
        *(u32x4*)(dst + (size_t)(nb * 256 + n) * ldd + kb * 64 + k8 * 8) = o; }
    __syncthreads();
}

__device__ __forceinline__ void rms_row_bf16(const float* x, const float* g, bf16_t* o, int lane) {
    f32x4 v[8]; float ss = 0.f;
#pragma unroll
    for (int j = 0; j < 8; ++j) { v[j] = ((const f32x4*)x)[lane + 64 * j]; ss += v[j][0] * v[j][0] + v[j][1] * v[j][1] + v[j][2] * v[j][2] + v[j][3] * v[j][3]; }
    ss = wave_sum(ss);
    const float rs = 1.0f / sqrtf(ss * (1.0f / D) + EPS);
#pragma unroll
    for (int j = 0; j < 8; ++j) { const f32x4 gg = ((const f32x4*)g)[lane + 64 * j];
        u32x2 w; w.x = pk2(v[j][0] * rs * gg[0], v[j][1] * rs * gg[1]); w.y = pk2(v[j][2] * rs * gg[2], v[j][3] * rs * gg[3]);
        ((u32x2*)o)[lane + 64 * j] = w; }
}
__device__ __forceinline__ void rms_row_f32(const float* x, const float* g, float* o, int lane) {
    f32x4 v[8]; float ss = 0.f;
#pragma unroll
    for (int j = 0; j < 8; ++j) { v[j] = ((const f32x4*)x)[lane + 64 * j]; ss += v[j][0] * v[j][0] + v[j][1] * v[j][1] + v[j][2] * v[j][2] + v[j][3] * v[j][3]; }
    ss = wave_sum(ss);
    const float rs = 1.0f / sqrtf(ss * (1.0f / D) + EPS);
#pragma unroll
    for (int j = 0; j < 8; ++j) { const f32x4 gg = ((const f32x4*)g)[lane + 64 * j]; ((f32x4*)o)[lane + 64 * j] = v[j] * rs * gg; }
}

__device__ __forceinline__ void phase_rms(const float* h, const float* g, bf16_t* xn, int nrows) {
    const int lane = tid_fresh() & 63, gw = bid_fresh() * 8 + (tid_fresh() >> 6), NGW = gridDim.x * 8;
    for (int r = gw; r < nrows; r += NGW) rms_row_bf16(h + (size_t)r * D, g, xn + (size_t)r * D, lane);
}

__device__ __forceinline__ void phase0(PP p, unsigned char* shm) {
    unsigned char* ws = p->ws;
    float* tile = (float*)shm;
    constexpr int C_IN = 32 * 14, C_OUT = 32 * 8, C_XQ = 32 * 2, C_XO = 8 * 8, C_UP = 32 * 32, C_DN = 128 * 8, C_GLU = 8 * 2, C_POOL = 16, C_PW = 8 * 2;
    constexpr int C_LAYER = C_IN + C_OUT + 3 * C_XQ + C_XO + C_UP + C_DN + C_GLU + C_POOL + C_PW;
    for (int it = bid_fresh(); it < DEPTH * C_LAYER; it += gridDim.x) {
        const int l = it / C_LAYER; int r = it % C_LAYER;
        if (r < C_IN) { tconv_tile_w(p->in[5] + (size_t)l * D * INW, INW, r / 14, r % 14, (bf16_t*)(ws + WS_WIN) + (size_t)l * INW * D, D, tile, p->in[4] + (size_t)l * D); continue; } r -= C_IN;
        if (r < C_OUT) { tconv_tile_w(p->in[23] + (size_t)l * D * D, D, r / 8, r % 8, (bf16_t*)(ws + WS_WOUT) + (size_t)l * D * D, D, tile, p->in[22] + (size_t)l * D); continue; } r -= C_OUT;
        if (r < C_XQ) { tconv_tile_w(p->in[25] + (size_t)l * D * 512, 512, r / 2, r % 2, (bf16_t*)(ws + WS_WXQ) + (size_t)l * 512 * D, D, tile, p->in[24] + (size_t)l * D); continue; } r -= C_XQ;
        if (r < C_XQ) { tconv_tile_w(p->in[26] + (size_t)l * D * 512, 512, r / 2, r % 2, (bf16_t*)(ws + WS_WKV) + (size_t)(l * 1024) * D, D, tile); continue; } r -= C_XQ;
        if (r < C_XQ) { tconv_tile_w(p->in[27] + (size_t)l * D * 512, 512, r / 2, r % 2, (bf16_t*)(ws + WS_WKV) + (size_t)(l * 1024 + 512) * D, D, tile); continue; } r -= C_XQ;
        if (r < C_XO) { tconv_tile_w(p->in[28] + (size_t)l * 512 * D, D, r / 8, r % 8, (bf16_t*)(ws + WS_WXO) + (size_t)l * D * 512, 512, tile); continue; } r -= C_XO;
        if (r < C_UP) { tconv_tile_w(p->in[30] + (size_t)l * D * DFF, DFF, r / 32, r % 32, (bf16_t*)(ws + WS_WUP) + (size_t)l * DFF * D, D, tile, p->in[29] + (size_t)l * D); continue; } r -= C_UP;
        if (r < C_DN) { tconv_tile_w(p->in[31] + (size_t)l * DFF * D, D, r / 8, r % 8, (bf16_t*)(ws + WS_WDN) + (size_t)l * D * DFF, DFF, tile); continue; } r -= C_DN;
        bf16_t* wsm = (bf16_t*)(ws + WS_WSM) + (size_t)l * 1536 * 512;
        if (r < C_GLU) { tconv_tile_w(p->in[14] + (size_t)l * 512 * 512, 512, r / 2, r % 2, wsm, 512, tile); continue; } r -= C_GLU;
        if (r < C_POOL) { const int gi = r >> 2, q = r & 3; tconv_tile(p->in[15] + (size_t)(l * 4 + gi) * 128 * 128, 128, q >> 1, q & 1, wsm + (size_t)(512 + gi * 128) * 512 + gi * 128, 512, tile); continue; } r -= C_POOL;
        tconv_tile_w(p->in[21] + (size_t)l * 512 * 512, 512, r / 2, r % 2, wsm + (size_t)1024 * 512, 512, tile);
    }
    {
        const int gt = bid_fresh() * 512 + tid_fresh(), NT = gridDim.x * 512;
        for (int i = gt; i < DEPTH * 512 * 64; i += NT) {
            const int l = i / (512 * 64), rr = (i / 64) % 512, ch = i % 64;
            if ((rr >> 7) != (ch >> 4)) { bf16_t* wsm = (bf16_t*)(ws + WS_WSM) + (size_t)l * 1536 * 512; *(u32x4*)(wsm + (size_t)(512 + rr) * 512 + ch * 8) = (u32x4){0u, 0u, 0u, 0u}; }
        }
    }
    phase_rms(p->in[1], p->in[3], (bf16_t*)(ws + WS_MEMN), 1024);
    {
        const int lane = tid_fresh() & 63, gw = bid_fresh() * 8 + (tid_fresh() >> 6), NGW = gridDim.x * 8;
        float* ssb = (float*)(ws + WS_SS);
        for (int r = gw; r < T; r += NGW) {
            const float* x = p->in[0] + (size_t)r * D; bf16_t* o = (bf16_t*)(ws + WS_XN) + (size_t)r * D; float sq = 0.f;
#pragma unroll
            for (int j = 0; j < 8; ++j) { const f32x4 v = ((const f32x4*)x)[lane + 64 * j]; sq += v[0] * v[0] + v[1] * v[1] + v[2] * v[2] + v[3] * v[3];
                u32x2 w; w.x = pk2(v[0], v[1]); w.y = pk2(v[2], v[3]); ((u32x2*)o)[lane + 64 * j] = w; }
            sq = wave_sum(sq);
            if (lane < 32) ssb[(size_t)r * 32 + lane] = (lane == 0) ? sq : 0.f;
        }
    }
}

constexpr int VS = 268;
template <int HD, bool DIL>
__device__ __forceinline__ void attn_compute(const bf16_t* Ks, const bf16_t* Vt, const bf16x8 (&qf)[HD / 32], int a, int quad, int fr,
                                             const float* biasT, int kmin, f32x4 (&oacc)[HD / 16], float& mx_out, float& den_out) {
    f32x4 s[16];
#pragma unroll
    for (int nt = 0; nt < 16; ++nt) {
        s[nt] = (f32x4){0.f, 0.f, 0.f, 0.f};
#pragma unroll
        for (int ks = 0; ks < HD / 32; ++ks) {
            const bf16x8 kf = *(const bf16x8*)(Ks + (16 * nt + fr) * (HD + 8) + quad * 8 + 32 * ks);
            s[nt] = __builtin_amdgcn_mfma_f32_16x16x32_bf16(kf, qf[ks], s[nt], 0, 0, 0);
        }
    }
    float mx = -3.0e38f;
    const float* tb = DIL ? (biasT + (127 - a + 4 * quad)) : nullptr;
#pragma unroll
    for (int nt = 0; nt < 16; ++nt)
#pragma unroll
        for (int j = 0; j < 4; ++j) {
            float v = s[nt][j];
            if (DIL) {
                v = v * 0.18033688011112042f + tb[16 * nt + j];
                if (nt < 8) v = kmin ? -1.0e30f : v;
            }
            s[nt][j] = v; mx = fmaxf(mx, v);
        }
    mx = fmaxf(mx, __shfl_xor(mx, 16)); mx = fmaxf(mx, __shfl_xor(mx, 32));
    float sum = 0.f;
#pragma unroll
    for (int nt = 0; nt < 16; ++nt)
#pragma unroll
        for (int j = 0; j < 4; ++j) { const float pv = __builtin_amdgcn_exp2f(s[nt][j] - mx); s[nt][j] = pv; sum += pv; }
    sum += __shfl_xor(sum, 16); sum += __shfl_xor(sum, 32);
#pragma unroll
    for (int dt = 0; dt < HD / 16; ++dt) oacc[dt] = (f32x4){0.f, 0.f, 0.f, 0.f};
#pragma unroll
    for (int k2 = 0; k2 < 8; ++k2) {
        u32x4 pp; pp.x = pk2(s[2 * k2][0], s[2 * k2][1]); pp.y = pk2(s[2 * k2][2], s[2 * k2][3]); pp.z = pk2(s[2 * k2 + 1][0], s[2 * k2 + 1][1]); pp.w = pk2(s[2 * k2 + 1][2], s[2 * k2 + 1][3]);
        const bf16x8 pf = __builtin_bit_cast(bf16x8, pp);
#pragma unroll
        for (int dt = 0; dt < HD / 16; ++dt) {
            const bf16_t* vp = Vt + (16 * dt + fr) * VS + 32 * k2 + quad * 4;
            const u32x2 lo = *(const u32x2*)vp, hi = *(const u32x2*)(vp + 16);
            u32x4 vv; vv.x = lo.x; vv.y = lo.y; vv.z = hi.x; vv.w = hi.y;
            oacc[dt] = __builtin_amdgcn_mfma_f32_16x16x32_bf16(__builtin_bit_cast(bf16x8, vv), pf, oacc[dt], 0, 0, 0);
        }
    }
    mx_out = mx; den_out = sum;
}

__device__ __forceinline__ void attn_band64(const bf16_t* Ks, const bf16_t* Vt, const bf16x8 (&qf)[2], int a, int w, int quad, int fr,
                                            const float* biasT, int kmin, f32x4 (&oacc)[4], float& mx_out, float& den_out) {
    f32x4 s[10];
#pragma unroll
    for (int i = 0; i < 10; ++i) {
        const int nt = (w + i) > 15 ? 15 : (w + i);
        s[i] = (f32x4){0.f, 0.f, 0.f, 0.f};
#pragma unroll
        for (int ks = 0; ks < 2; ++ks) {
            const bf16x8 kf = *(const bf16x8*)(Ks + (16 * nt + fr) * 72 + quad * 8 + 32 * ks);
            s[i] = __builtin_amdgcn_mfma_f32_16x16x32_bf16(kf, qf[ks], s[i], 0, 0, 0);
        }
    }
    float mx = -3.0e38f;
    const float* tb = biasT + (127 - a + 4 * quad + 16 * w);
#pragma unroll
    for (int i = 0; i < 10; ++i) {
        const bool dead = (kmin != 0) && ((w + i) < 8);
#pragma unroll
        for (int j = 0; j < 4; ++j) {
            float v = s[i][j] * 0.18033688011112042f + tb[16 * i + j];
            v = dead ? -1.0e30f : v;
            s[i][j] = v; mx = fmaxf(mx, v);
        }
    }
    mx = fmaxf(mx, __shfl_xor(mx, 16)); mx = fmaxf(mx, __shfl_xor(mx, 32));
    float sum = 0.f;
#pragma unroll
    for (int i = 0; i < 10; ++i)
#pragma unroll
        for (int j = 0; j < 4; ++j) { const float pv = __builtin_amdgcn_exp2f(s[i][j] - mx); s[i][j] = pv; sum += pv; }
    sum += __shfl_xor(sum, 16); sum += __shfl_xor(sum, 32);
#pragma unroll
    for (int dt = 0; dt < 4; ++dt) oacc[dt] = (f32x4){0.f, 0.f, 0.f, 0.f};
#pragma unroll
    for (int k2 = 0; k2 < 5; ++k2) {
        u32x4 pp; pp.x = pk2(s[2 * k2][0], s[2 * k2][1]); pp.y = pk2(s[2 * k2][2], s[2 * k2][3]); pp.z = pk2(s[2 * k2 + 1][0], s[2 * k2 + 1][1]); pp.w = pk2(s[2 * k2 + 1][2], s[2 * k2 + 1][3]);
        const bf16x8 pf = __builtin_bit_cast(bf16x8, pp);
        const int t0 = w + 2 * k2, t1 = (t0 + 1) > 15 ? 15 : (t0 + 1);
#pragma unroll
        for (int dt = 0; dt < 4; ++dt) {
            const bf16_t* vp = Vt + (16 * dt + fr) * VS + quad * 4;
            const u32x2 lo = *(const u32x2*)(vp + 16 * t0), hi = *(const u32x2*)(vp + 16 * t1);
            u32x4 vv; vv.x = lo.x; vv.y = lo.y; vv.z = hi.x; vv.w = hi.y;
            oacc[dt] = __builtin_amdgcn_mfma_f32_16x16x32_bf16(__builtin_bit_cast(bf16x8, vv), pf, oacc[dt], 0, 0, 0);
        }
    }
    mx_out = mx; den_out = sum;
}

__device__ __forceinline__ void vt_store_pair(bf16_t* Vt, int dim0, int bi, const u32x4 a, const u32x4 b) {
    unsigned* vd = (unsigned*)(Vt + dim0 * VS + bi);
    constexpr int RS = VS / 2;
    vd[0 * RS] = (a.x & 0xffffu) | (b.x << 16); vd[1 * RS] = (a.x >> 16) | (b.x & 0xffff0000u);
    vd[2 * RS] = (a.y & 0xffffu) | (b.y << 16); vd[3 * RS] = (a.y >> 16) | (b.y & 0xffff0000u);
    vd[4 * RS] = (a.z & 0xffffu) | (b.z << 16); vd[5 * RS] = (a.z >> 16) | (b.z & 0xffff0000u);
    vd[6 * RS] = (a.w & 0xffffu) | (b.w << 16); vd[7 * RS] = (a.w >> 16) | (b.w & 0xffff0000u);
}
__device__ __forceinline__ int t5_bucket(int n) {
    if (n < 16) return n;
    int b = 16;
    b += (n >= 22); b += (n >= 30); b += (n >= 40); b += (n >= 54); b += (n >= 73); b += (n >= 99); b += (n >= 134); b += (n >= 182);
    b += (n >= 246); b += (n >= 332); b += (n >= 450); b += (n >= 609); b += (n >= 825); b += (n >= 1117); b += (n >= 1513);
    return b;
}

constexpr int AT_KS = 0, AT_VT = 69632, AT_BIAS = 137216;
constexpr int DA_KS = 0, DA_VT = 36864, DA_BIAS = 36864 + 64 * VS * 2, DA_BUF = 73728;

struct DilUnit { int br, b, h, d, r, n; };
__device__ __forceinline__ DilUnit dil_decode(int u0) {
    const int u = (u0 & 7) * 192 + (u0 >> 3);
    DilUnit q; q.br = u / 512; const int rem = u % 512; q.b = rem / 128; q.h = (rem / 16) % 8; const int rn = rem % 16;
    q.d = (q.br == 0) ? 1 : (q.br == 1 ? 4 : 16); const int nbk = 16 / q.d; q.r = rn / nbk; q.n = rn % nbk; return q;
}
struct DilRegs { u32x4 kv[4], vv[4]; float bias; bf16x8 qf[2]; };
__device__ __forceinline__ void dil_issue(PP p, const DilUnit& q, DilRegs& R, int tid) {
    const bf16_t* proj = (const bf16_t*)(p->ws + WS_PROJ);
#pragma unroll
    for (int i = 0; i < 4; ++i) {
        const int bi = 2 * (tid >> 3) + (i & 1) + 128 * (i >> 1), ch = tid & 7, sp = 128 * (q.n - 1) + bi;
        R.kv[i] = (u32x4){0u, 0u, 0u, 0u}; R.vv[i] = R.kv[i];
        if (sp >= 0) { const size_t hp = ((size_t)((q.b * 8 + q.h) * SEQ + sp * q.d + q.r)) * 64 + ch * 8; R.kv[i] = *(const u32x4*)(proj + PJ_QKV + (size_t)1 * 4 * 8 * SEQ * 64 + hp); R.vv[i] = *(const u32x4*)(proj + PJ_QKV + (size_t)2 * 4 * 8 * SEQ * 64 + hp); }
    }
    { const int w = tid >> 6, lane = tid & 63, fr = lane & 15, quad = lane >> 4, a = 16 * w + fr;
      const size_t rowq = (size_t)(q.b * SEQ + (128 * q.n + a) * q.d + q.r);
      const bf16_t* qp = proj + PJ_QKV + ((size_t)((q.b * 8 + q.h) * SEQ) + (rowq - (size_t)q.b * SEQ)) * 64 + quad * 8;
      R.qf[0] = *(const bf16x8*)qp; R.qf[1] = *(const bf16x8*)(qp + 32); }
    R.bias = -1.0e30f;
    if (tid < 383) { const int sd = 255 - tid; if (sd >= 0 && sd <= 128) R.bias = p->in[2][t5_bucket(sd * q.d) * 8 + q.h] * 1.4426950408889634f; }
}
__device__ __forceinline__ void dil_stage(const DilRegs& R, unsigned char* buf, int tid) {
    bf16_t* Ks = (bf16_t*)(buf + DA_KS); bf16_t* Vt = (bf16_t*)(buf + DA_VT); float* biasT = (float*)(buf + DA_BIAS);
#pragma unroll
    for (int i = 0; i < 4; ++i) { const int bi = 2 * (tid >> 3) + (i & 1) + 128 * (i >> 1), ch = tid & 7; *(u32x4*)(Ks + bi * 72 + ch * 8) = R.kv[i]; }
#pragma unroll
    for (int i = 0; i < 4; i += 2) { const int bi = 2 * (tid >> 3) + 128 * (i >> 1), ch = tid & 7; vt_store_pair(Vt, ch * 8, bi, R.vv[i], R.vv[i + 1]); }
    if (tid < 383) biasT[tid] = R.bias;
}
__device__ __forceinline__ void dil_compute(PP p, const DilUnit& q, const unsigned char* buf, int tid, const bf16x8 (&qf)[2]) {
    const bf16_t* Ks = (const bf16_t*)(buf + DA_KS); const bf16_t* Vt = (const bf16_t*)(buf + DA_VT); const float* biasT = (const float*)(buf + DA_BIAS);
    const int w = tid >> 6, lane = tid & 63, fr = lane & 15, quad = lane >> 4;
    const int a = 16 * w + fr;
    const size_t rowq = (size_t)(q.b * SEQ + (128 * q.n + a) * q.d + q.r);
    f32x4 oacc[4]; float mx, den;
    attn_band64(Ks, Vt, qf, a, w, quad, fr, biasT, (q.n == 0) ? 128 : 0, oacc, mx, den);
    const float inv = 1.0f / den;
    bf16_t* ob = (bf16_t*)(p->ws + WS_OB) + ((size_t)q.br * T + rowq) * 512 + q.h * 64 + quad * 4;
#pragma unroll
    for (int dt = 0; dt < 4; ++dt) { u32x2 o; o.x = pk2(oacc[dt][0] * inv, oacc[dt][1] * inv); o.y = pk2(oacc[dt][2] * inv, oacc[dt][3] * inv); *(u32x2*)(ob + 16 * dt) = o; }
    if (quad == 0) ((float*)(p->ws + WS_LSE))[((size_t)q.br * T + rowq) * 8 + q.h] = mx * 0.6931471805599453f + __logf(den);
}
__device__ __forceinline__ void dil_attn_units(unsigned char* shm, int first, int stride) {
    const int tid = tid_fresh();
    if (first >= 1536) return;
    bf16x8 qcur[2];
    { PP p = get_pp(); DilRegs R; const DilUnit q = dil_decode(first); dil_issue(p, q, R, tid); dil_stage(R, shm, tid); qcur[0] = R.qf[0]; qcur[1] = R.qf[1]; }
    __syncthreads();
    int par = 0;
    for (int u = first; u < 1536; u += stride) {
        PP p = get_pp();
        const bool more = (u + stride) < 1536;
        DilRegs R; DilUnit qn = dil_decode(more ? u + stride : u);
        if (more) dil_issue(p, qn, R, tid);
        const DilUnit q = dil_decode(u);
        dil_compute(p, q, shm + par * DA_BUF, tid, qcur);
        if (more) { dil_stage(R, shm + (par ^ 1) * DA_BUF, tid); qcur[0] = R.qf[0]; qcur[1] = R.qf[1]; }
        __syncthreads();
        par ^= 1;
    }
}

__device__ __forceinline__ void cross_attn_unit(PP p, unsigned char* shm, int u, int l) {
    const bf16_t* kvb = (const bf16_t*)(p->ws + WS_KV);
    bf16_t* Ks = (bf16_t*)(shm + AT_KS); bf16_t* Vt = (bf16_t*)(shm + AT_VT);
    const int tid = tid_fresh(), w = tid >> 6, lane = tid & 63, fr = lane & 15, quad = lane >> 4;
    const int b = u / 64, xh = (u / 16) % 4, qt = u % 16;
    const size_t rowq = (size_t)(b * SEQ + qt * 128 + 16 * w + fr);
    float qs;
    { const float* sp = (const float*)(p->ws + WS_SS) + ((size_t)(1 + 3 * l) * T + rowq) * 32 + quad * 8;
      const f32x4 a0 = *(const f32x4*)sp, a1 = *(const f32x4*)(sp + 4);
      float t = ((a0[0] + a0[1]) + (a0[2] + a0[3])) + ((a1[0] + a1[1]) + (a1[2] + a1[3]));
      t += __shfl_xor(t, 16); t += __shfl_xor(t, 32);
      qs = (0.08838834764831845f * 1.4426950408889634f) / sqrtf(t * (1.0f / D) + EPS); }
    bf16x8 qf[4];
    const float* qp = (const float*)(p->ws + WS_QP) + rowq * 512 + xh * 128 + quad * 8;
#pragma unroll
    for (int ks = 0; ks < 4; ++ks) {
        f32x4 s0 = *(const f32x4*)(qp + 32 * ks), s1 = *(const f32x4*)(qp + 32 * ks + 4);
#pragma unroll
        for (int sp = 1; sp < 4; ++sp) { s0 += *(const f32x4*)(qp + (size_t)sp * T * 512 + 32 * ks); s1 += *(const f32x4*)(qp + (size_t)sp * T * 512 + 32 * ks + 4); }
        u32x4 pk; pk.x = pk2(s0[0] * qs, s0[1] * qs); pk.y = pk2(s0[2] * qs, s0[3] * qs); pk.z = pk2(s1[0] * qs, s1[1] * qs); pk.w = pk2(s1[2] * qs, s1[3] * qs);
        qf[ks] = __builtin_bit_cast(bf16x8, pk);
    }
    {
        u32x4 kq[8], vq[8];
#pragma unroll
        for (int i = 0; i < 8; ++i) { const int m = 2 * (tid >> 4) + (i & 1) + 64 * (i >> 1), ch = tid & 15;
            const bf16_t* rowp = kvb + (size_t)(b * 256 + m) * 4096 + l * 1024 + xh * 128 + ch * 8; kq[i] = *(const u32x4*)rowp; vq[i] = *(const u32x4*)(rowp + 512); }
#pragma unroll
        for (int i = 0; i < 8; ++i) { const int m = 2 * (tid >> 4) + (i & 1) + 64 * (i >> 1), ch = tid & 15; *(u32x4*)(Ks + m * 136 + ch * 8) = kq[i]; }
#pragma unroll
        for (int i = 0; i < 8; i += 2) { const int m = 2 * (tid >> 4) + 64 * (i >> 1), ch = tid & 15; vt_store_pair(Vt, ch * 8, m, vq[i], vq[i + 1]); }
    }
    __syncthreads();
    f32x4 oacc[8]; float mx, den;
    attn_compute<128, false>(Ks, Vt, qf, 0, quad, fr, nullptr, 0, oacc, mx, den);
    const float inv = 1.0f / den;
    bf16_t* ox = (bf16_t*)(p->ws + WS_OX) + rowq * 512 + xh * 128 + quad * 4;
#pragma unroll
    for (int dt = 0; dt < 8; ++dt) { u32x2 o; o.x = pk2(oacc[dt][0] * inv, oacc[dt][1] * inv); o.y = pk2(oacc[dt][2] * inv, oacc[dt][3] * inv); *(u32x2*)(ox + 16 * dt) = o; }
    __syncthreads();
}

typedef float f32x2 __attribute__((ext_vector_type(2)));
struct S5Lane { float ar, ai; f32x2 bb[16]; };
__device__ __forceinline__ void s5_lane_params(PP p, int l, int g, int n, S5Lane& q) {
    const int gi = (l * 32 + g) * 64 + n;
    const float lr = p->in[6][gi], li = p->in[7][gi], dt = expf(p->in[8][l * 32 + g]);
    const float mag = expf(lr * dt);
    float sn, cs; sincosf(li * dt, &sn, &cs);
    q.ar = mag * cs; q.ai = mag * sn;
    const float den = lr * lr + li * li, nr = q.ar - 1.0f, ni = q.ai;
    const float fr_ = (nr * lr + ni * li) / den, fi_ = (ni * lr - nr * li) / den;
    const f32x4* bre = (const f32x4*)(p->in[9] + (size_t)gi * 16); const f32x4* bim = (const f32x4*)(p->in[10] + (size_t)gi * 16);
#pragma unroll
    for (int c4 = 0; c4 < 4; ++c4) { const f32x4 br = bre[c4], bi = bim[c4];
#pragma unroll
        for (int e = 0; e < 4; ++e) { q.bb[c4 * 4 + e] = (f32x2){fr_ * br[e] - fi_ * bi[e], fr_ * bi[e] + fi_ * br[e]}; } }
}
__device__ __forceinline__ void s5_load_u(const bf16_t* proj, int b, int l0, int g, float* ub, int lane) {
    const bf16_t* src = proj + PJ_UA + (size_t)(b * SEQ + l0 + lane) * 512 + g * 16;
    const u32x4 a = *(const u32x4*)src, c = *(const u32x4*)(src + 8);
    f32x4* d = (f32x4*)(ub + lane * 16);
    d[0] = (f32x4){__uint_as_float(a.x << 16), __uint_as_float(a.x & 0xffff0000u), __uint_as_float(a.y << 16), __uint_as_float(a.y & 0xffff0000u)};
    d[1] = (f32x4){__uint_as_float(a.z << 16), __uint_as_float(a.z & 0xffff0000u), __uint_as_float(a.w << 16), __uint_as_float(a.w & 0xffff0000u)};
    d[2] = (f32x4){__uint_as_float(c.x << 16), __uint_as_float(c.x & 0xffff0000u), __uint_as_float(c.y << 16), __uint_as_float(c.y & 0xffff0000u)};
    d[3] = (f32x4){__uint_as_float(c.z << 16), __uint_as_float(c.z & 0xffff0000u), __uint_as_float(c.w << 16), __uint_as_float(c.w & 0xffff0000u)};
}
__device__ __forceinline__ void s5_step(const S5Lane& q, const float* urow, f32x2& x) {
    const f32x4* u4 = (const f32x4*)urow;
    f32x2 b0 = (f32x2){0.f, 0.f}, b1 = b0;
#pragma unroll
    for (int c4 = 0; c4 < 4; ++c4) { const f32x4 uv = u4[c4];
        b0 += q.bb[c4 * 4 + 0] * uv[0]; b1 += q.bb[c4 * 4 + 1] * uv[1]; b0 += q.bb[c4 * 4 + 2] * uv[2]; b1 += q.bb[c4 * 4 + 3] * uv[3]; }
    const f32x2 rot = (f32x2){-x.y, x.x};
    x = (x * q.ar + rot * q.ai) + (b0 + b1);
}
constexpr int S5_BBL = 0, S5_BUL = 4096, S5_XS = 4096 + 65536;
struct S5Frag { bf16x8 bfr[8]; };
__device__ __forceinline__ void s5_write_bbl(const S5Lane& q, bf16_t* bbL, int lane) {
    u32x4 re0, re1, im0, im1;
    re0.x = pk2(q.bb[0].x, q.bb[1].x); re0.y = pk2(q.bb[2].x, q.bb[3].x); re0.z = pk2(q.bb[4].x, q.bb[5].x); re0.w = pk2(q.bb[6].x, q.bb[7].x);
    re1.x = pk2(q.bb[8].x, q.bb[9].x); re1.y = pk2(q.bb[10].x, q.bb[11].x); re1.z = pk2(q.bb[12].x, q.bb[13].x); re1.w = pk2(q.bb[14].x, q.bb[15].x);
    im0.x = pk2(q.bb[0].y, q.bb[1].y); im0.y = pk2(q.bb[2].y, q.bb[3].y); im0.z = pk2(q.bb[4].y, q.bb[5].y); im0.w = pk2(q.bb[6].y, q.bb[7].y);
    im1.x = pk2(q.bb[8].y, q.bb[9].y); im1.y = pk2(q.bb[10].y, q.bb[11].y); im1.z = pk2(q.bb[12].y, q.bb[13].y); im1.w = pk2(q.bb[14].y, q.bb[15].y);
    *(u32x4*)(bbL + lane * 16) = re0; *(u32x4*)(bbL + lane * 16 + 8) = re1;
    *(u32x4*)(bbL + (64 + lane) * 16) = im0; *(u32x4*)(bbL + (64 + lane) * 16 + 8) = im1;
}
__device__ __forceinline__ void s5_load_frags(const bf16_t* bbL, S5Frag& f, int lane) {
    const int jj = lane & 15, quad = lane >> 4;
#pragma unroll
    for (int nt = 0; nt < 8; ++nt) { u32x4 v = (u32x4){0u, 0u, 0u, 0u}; if (quad < 2) v = *(const u32x4*)(bbL + (16 * nt + jj) * 16 + quad * 8); f.bfr[nt] = __builtin_bit_cast(bf16x8, v); }
}
__device__ __forceinline__ bf16x8 s5_ufrag(const bf16_t* proj, size_t row, int g, int lane) {
    const int tt = lane & 15, quad = lane >> 4;
    u32x4 v = (u32x4){0u, 0u, 0u, 0u};
    if (quad < 2) v = *(const u32x4*)(proj + PJ_UA + (row + tt) * 512 + g * 16 + quad * 8);
    return __builtin_bit_cast(bf16x8, v);
}
__device__ __forceinline__ void s5_bu16(const S5Frag& f, const bf16x8 uf, float* buL, int lane) {
    const int jj = lane & 15, quad = lane >> 4;
#pragma unroll
    for (int nt = 0; nt < 4; ++nt) {
        const f32x4 z = (f32x4){0.f, 0.f, 0.f, 0.f};
        const f32x4 dre = __builtin_amdgcn_mfma_f32_16x16x32_bf16(uf, f.bfr[nt], z, 0, 0, 0);
        const f32x4 dim = __builtin_amdgcn_mfma_f32_16x16x32_bf16(uf, f.bfr[nt + 4], z, 0, 0, 0);
#pragma unroll
        for (int r = 0; r < 4; ++r) *(f32x2*)(buL + ((4 * quad + r) * 64 + 16 * nt + jj) * 2) = (f32x2){dre[r], dim[r]};
    }
}
__device__ __forceinline__ void s5_rec(const S5Lane& q, f32x2 bu, f32x2& x) { const f32x2 rot = (f32x2){-x.y, x.x}; x = (x * q.ar + rot * q.ai) + bu; }

__device__ __forceinline__ void s5_pass1_item(PP p, unsigned char* shm, int item, int l) {
    const int tid = tid_fresh(), w = tid >> 6, lane = tid & 63;
    const int b = item / 128, g = (item / 4) % 32, jg = item % 4, j = jg * 8 + w;
    const bf16_t* proj = (const bf16_t*)(p->ws + WS_PROJ);
    bf16_t* bbL = (bf16_t*)(shm + S5_BBL); float* buL = (float*)(shm + S5_BUL) + w * 2048;
    S5Lane q; s5_lane_params(p, l, g, lane, q);
    const size_t row0 = (size_t)b * SEQ + j * 64;
    bf16x8 uf[4];
#pragma unroll
    for (int sc = 0; sc < 4; ++sc) uf[sc] = s5_ufrag(proj, row0 + sc * 16, g, lane);
    s5_write_bbl(q, bbL, lane);
    __syncthreads();
    S5Frag f; s5_load_frags(bbL, f, lane);
    f32x2 x = (f32x2){0.f, 0.f};
#pragma unroll
    for (int sc = 0; sc < 4; ++sc) {
        s5_bu16(f, uf[sc], buL, lane);
        __syncthreads();
#pragma unroll
        for (int t = 0; t < 16; ++t) s5_rec(q, *(const f32x2*)(buL + (t * 64 + lane) * 2), x);
        __syncthreads();
    }
    *(f32x2*)((float*)(p->ws + WS_CARRY) + ((size_t)((b * 32 + g) * 32 + j) * 64 + lane) * 2) = x;
}
__device__ __forceinline__ void s5_pass2_item(PP p, unsigned char* shm, int item, int l) {
    const int tid = tid_fresh(), w = tid >> 6, lane = tid & 63;
    const int b = item / 128, g = (item / 4) % 32, jg = item % 4, j = jg * 8 + w;
    const bf16_t* proj = (const bf16_t*)(p->ws + WS_PROJ);
    bf16_t* bbL = (bf16_t*)(shm + S5_BBL); float* buL = (float*)(shm + S5_BUL) + w * 2048; float* xs = (float*)(shm + S5_XS) + w * (16 * 132);
    const int cc = lane & 15, quad = lane >> 4;
    float cmr[32];
    { const float* src = ((quad < 2) ? p->in[11] : p->in[12]) + ((size_t)(l * 32 + g) * 16 + cc) * 64 + (quad & 1) * 32;
      const float sgn = (quad < 2) ? 1.0f : -1.0f;
#pragma unroll
      for (int i = 0; i < 8; ++i) { const f32x4 v = *(const f32x4*)(src + 4 * i); cmr[4 * i] = v[0] * sgn; cmr[4 * i + 1] = v[1] * sgn; cmr[4 * i + 2] = v[2] * sgn; cmr[4 * i + 3] = v[3] * sgn; } }
    S5Lane q; s5_lane_params(p, l, g, lane, q);
    const size_t row0 = (size_t)b * SEQ + j * 64;
    bf16x8 uf[4];
#pragma unroll
    for (int sc = 0; sc < 4; ++sc) uf[sc] = s5_ufrag(proj, row0 + sc * 16, g, lane);
    s5_write_bbl(q, bbL, lane);
    float pr = q.ar, pi = q.ai;
#pragma unroll
    for (int s = 0; s < 6; ++s) { const float nr = pr * pr - pi * pi, ni = 2.f * pr * pi; pr = nr; pi = ni; }
    f32x2 x = (f32x2){0.f, 0.f};
    const f32x2* carry = (const f32x2*)((const float*)(p->ws + WS_CARRY) + ((size_t)((b * 32 + g) * 32) * 64 + lane) * 2);
    for (int i0 = 0; i0 < j; i0 += 8) {
        f32x2 sv[8];
#pragma unroll
        for (int e = 0; e < 8; ++e) sv[e] = (i0 + e < j) ? carry[(size_t)(i0 + e) * 64] : (f32x2){0.f, 0.f};
#pragma unroll
        for (int e = 0; e < 8; ++e) if (i0 + e < j) { const f32x2 rot = (f32x2){-x.y, x.x}; x = (x * pr + rot * pi) + sv[e]; }
    }
    __syncthreads();
    S5Frag f; s5_load_frags(bbL, f, lane);
    const float dsk = p->in[13][(size_t)l * 512 + g * 16 + cc];
    bf16_t* Gout = (bf16_t*)(p->ws + WS_GPH);
    for (int sc = 0; sc < 4; ++sc) {
        s5_bu16(f, uf[sc], buL, lane);
        __syncthreads();
#pragma unroll
        for (int t = 0; t < 16; ++t) { s5_rec(q, *(const f32x2*)(buL + (t * 64 + lane) * 2), x); xs[t * 132 + lane] = x.x; xs[t * 132 + 64 + lane] = x.y; }
        __syncthreads();
        f32x4 y0 = (f32x4){0.f, 0.f, 0.f, 0.f}, y1 = y0;
        const f32x4* xrow = (const f32x4*)(xs + cc * 132 + quad * 32);
#pragma unroll
        for (int i = 0; i < 8; ++i) { const f32x4 xv = xrow[i];
            y0 = __builtin_amdgcn_mfma_f32_16x16x4f32(xv[0], cmr[4 * i + 0], y0, 0, 0, 0);
            y1 = __builtin_amdgcn_mfma_f32_16x16x4f32(xv[1], cmr[4 * i + 1], y1, 0, 0, 0);
            y0 = __builtin_amdgcn_mfma_f32_16x16x4f32(xv[2], cmr[4 * i + 2], y0, 0, 0, 0);
            y1 = __builtin_amdgcn_mfma_f32_16x16x4f32(xv[3], cmr[4 * i + 3], y1, 0, 0, 0); }
        const f32x4 y = y0 + y1;
#pragma unroll
        for (int r = 0; r < 4; ++r) { const int tl = sc * 16 + quad * 4 + r;
            const float v = y[r] + dsk * bf2f(proj[PJ_UA + (row0 + tl) * 512 + g * 16 + cc]);
            const float z = 0.7978845608028654f * (v + 0.044715f * v * v * v);
            const float th = 1.0f - 2.0f / (__expf(2.0f * z) + 1.0f);
            Gout[(row0 + tl) * 512 + g * 16 + cc] = f2bf(0.5f * v * (1.0f + th)); }
        __syncthreads();
    }
}

__device__ __forceinline__ void pool_item(PP p, unsigned char* shm, int item) {
    const bf16_t* proj = (const bf16_t*)(p->ws + WS_PROJ);
    bf16_t* P = (bf16_t*)(p->ws + WS_GPH) + (size_t)T * 512;
    float* ut = (float*)shm;
    const int tid = tid_fresh(), ch = tid, gi = ch >> 7, w = 2 << gi;
    const int row0 = item * 32, b = row0 / SEQ, l0 = row0 % SEQ;
#pragma unroll
    for (int i = 0; i < 6; ++i) {
        const int ci = tid + i * 512, rr = ci >> 6, c8 = ci & 63, ll = l0 - 16 + rr;
        u32x4 v = (u32x4){0u, 0u, 0u, 0u};
        if (ll >= 0) v = *(const u32x4*)(proj + PJ_UB + (size_t)(b * SEQ + ll) * 512 + c8 * 8);
        f32x4* d = (f32x4*)(ut + rr * 512 + c8 * 8);
        d[0] = (f32x4){__uint_as_float(v.x << 16), __uint_as_float(v.x & 0xffff0000u), __uint_as_float(v.y << 16), __uint_as_float(v.y & 0xffff0000u)};
        d[1] = (f32x4){__uint_as_float(v.z << 16), __uint_as_float(v.z & 0xffff0000u), __uint_as_float(v.w << 16), __uint_as_float(v.w & 0xffff0000u)};
    }
    __syncthreads();
    float sum = 0.f;
    for (int s = 1; s <= w; ++s) sum += ut[(16 - s) * 512 + ch];
    for (int t = 0; t < 32; ++t) {
        const int l = l0 + t;
        const float cur = ut[(16 + t) * 512 + ch];
        sum += cur - ut[(16 + t - w) * 512 + ch];
        const int cnt = (l + 1 < w) ? (l + 1) : w;
        P[(size_t)(row0 + t) * 512 + ch] = f2bf(sum / (float)cnt - cur);
    }
    __syncthreads();
}
constexpr int CV_HG = 0, CV_CV = 46 * 512 * 4;
__device__ __forceinline__ void conv_item(PP p, unsigned char* shm, int item, int l) {
    const bf16_t* proj = (const bf16_t*)(p->ws + WS_PROJ);
    bf16_t* HC = (bf16_t*)(p->ws + WS_GPH) + (size_t)2 * T * 512;
    float* hg = (float*)(shm + CV_HG); float* cv = (float*)(shm + CV_CV);
    const int tid = tid_fresh(), c = tid, row0 = item * 16, b = row0 / SEQ, l0 = row0 % SEQ;
#pragma unroll
    for (int i = 0; i < 6; ++i) {
        const int ci = tid + i * 512, rr = ci >> 6, c8 = ci & 63, ll = l0 - 30 + rr;
        if (rr < 46) {
            u32x4 v = (u32x4){0u, 0u, 0u, 0u}, gt = v;
            if (ll >= 0) { const bf16_t* rp = proj + PJ_UC + (size_t)(b * SEQ + ll) * 1024 + c8 * 8; v = *(const u32x4*)rp; gt = *(const u32x4*)(rp + 512); }
            float vf[8], gf[8];
            vf[0] = __uint_as_float(v.x << 16); vf[1] = __uint_as_float(v.x & 0xffff0000u); vf[2] = __uint_as_float(v.y << 16); vf[3] = __uint_as_float(v.y & 0xffff0000u);
            vf[4] = __uint_as_float(v.z << 16); vf[5] = __uint_as_float(v.z & 0xffff0000u); vf[6] = __uint_as_float(v.w << 16); vf[7] = __uint_as_float(v.w & 0xffff0000u);
            gf[0] = __uint_as_float(gt.x << 16); gf[1] = __uint_as_float(gt.x & 0xffff0000u); gf[2] = __uint_as_float(gt.y << 16); gf[3] = __uint_as_float(gt.y & 0xffff0000u);
            gf[4] = __uint_as_float(gt.z << 16); gf[5] = __uint_as_float(gt.z & 0xffff0000u); gf[6] = __uint_as_float(gt.w << 16); gf[7] = __uint_as_float(gt.w & 0xffff0000u);
            f32x4* d = (f32x4*)(hg + rr * 512 + c8 * 8);
            d[0] = (f32x4){vf[0] * sigmoidf_(gf[0]), vf[1] * sigmoidf_(gf[1]), vf[2] * sigmoidf_(gf[2]), vf[3] * sigmoidf_(gf[3])};
            d[1] = (f32x4){vf[4] * sigmoidf_(gf[4]), vf[5] * sigmoidf_(gf[5]), vf[6] * sigmoidf_(gf[6]), vf[7] * sigmoidf_(gf[7])};
        }
    }
    float wdw[31];
#pragma unroll
    for (int j = 0; j < 31; ++j) wdw[j] = p->in[17][((size_t)l * 31 + j) * 512 + c];
    const float bias = p->in[18][(size_t)l * 512 + c];
    __syncthreads();
    for (int t = 0; t < 16; ++t) {
        float acc = bias, acc2 = 0.f;
#pragma unroll
        for (int j = 0; j < 30; j += 2) { acc += wdw[j] * hg[(t + j) * 512 + c]; acc2 += wdw[j + 1] * hg[(t + j + 1) * 512 + c]; }
        acc += wdw[30] * hg[(t + 30) * 512 + c];
        cv[t * 512 + c] = acc + acc2;
    }
    __syncthreads();
    const int w = c >> 6, lane = c & 63;
    for (int tk = 0; tk < 2; ++tk) {
        const int t = w * 2 + tk;
        const f32x4 v0 = *(const f32x4*)(cv + t * 512 + lane * 8), v1 = *(const f32x4*)(cv + t * 512 + lane * 8 + 4);
        float s = v0[0] + v0[1] + v0[2] + v0[3] + v1[0] + v1[1] + v1[2] + v1[3];
        const float mean = wave_sum(s) * (1.0f / 512.0f);
        const f32x4 d0 = v0 - mean, d1 = v1 - mean;
        float s2 = d0[0] * d0[0] + d0[1] * d0[1] + d0[2] * d0[2] + d0[3] * d0[3] + d1[0] * d1[0] + d1[1] * d1[1] + d1[2] * d1[2] + d1[3] * d1[3];
        const float rstd = 1.0f / sqrtf(wave_sum(s2) * (1.0f / 512.0f) + EPS);
        const f32x4 g0 = *(const f32x4*)(p->in[19] + (size_t)l * 512 + lane * 8), g1 = *(const f32x4*)(p->in[19] + (size_t)l * 512 + lane * 8 + 4);
        const f32x4 b0 = *(const f32x4*)(p->in[20] + (size_t)l * 512 + lane * 8), b1 = *(const f32x4*)(p->in[20] + (size_t)l * 512 + lane * 8 + 4);
        float o[8];
#pragma unroll
        for (int e = 0; e < 4; ++e) { const float y0 = d0[e] * rstd * g0[e] + b0[e], y1 = d1[e] * rstd * g1[e] + b1[e]; o[e] = y0 * sigmoidf_(y0); o[4 + e] = y1 * sigmoidf_(y1); }
        u32x4 ov; ov.x = pk2(o[0], o[1]); ov.y = pk2(o[2], o[3]); ov.z = pk2(o[4], o[5]); ov.w = pk2(o[6], o[7]);
        *(u32x4*)(HC + (size_t)(row0 + t) * 512 + lane * 8) = ov;
    }
    __syncthreads();
}

__device__ __forceinline__ void unpack8(const u32x4 v, float (&f)[8]) {
    f[0] = __uint_as_float(v.x << 16); f[1] = __uint_as_float(v.x & 0xffff0000u); f[2] = __uint_as_float(v.y << 16); f[3] = __uint_as_float(v.y & 0xffff0000u);
    f[4] = __uint_as_float(v.z << 16); f[5] = __uint_as_float(v.z & 0xffff0000u); f[6] = __uint_as_float(v.w << 16); f[7] = __uint_as_float(v.w & 0xffff0000u);
}
struct CbTok { u32x4 ob[3]; float ls[3]; };
__device__ __forceinline__ void cb_load(CbTok& k, const bf16_t* ob, const float* lse, int t, int lane) {
#pragma unroll
    for (int g = 0; g < 3; ++g) { k.ob[g] = *(const u32x4*)(ob + ((size_t)g * T + t) * 512 + lane * 8); k.ls[g] = lse[((size_t)g * T + t) * 8 + (lane >> 3)]; }
}
__device__ __forceinline__ void phase_combine(PP p) {
    const int lane = tid_fresh() & 63, gw = bid_fresh() * 8 + (tid_fresh() >> 6), NGW = gridDim.x * 8;
    const bf16_t* ob = (const bf16_t*)(p->ws + WS_OB); const float* lse = (const float*)(p->ws + WS_LSE);
    bf16_t* y = (bf16_t*)(p->ws + WS_YN); float* ssg = (float*)(p->ws + WS_SSG);
    CbTok cur, nxt;
    if (gw < T) cb_load(cur, ob, lse, gw, lane);
    for (int t = gw; t < T; t += NGW) {
        const bool more = (t + NGW) < T;
        if (more) cb_load(nxt, ob, lse, t + NGW, lane);
        const float lm = fmaxf(cur.ls[0], fmaxf(cur.ls[1], cur.ls[2]));
        const float e0 = __expf(cur.ls[0] - lm), e1 = __expf(cur.ls[1] - lm), e2 = __expf(cur.ls[2] - lm), ei = 1.0f / (e0 + e1 + e2);
        float o0[8], o1[8], o2[8], v[8];
        unpack8(cur.ob[0], o0); unpack8(cur.ob[1], o1); unpack8(cur.ob[2], o2);
        float sq = 0.f;
#pragma unroll
        for (int e = 0; e < 8; ++e) { v[e] = (e0 * o0[e] + e1 * o1[e] + e2 * o2[e]) * ei; sq += v[e] * v[e]; }
        sq = wave_sum(sq);
        u32x4 ov; ov.x = pk2(v[0], v[1]); ov.y = pk2(v[2], v[3]); ov.z = pk2(v[4], v[5]); ov.w = pk2(v[6], v[7]);
        *(u32x4*)(y + (size_t)t * D + 1536 + lane * 8) = ov;
        if (lane < 8) ssg[(size_t)t * 32 + 24 + lane] = (lane == 0) ? sq : 0.f;
        if (more) cur = nxt;
    }
}

__global__ void __launch_bounds__(512, 2) hymba_fwd(Params p_unused) {
    extern __shared__ __attribute__((aligned(16))) unsigned char shm[];
    cg::grid_group grid = cg::this_grid();
    volatile LAS unsigned* xst = (volatile LAS unsigned*)(LAS unsigned char*)(shm + LDS_BYTES - 16);
    if (threadIdx.x == 0) { xst[0] = 0u; xst[1] = 0u; }
    __syncthreads();
    XcdBarrier xbar;
    { PP p = get_pp(); unsigned* barw = (unsigned*)(p->ws + WS_BAR); xbar = xcd_barrier_post(barw, xst);
      if (p->ws == nullptr) grid.sync(); }

    for (int rep = 0; rep < P0_REPS; ++rep) phase0(get_pp(), shm);
    GSYNC();

    for (int l = 0; l < N_LAYERS_RUN; ++l) {
        if (l == 0) { PP p = get_pp(); unsigned char* ws = p->ws;
          pg8::WinKvOrder S; S.so.init(T, INW, (int)gridDim.x, (int)bid_fresh()); S.a_delta = WS_MEMN - WS_XN; S.b_delta = WS_WKV - WS_WIN;
          pg8::Gemm g{(const bf16_t*)(ws + WS_XN), (const bf16_t*)(ws + WS_WIN), T, INW, D, D};
          pg8::EpiWinKv E{{(bf16_t*)(ws + WS_PROJ), (const float*)(ws + WS_SS)}, {(bf16_t*)(ws + WS_KV), 4096, 1.0f, nullptr}};
          pg8::gemm_phase<pg8::EpiWinKv, pg8::WinKvOrder>((PG8_LAS unsigned char*)shm, g, S, E); }
        else { PP p = get_pp(); unsigned char* ws = p->ws;
          pg8::EpiWin E{(bf16_t*)(ws + WS_PROJ), (const float*)(ws + WS_SS) + (size_t)(3 * l) * T * 32};
          run_gemm(shm, (const bf16_t*)(ws + WS_XN), (const bf16_t*)(ws + WS_WIN) + (size_t)l * INW * D, T, INW, D, E); }
        GSYNC();
        for (int rep = 0; rep < MIX_REPS; ++rep) {
            dil_attn_units(shm, bid_fresh(), (int)gridDim.x);
            int it0 = bid_fresh(); while (it0 < 1536) it0 += gridDim.x;
            for (int it = it0; it < 1536 + 512 + 256 + 512; it += gridDim.x) {
                PP p = get_pp();
                if (it < 2048) s5_pass1_item(p, shm, it - 1536, l);
                else if (it < 2304) pool_item(p, shm, it - 2048);
                else conv_item(p, shm, it - 2304, l);
            }
        }
        GSYNC();
        for (int rep = 0; rep < P3_REPS; ++rep) for (int it = bid_fresh(); it < 512; it += gridDim.x) s5_pass2_item(get_pp(), shm, it, l);
        for (int rep = 0; rep < NORM_REPS; ++rep) phase_combine(get_pp());
        GSYNC();
        { PP p = get_pp(); unsigned char* ws = p->ws;
          pg8::SmallOrder S{(int)gridDim.x, (int)bid_fresh()};
          pg8::Gemm g{(const bf16_t*)(ws + WS_GPH), (const bf16_t*)(ws + WS_WSM) + (size_t)l * 1536 * 512, T, 1536, 512, 512};
          pg8::EpiSmall E{(bf16_t*)(ws + WS_YN), (const bf16_t*)(ws + WS_GPH), p->in[16] + (size_t)l * 512, (float*)(ws + WS_SSG)};
          pg8::gemm_phase<pg8::EpiSmall, pg8::SmallOrder>((PG8_LAS unsigned char*)shm, g, S, E); }
        GSYNC();
        { PP p = get_pp(); unsigned char* ws = p->ws;
          pg8::StaticOrder S; S.init(T, D, (int)gridDim.x, (int)bid_fresh());
          pg8::Gemm g{(const bf16_t*)(ws + WS_YN), (const bf16_t*)(ws + WS_WOUT) + (size_t)l * D * D, T, D, D, D};
          if (l == 0) { pg8::EpiRes2<2, true> E{p->in[0], (bf16_t*)(ws + WS_XN), (bf16_t*)(ws + WS_H), (float*)(ws + WS_SS) + (size_t)(1 + 3 * l) * T * 32, nullptr};
            pg8::gemm_phase<pg8::EpiRes2<2, true>, pg8::StaticOrder, true, true, true>((PG8_LAS unsigned char*)shm, g, S, E, (const float*)(ws + WS_SSG)); }
          else { pg8::EpiRes2<2, false> E{nullptr, (bf16_t*)(ws + WS_XN), (bf16_t*)(ws + WS_H), (float*)(ws + WS_SS) + (size_t)(1 + 3 * l) * T * 32, nullptr};
            pg8::gemm_phase<pg8::EpiRes2<2, false>, pg8::StaticOrder, true, true, true>((PG8_LAS unsigned char*)shm, g, S, E, (const float*)(ws + WS_SSG)); } }
        GSYNC();
        { PP p = get_pp(); unsigned char* ws = p->ws;
          pg8::SplitOrder S{(int)gridDim.x, (int)bid_fresh()};
          pg8::Gemm g{(const bf16_t*)(ws + WS_XN), (const bf16_t*)(ws + WS_WXQ) + (size_t)l * 512 * D, T, 512, D, 512};
          pg8::EpiPart E{(float*)(ws + WS_QP)};
          pg8::gemm_phase<pg8::EpiPart, pg8::SplitOrder>((PG8_LAS unsigned char*)shm, g, S, E); }
        GSYNC();
        for (int rep = 0; rep < P9_REPS; ++rep) for (int it = bid_fresh(); it < 256; it += gridDim.x) cross_attn_unit(get_pp(), shm, it, l);
        GSYNC();
        { PP p = get_pp(); unsigned char* ws = p->ws;
          pg8::EpiRes2<2, false> E{nullptr, (bf16_t*)(ws + WS_XN), (bf16_t*)(ws + WS_H), (float*)(ws + WS_SS) + (size_t)(2 + 3 * l) * T * 32, nullptr};
          run_gemm(shm, (const bf16_t*)(ws + WS_OX), (const bf16_t*)(ws + WS_WXO) + (size_t)l * D * 512, T, D, 512, E); }
        GSYNC();
        { PP p = get_pp(); unsigned char* ws = p->ws;
          pg8::EpiBf16<1> E{(bf16_t*)(ws + WS_ACT), DFF, 1.0f, nullptr};
          run_gemm(shm, (const bf16_t*)(ws + WS_XN), (const bf16_t*)(ws + WS_WUP) + (size_t)l * DFF * D, T, DFF, D, E); }
        GSYNC();
        { PP p = get_pp(); unsigned char* ws = p->ws;
          pg8::EpiRes2<2, false> E{nullptr, (bf16_t*)(ws + WS_XN), (bf16_t*)(ws + WS_H), (float*)(ws + WS_SS) + (size_t)(3 + 3 * l) * T * 32, (const float*)(ws + WS_SS) + (size_t)(2 + 3 * l) * T * 32};
          run_gemm(shm, (const bf16_t*)(ws + WS_ACT), (const bf16_t*)(ws + WS_WDN) + (size_t)l * D * DFF, T, D, DFF, E); }
        GSYNC();
    }
    {
        PP p = get_pp(); const bf16_t* hb = (const bf16_t*)(p->ws + WS_XN); const bf16_t* hl = (const bf16_t*)(p->ws + WS_H); const float* gf = p->in[32]; float* outp = p->out;
        const int lane = tid_fresh() & 63, gw = bid_fresh() * 8 + (tid_fresh() >> 6), NGW = gridDim.x * 8;
        for (int r = gw; r < T; r += NGW) {
            float v[4][8]; float sq = 0.f;
#pragma unroll
            for (int j = 0; j < 4; ++j) { float a[8], b[8]; unpack8(*(const u32x4*)(hb + (size_t)r * D + (lane + 64 * j) * 8), a); unpack8(*(const u32x4*)(hl + (size_t)r * D + (lane + 64 * j) * 8), b);
#pragma unroll
                for (int e = 0; e < 8; ++e) { v[j][e] = a[e] + b[e]; sq += v[j][e] * v[j][e]; } }
            sq = wave_sum(sq);
            const float rs = 1.0f / sqrtf(sq * (1.0f / D) + EPS);
#pragma unroll
            for (int j = 0; j < 4; ++j) { const f32x4 g0 = *(const f32x4*)(gf + (lane + 64 * j) * 8), g1 = *(const f32x4*)(gf + (lane + 64 * j) * 8 + 4);
                float* o = outp + (size_t)r * D + (lane + 64 * j) * 8;
                *(f32x4*)o = (f32x4){v[j][0] * rs * g0[0], v[j][1] * rs * g0[1], v[j][2] * rs * g0[2], v[j][3] * rs * g0[3]};
                *(f32x4*)(o + 4) = (f32x4){v[j][4] * rs * g1[0], v[j][5] * rs * g1[1], v[j][6] * rs * g1[2], v[j][7] * rs * g1[3]}; }
        }
    }
}

extern "C" void kernel_launch(void* const* d_in, const int* in_sizes, int n_in, void* d_out, int out_size, void* d_ws, size_t ws_size, hipStream_t stream) {
    static int grid_blocks = 0;
    if (grid_blocks == 0) {
        if (n_in != 33 || ws_size < WS_END) { fprintf(stderr, "kernel_launch: unexpected n_in %d or ws_size %zu (need %zu)\n", n_in, ws_size, (size_t)WS_END); grid_blocks = -1; return; }
        int dev = 0, cus = 0, per_cu = 0;
        (void)hipGetDevice(&dev);
        (void)hipDeviceGetAttribute(&cus, hipDeviceAttributeMultiprocessorCount, dev);
        if (hipFuncSetAttribute((const void*)hymba_fwd, hipFuncAttributeMaxDynamicSharedMemorySize, LDS_BYTES) != hipSuccess) { fprintf(stderr, "kernel_launch: hipFuncSetAttribute failed\n"); }
        if (hipOccupancyMaxActiveBlocksPerMultiprocessor(&per_cu, (const void*)hymba_fwd, 512, LDS_BYTES) != hipSuccess || per_cu < 1) { fprintf(stderr, "kernel_launch: occupancy query says %d\n", per_cu); per_cu = 1; }
        (void)hipGetLastError();
        grid_blocks = cus * 1;
    }
    if (grid_blocks < 0) return;
    (void)hipMemsetAsync((unsigned char*)d_ws + WS_BAR, 0, 16384, stream);
    Params p{};
    for (int i = 0; i < 33; ++i) p.in[i] = (const float*)d_in[i];
    p.out = (float*)d_out; p.ws = (unsigned char*)d_ws;
    void* args[] = {&p};
    hipError_t e = hipLaunchCooperativeKernel((const void*)hymba_fwd, dim3(grid_blocks), dim3(512), args, LDS_BYTES, stream);
    if (e != hipSuccess) fprintf(stderr, "cooperative launch failed: %s (grid %d)\n", hipGetErrorString(e), grid_blocks);
}
```

```cpp
#include <hip/hip_runtime.h>
#include <hip/hip_cooperative_groups.h>
#include <cstdio>
#include <cstdint>
namespace cg = cooperative_groups;

#ifndef N_LAYERS_RUN
#define N_LAYERS_RUN 4
#endif
#ifndef GEMM_REPS
#define GEMM_REPS 1
#endif
#ifndef MIX_REPS
#define MIX_REPS 1
#endif
#ifndef NORM_REPS
#define NORM_REPS 1
#endif
#ifndef P3_REPS
#define P3_REPS 1
#endif
#ifndef P9_REPS
#define P9_REPS 1
#endif
#ifndef SYNC_REPS
#define SYNC_REPS 1
#endif
#define GSYNC() do { for (int _r = 0; _r < SYNC_REPS; ++_r) xcd_barrier(xbar); } while (0)
#ifndef P0_REPS
#define P0_REPS 1
#endif

typedef unsigned short bf16_t;
typedef short bf16x8 __attribute__((ext_vector_type(8)));
typedef short s16x4 __attribute__((ext_vector_type(4)));
typedef float f32x4 __attribute__((ext_vector_type(4)));
typedef unsigned u32x4 __attribute__((ext_vector_type(4)));
typedef unsigned u32x2 __attribute__((ext_vector_type(2)));

constexpr int T = 8192, D = 2048, SEQ = 2048, INW = 3584, DFF = 8192, DEPTH = 4;
constexpr float EPS = 1e-6f;

constexpr size_t SZ_WIN = (size_t)INW * D * 2, SZ_WOUT = (size_t)D * D * 2, SZ_WXQ = (size_t)512 * D * 2, SZ_WXO = (size_t)D * 512 * 2,
                 SZ_WUP = (size_t)DFF * D * 2, SZ_WDN = (size_t)D * DFF * 2, SZ_WSM = (size_t)1536 * 512 * 2;
constexpr size_t WS_WIN = 0;
constexpr size_t WS_WOUT = WS_WIN + 4 * SZ_WIN;
constexpr size_t WS_WXQ = WS_WOUT + 4 * SZ_WOUT;
constexpr size_t WS_WKV = WS_WXQ + 4 * SZ_WXQ;
constexpr size_t WS_WXO = WS_WKV + (size_t)4096 * D * 2;
constexpr size_t WS_WUP = WS_WXO + 4 * SZ_WXO;
constexpr size_t WS_WDN = WS_WUP + 4 * SZ_WUP;
constexpr size_t WS_WSM = WS_WDN + 4 * SZ_WDN;
constexpr size_t WS_H = WS_WSM + 4 * SZ_WSM;
constexpr size_t WS_XN = WS_H + (size_t)T * D * 4;
constexpr size_t WS_PROJ = WS_XN + (size_t)T * D * 2;
constexpr size_t PJ_UA = 0, PJ_UB = (size_t)T * 512, PJ_UC = (size_t)2 * T * 512, PJ_QKV = (size_t)T * 2048;
constexpr size_t WS_GPH = WS_PROJ + (size_t)T * INW * 2;
constexpr size_t WS_YCAT = WS_GPH + (size_t)3 * T * 512 * 2;
constexpr size_t WS_OB = WS_YCAT + (size_t)T * 1536 * 2;
constexpr size_t WS_LSE = WS_OB + (size_t)3 * T * 512 * 2;
constexpr size_t WS_YN = WS_LSE + (size_t)3 * T * 8 * 4;
constexpr size_t WS_QX = WS_YN + (size_t)T * D * 2;
constexpr size_t WS_OX = WS_QX + (size_t)T * 512 * 2;
constexpr size_t WS_KV = WS_OX + (size_t)T * 512 * 2;
constexpr size_t WS_MEMN = WS_KV + (size_t)1024 * 4096 * 2;
constexpr size_t WS_ACT = WS_MEMN + (size_t)1024 * D * 2;
constexpr size_t WS_CARRY = WS_ACT + (size_t)T * DFF * 2;
constexpr size_t WS_DUMMY = WS_CARRY + (size_t)128 * 32 * 64 * 2 * 4;
constexpr size_t WS_BAR = WS_DUMMY + (size_t)T * D * 4;
constexpr size_t WS_SS = WS_BAR + 16384;
constexpr size_t WS_QP = WS_SS + (size_t)13 * T * 32 * 4;
constexpr size_t WS_SSG = WS_QP + (size_t)4 * T * 512 * 4;
constexpr size_t WS_END = WS_SSG + (size_t)T * 32 * 4;

constexpr int LDS_BYTES = 160 * 1024;

struct Params {
    const float* in[33];
    float* out;
    unsigned char* ws;
};

typedef const __attribute__((address_space(4))) Params* PP;
__device__ __forceinline__ PP get_pp() { PP q = (PP)__builtin_amdgcn_kernarg_segment_ptr(); asm volatile("" : "+s"(q)); return q; }
__device__ __forceinline__ int tid_fresh() { int t = threadIdx.x; asm volatile("" : "+v"(t)); return t; }
__device__ __forceinline__ int bid_fresh() { int t = blockIdx.x; asm volatile("" : "+s"(t)); return t; }
__device__ __forceinline__ float bf2f(bf16_t v) { return __uint_as_float(((unsigned)v) << 16); }
__device__ __forceinline__ bf16_t f2bf(float f) { unsigned u = __float_as_uint(f); u += 0x7FFFu + ((u >> 16) & 1u); return (bf16_t)(u >> 16); }
typedef __bf16 hbf16x2 __attribute__((ext_vector_type(2)));
typedef float hf32x2 __attribute__((ext_vector_type(2)));
__device__ __forceinline__ unsigned pk2(float lo, float hi) { const hf32x2 v = {lo, hi}; return __builtin_bit_cast(unsigned, __builtin_convertvector(v, hbf16x2)); }
__device__ __forceinline__ float wave_sum(float v) {
#pragma unroll
    for (int o = 1; o < 64; o <<= 1) v += __shfl_xor(v, o);
    return v;
}
__device__ __forceinline__ void unpack8(const u32x4 v, float (&f)[8]) {
    f[0] = __uint_as_float(v.x << 16); f[1] = __uint_as_float(v.x & 0xffff0000u); f[2] = __uint_as_float(v.y << 16); f[3] = __uint_as_float(v.y & 0xffff0000u);
    f[4] = __uint_as_float(v.z << 16); f[5] = __uint_as_float(v.z & 0xffff0000u); f[6] = __uint_as_float(v.w << 16); f[7] = __uint_as_float(v.w & 0xffff0000u);
}
__device__ __forceinline__ float sigmoidf_(float x) { return 1.0f / (1.0f + __expf(-x)); }


#define XB_TMO      128
#define XB_XCNT(j)  (256  + 64 * (j))
#define XB_XSUB(j)  (1280 + 64 * (j))
#define XB_XGEN(j)  (2304 + 64 * (j))
#define XB_TOP      3328
#define XB_TOPGEN   3392
#define XCD_BAR_WORDS 3456
#define XB_SPIN_CAP (1u << 20)
#define LAS __attribute__((address_space(3)))
__device__ __forceinline__ unsigned xb_ld(unsigned* p)              { return __hip_atomic_load(p, __ATOMIC_RELAXED, __HIP_MEMORY_SCOPE_AGENT); }
__device__ __forceinline__ unsigned xb_add(unsigned* p, unsigned v) { return __hip_atomic_fetch_add(p, v, __ATOMIC_RELAXED, __HIP_MEMORY_SCOPE_AGENT); }
__device__ __forceinline__ unsigned xb_xcc_id() { return (unsigned)__builtin_amdgcn_s_getreg((3 << 11) | 20) & 0xFu; }
#define XB_SPIN(cond, bar) do { unsigned _sp = 0; while (cond) { __builtin_amdgcn_s_sleep(1); \
    if ((++_sp & 255u) == 0u) { if (xb_ld(&(bar)[XB_TMO])) break; if (_sp > XB_SPIN_CAP) { atomicAdd(&(bar)[XB_TMO], 1u); break; } } } } while (0)
struct XcdBarrier { unsigned* bar; unsigned x; volatile LAS unsigned* st; };
__device__ __forceinline__ XcdBarrier xcd_barrier_post(unsigned* bar, volatile LAS unsigned* st) {
    XcdBarrier b; b.bar = bar; b.x = xb_xcc_id(); b.st = st;
    if (threadIdx.x == 0) (void)xb_add(&bar[XB_XCNT(b.x)], 1u);
    return b;
}
__device__ __forceinline__ void xcd_barrier_complete(unsigned* bar, unsigned x, unsigned& nloc, unsigned& nx) {
    const unsigned G = gridDim.x * gridDim.y * gridDim.z;
    unsigned sum, cnt, mine, sp = 0u;
    for (;;) {
        sum = 0u; cnt = 0u; mine = 0u;
#pragma unroll
        for (unsigned j = 0; j < 16; ++j) { const unsigned c = xb_ld(&bar[XB_XCNT(j)]); sum += c; cnt += (c > 0u) ? 1u : 0u; mine = (j == x) ? c : mine; }
        if (sum == G) break;
        __builtin_amdgcn_s_sleep(1);
        if ((++sp & 255u) == 0u) { if (xb_ld(&bar[XB_TMO])) break; if (sp > XB_SPIN_CAP) { atomicAdd(&bar[XB_TMO], 1u); break; } }
    }
    nloc = mine > 0u ? mine : 1u; nx = cnt > 0u ? cnt : 1u;
}
__device__ __forceinline__ void xcd_barrier(const XcdBarrier& b) {
    asm volatile("s_waitcnt vmcnt(0)" ::: "memory");
    __syncthreads();
    if (threadIdx.x == 0) {
        unsigned* bar = b.bar;
        __builtin_amdgcn_s_waitcnt(0);
        unsigned nloc = b.st[0], nx = b.st[1];
        if (nloc == 0u) { xcd_barrier_complete(bar, b.x, nloc, nx); b.st[0] = nloc; b.st[1] = nx; }
        const unsigned old = xb_add(&bar[XB_XSUB(b.x)], 1u);
        const unsigned gen = old / nloc;
        if (old + 1u == (gen + 1u) * nloc) {
            __builtin_amdgcn_fence(__ATOMIC_RELEASE, "agent");
            asm volatile("s_waitcnt vmcnt(0)" ::: "memory");
            const unsigned og = xb_add(&bar[XB_TOP], 1u);
            const unsigned tg = og / nx;
            if (og + 1u == (tg + 1u) * nx) xb_add(&bar[XB_TOPGEN], 1u);
            else XB_SPIN(xb_ld(&bar[XB_TOPGEN]) == tg, bar);
            __builtin_amdgcn_fence(__ATOMIC_ACQUIRE, "agent");
            xb_add(&bar[XB_XGEN(b.x)], 1u);
            asm volatile("s_waitcnt vmcnt(0)" ::: "memory");
        } else {
            XB_SPIN(xb_ld(&bar[XB_XGEN(b.x)]) == gen, bar);
            __builtin_amdgcn_fence(__ATOMIC_ACQUIRE, "agent");
            asm volatile("s_waitcnt vmcnt(0)" ::: "memory");
        }
    }
    __syncthreads();
}

namespace pg8 {
#define PG8_LAS __attribute__((address_space(3)))
constexpr int BM = 256, BK = 64, HALF = 128, HTB = HALF * BK * 2, STAGE_BYTES = 8 * HTB, NXCD = 8, WGM = 8;
__host__ __device__ __forceinline__ int lds_byte(int r, int c) { const int st = (r >> 4) * 2 + (c >> 5), rr = r & 15, cc = c & 31, ob = rr * 64 + cc * 2; return st * 1024 + (ob ^ (((ob >> 9) & 1) << 5)); }
__host__ __device__ __forceinline__ void stage_rc(int b, int& R, int& C) { const int st = b / 1024, sb = b % 1024, swz = sb ^ (((sb >> 9) & 1) << 5); R = (st >> 1) * 16 + swz / 64; C = (st & 1) * 32 + (swz % 64) / 2; }
__host__ __device__ __forceinline__ int perm32(int rho) { const int n = rho >> 4, i = rho & 15; return 8 * (i >> 2) + 4 * n + (i & 3); }
struct Unit { int pm, pn; };
struct Gemm { const bf16_t* A; const bf16_t* Bt; int M, N, K; int Kloop; };
struct StaticOrder {
    int nM, nN, nwg, G, c;
    __device__ void init(int M, int N, int G_, int c_) { nM = M / BM; nN = N / BM; nwg = nM * nN; G = G_; c = c_; }
    __device__ bool next(int i, Unit& u) const {
        const long L = (long)i * G + c; if (L >= nwg) return false;
        int wgid = (int)L; { const int q = nwg / NXCD, r = nwg % NXCD, xcd = wgid % NXCD, off = wgid / NXCD; wgid = (xcd < r ? xcd * (q + 1) : r * (q + 1) + (xcd - r) * q) + off; }
        const int nig = WGM * nN, gid = wgid / nig, fm = gid * WGM, gsz = (nM - fm) < WGM ? (nM - fm) : WGM;
        u.pm = fm + ((wgid % nig) % gsz); u.pn = (wgid % nig) / gsz; return true;
    }
    __device__ __forceinline__ size_t a_extra(const Unit&) const { return 0; }
    __device__ __forceinline__ size_t b_extra(const Unit&) const { return 0; }
};
struct SmallOrder {
    int G, c;
    __device__ bool next(int i, Unit& u) const { const int L = i * G + c; if (L >= 192) return false; u.pm = L / 6; u.pn = L % 6; return true; }
    __device__ __forceinline__ size_t a_extra(const Unit& u) const { return (size_t)(u.pn >> 1) * ((size_t)T * 512 * 2); }
    __device__ __forceinline__ size_t b_extra(const Unit&) const { return 0; }
};
struct SplitOrder {
    int G, c;
    __device__ bool next(int i, Unit& u) const { const int L = i * G + c; if (L >= 256) return false; u.pm = L >> 3; u.pn = L & 7; return true; }
    __device__ __forceinline__ size_t a_extra(const Unit& u) const { return (size_t)(u.pn >> 1) * 512 * 2; }
    __device__ __forceinline__ size_t b_extra(const Unit& u) const { return (size_t)(u.pn >> 1) * 512 * 2 - (size_t)(u.pn & ~1) * ((size_t)256 * D * 2); }
};
__device__ __forceinline__ unsigned cvt_pk_bf16(float lo, float hi) { unsigned r; asm volatile("v_cvt_pk_bf16_f32 %0, %1, %2" : "=v"(r) : "v"(lo), "v"(hi)); return r; }

template <int ACT  > struct EpiBf16 {
    static constexpr bool PERM = true;
    bf16_t* O; int ldc; float scale; const float* ss;
    __device__ __forceinline__ void operator()(const f32x4 (&acc)[2][2][4][2], const Unit& u, int wr, int wc, int fr, int fq) const {
        const int row0 = u.pm * BM + wr * 64 + fr, col0 = u.pn * BM + wc * 32 + 8 * fq;
        float rsv[2][4];
        if (ss) {
            f32x4 p0[2][4], p1[2][4];
#pragma unroll
            for (int ai = 0; ai < 2; ++ai)
#pragma unroll
                for (int m = 0; m < 4; ++m) { const float* sp = ss + (size_t)(row0 + ai * HALF + m * 16) * 32 + fq * 8; p0[ai][m] = *(const f32x4*)sp; p1[ai][m] = *(const f32x4*)(sp + 4); }
#pragma unroll
            for (int ai = 0; ai < 2; ++ai)
#pragma unroll
                for (int m = 0; m < 4; ++m) { float t = ((p0[ai][m][0] + p0[ai][m][1]) + (p0[ai][m][2] + p0[ai][m][3])) + ((p1[ai][m][0] + p1[ai][m][1]) + (p1[ai][m][2] + p1[ai][m][3]));
                    t += __shfl_xor(t, 16); t += __shfl_xor(t, 32);
                    rsv[ai][m] = scale / sqrtf(t * (1.0f / D) + EPS); }
        } else {
#pragma unroll
            for (int ai = 0; ai < 2; ++ai)
#pragma unroll
                for (int m = 0; m < 4; ++m) rsv[ai][m] = scale;
        }
#pragma unroll
        for (int ai = 0; ai < 2; ++ai)
#pragma unroll
            for (int m = 0; m < 4; ++m) { const int row = row0 + ai * HALF + m * 16; bf16_t* rowp = O + (size_t)row * ldc + col0;
                const float rs = rsv[ai][m];
#pragma unroll
                for (int bj = 0; bj < 2; ++bj) { f32x4 v0 = acc[ai][bj][m][0] * rs, v1 = acc[ai][bj][m][1] * rs;
                    if (ACT == 1) {
#pragma unroll
                        for (int e = 0; e < 4; ++e) { float a = fmaxf(v0[e], 0.f), b = fmaxf(v1[e], 0.f); v0[e] = a * a; v1[e] = b * b; } }
                    u32x4 o; o.x = cvt_pk_bf16(v0[0], v0[1]); o.y = cvt_pk_bf16(v0[2], v0[3]); o.z = cvt_pk_bf16(v1[0], v1[1]); o.w = cvt_pk_bf16(v1[2], v1[3]);
                    *(u32x4*)(rowp + bj * HALF) = o; } }
    }
};
struct EpiWin {
    static constexpr bool PERM = true;
    bf16_t* P; const float* ss;
    __device__ __forceinline__ void operator()(const f32x4 (&acc)[2][2][4][2], const Unit& u, int wr, int wc, int fr, int fq) const {
        const int row0 = u.pm * BM + wr * 64 + fr;
        float rsv[2][4];
        {
            f32x4 p0[2][4], p1[2][4];
#pragma unroll
            for (int ai = 0; ai < 2; ++ai)
#pragma unroll
                for (int m = 0; m < 4; ++m) { const float* sp = ss + (size_t)(row0 + ai * HALF + m * 16) * 32 + fq * 8; p0[ai][m] = *(const f32x4*)sp; p1[ai][m] = *(const f32x4*)(sp + 4); }
#pragma unroll
            for (int ai = 0; ai < 2; ++ai)
#pragma unroll
                for (int m = 0; m < 4; ++m) { float t = ((p0[ai][m][0] + p0[ai][m][1]) + (p0[ai][m][2] + p0[ai][m][3])) + ((p1[ai][m][0] + p1[ai][m][1]) + (p1[ai][m][2] + p1[ai][m][3]));
                    t += __shfl_xor(t, 16); t += __shfl_xor(t, 32);
                    rsv[ai][m] = 1.0f / sqrtf(t * (1.0f / D) + EPS); }
        }
#pragma unroll
        for (int ai = 0; ai < 2; ++ai)
#pragma unroll
            for (int m = 0; m < 4; ++m) { const int row = row0 + ai * HALF + m * 16; const float rs = rsv[ai][m];
#pragma unroll
                for (int bj = 0; bj < 2; ++bj) { const f32x4 v0 = acc[ai][bj][m][0] * rs, v1 = acc[ai][bj][m][1] * rs;
                    u32x4 o; o.x = cvt_pk_bf16(v0[0], v0[1]); o.y = cvt_pk_bf16(v0[2], v0[3]); o.z = cvt_pk_bf16(v1[0], v1[1]); o.w = cvt_pk_bf16(v1[2], v1[3]);
                    bf16_t* dst;
                    if (u.pn < 4) { const int colg = u.pn * BM + bj * HALF + wc * 32 + 8 * fq; dst = P + (size_t)(colg >> 9) * ((size_t)T * 512) + (size_t)row * 512 + (colg & 511); }
                    else if (u.pn < 8) { const int colc = (u.pn - 4) * BM + bj * HALF + wc * 32 + 8 * fq; dst = P + PJ_UC + (size_t)row * 1024 + colc; }
                    else { const int which = (u.pn - 8) >> 1, hd = ((u.pn - 8) & 1) * 4 + 2 * bj + (wc >> 1), dim = 32 * (wc & 1) + 8 * fq, bb = row >> 11, ll = row & 2047;
                        dst = P + PJ_QKV + ((size_t)(((which * 4 + bb) * 8 + hd) * SEQ + ll)) * 64 + dim; }
                    *(u32x4*)dst = o; } }
    }
};
template <int MB  > struct EpiRes {
    static constexpr bool PERM = false;
    const float* Hin; float* Hout; bf16_t* Hb; float* ss; const float* ssin;
    __device__ __forceinline__ void operator()(const f32x4 (&acc)[2][2][4][2], const Unit& u, int wr, int wc, int fr, int fq) const {
        const int row0 = u.pm * BM + wr * 64 + fr, col0 = u.pn * BM + wc * 32 + 4 * fq;
        float rsc[2][4];
        if (ssin) {
#pragma unroll
            for (int ai = 0; ai < 2; ++ai) {
                f32x4 q0[4], q1[4];
#pragma unroll
                for (int m = 0; m < 4; ++m) { const float* sp = ssin + (size_t)(row0 + ai * HALF + m * 16) * 32 + fq * 8; q0[m] = *(const f32x4*)sp; q1[m] = *(const f32x4*)(sp + 4); }
#pragma unroll
                for (int m = 0; m < 4; ++m) { float t = ((q0[m][0] + q0[m][1]) + (q0[m][2] + q0[m][3])) + ((q1[m][0] + q1[m][1]) + (q1[m][2] + q1[m][3]));
                    t += __shfl_xor(t, 16); t += __shfl_xor(t, 32); rsc[ai][m] = 1.0f / (t * (1.0f / D) + EPS); }
                asm volatile("" ::: "memory");
            }
        } else {
#pragma unroll
            for (int ai = 0; ai < 2; ++ai)
#pragma unroll
                for (int m = 0; m < 4; ++m) rsc[ai][m] = 1.0f;
        }
#pragma unroll
        for (int ai = 0; ai < 2; ++ai)
#pragma unroll
        for (int mh = 0; mh < 4; mh += MB) {
            f32x4 hv[MB][2][2];
#pragma unroll
            for (int m = 0; m < MB; ++m)
#pragma unroll
                for (int bj = 0; bj < 2; ++bj)
#pragma unroll
                    for (int n = 0; n < 2; ++n) hv[m][bj][n] = *(const f32x4*)(Hin + (size_t)(row0 + ai * HALF + (mh + m) * 16) * D + col0 + bj * HALF + n * 16);
#pragma unroll
            for (int m = 0; m < MB; ++m) { const int row = row0 + ai * HALF + (mh + m) * 16; const size_t off = (size_t)row * D + col0; float sq = 0.f;
                const float rs1 = rsc[ai][mh + m];
#pragma unroll
                for (int bj = 0; bj < 2; ++bj)
#pragma unroll
                    for (int n = 0; n < 2; ++n) { const size_t idx = off + bj * HALF + n * 16; const f32x4 o = hv[m][bj][n] + acc[ai][bj][mh + m][n] * rs1;
                        *(f32x4*)(Hout + idx) = o; sq += o[0] * o[0] + o[1] * o[1] + o[2] * o[2] + o[3] * o[3];
                        if (Hb) { u32x2 w; w.x = cvt_pk_bf16(o[0], o[1]); w.y = cvt_pk_bf16(o[2], o[3]); *(u32x2*)(Hb + idx) = w; } }
                if (ss) { sq += __shfl_xor(sq, 16); sq += __shfl_xor(sq, 32); if (fq == 0) ss[(size_t)row * 32 + u.pn * 4 + wc] = sq; } }
        }
    }
    __device__ __forceinline__ void gs(const f32x4 (&acc)[2][2][4][2], const Unit& u, int wr, int wc, int fr, int fq, const PG8_LAS float* rtab) const {
        const int row0 = u.pm * BM + wr * 64 + fr, col0 = u.pn * BM + wc * 32 + 4 * fq;
#pragma unroll
        for (int ai = 0; ai < 2; ++ai)
#pragma unroll
        for (int mh = 0; mh < 4; mh += MB) {
            f32x4 hv[MB][2][2];
#pragma unroll
            for (int m = 0; m < MB; ++m)
#pragma unroll
                for (int bj = 0; bj < 2; ++bj)
#pragma unroll
                    for (int n = 0; n < 2; ++n) hv[m][bj][n] = *(const f32x4*)(Hin + (size_t)(row0 + ai * HALF + (mh + m) * 16) * D + col0 + bj * HALF + n * 16);
#pragma unroll
            for (int m = 0; m < MB; ++m) { const int rl = ai * HALF + wr * 64 + (mh + m) * 16 + fr, row = u.pm * BM + rl; const size_t off = (size_t)row * D + col0; float sq = 0.f;
                const float rs1 = rtab[3 * 256 + rl];
#pragma unroll
                for (int bj = 0; bj < 2; ++bj)
#pragma unroll
                    for (int n = 0; n < 2; ++n) { const size_t idx = off + bj * HALF + n * 16; const f32x4 o = hv[m][bj][n] + acc[ai][bj][mh + m][n] * rs1;
                        *(f32x4*)(Hout + idx) = o; sq += o[0] * o[0] + o[1] * o[1] + o[2] * o[2] + o[3] * o[3];
                        if (Hb) { u32x2 w; w.x = cvt_pk_bf16(o[0], o[1]); w.y = cvt_pk_bf16(o[2], o[3]); *(u32x2*)(Hb + idx) = w; } }
                if (ss) { sq += __shfl_xor(sq, 16); sq += __shfl_xor(sq, 32); if (fq == 0) ss[(size_t)row * 32 + u.pn * 4 + wc] = sq; } }
        }
    }
};
template <int MB  , bool F32IN> struct EpiRes2 {
    static constexpr bool PERM = true;
    const float* Xin; bf16_t* Hb; bf16_t* Hl; float* ss; const float* ssin;
    __device__ __forceinline__ void core(const f32x4 (&acc)[2][2][4][2], const Unit& u, int wr, int wc, int fr, int fq, const float (&rsc)[2][4]) const {
        const int row0 = u.pm * BM + wr * 64 + fr, col0 = u.pn * BM + wc * 32 + 8 * fq;
#pragma unroll
        for (int ai = 0; ai < 2; ++ai)
#pragma unroll
        for (int mh = 0; mh < 4; mh += MB) {
            u32x4 va[MB][2], vb[MB][2];
            f32x4 xa[MB][2], xb[MB][2];
#pragma unroll
            for (int m = 0; m < MB; ++m)
#pragma unroll
                for (int bj = 0; bj < 2; ++bj) { const size_t idx = (size_t)(row0 + ai * HALF + (mh + m) * 16) * D + col0 + bj * HALF;
                    if (F32IN) { xa[m][bj] = *(const f32x4*)(Xin + idx); xb[m][bj] = *(const f32x4*)(Xin + idx + 4); }
                    else { va[m][bj] = *(const u32x4*)(Hb + idx); vb[m][bj] = *(const u32x4*)(Hl + idx); } }
#pragma unroll
            for (int m = 0; m < MB; ++m) { const int row = row0 + ai * HALF + (mh + m) * 16; float sq = 0.f;
                const float rs1 = rsc[ai][mh + m];
#pragma unroll
                for (int bj = 0; bj < 2; ++bj) { const size_t idx = (size_t)row * D + col0 + bj * HALF;
                    float h[8];
                    if (F32IN) { h[0] = xa[m][bj][0]; h[1] = xa[m][bj][1]; h[2] = xa[m][bj][2]; h[3] = xa[m][bj][3]; h[4] = xb[m][bj][0]; h[5] = xb[m][bj][1]; h[6] = xb[m][bj][2]; h[7] = xb[m][bj][3]; }
                    else { const u32x4 a = va[m][bj], b = vb[m][bj];
                        h[0] = __uint_as_float(a.x << 16) + __uint_as_float(b.x << 16); h[1] = __uint_as_float(a.x & 0xffff0000u) + __uint_as_float(b.x & 0xffff0000u);
                        h[2] = __uint_as_float(a.y << 16) + __uint_as_float(b.y << 16); h[3] = __uint_as_float(a.y & 0xffff0000u) + __uint_as_float(b.y & 0xffff0000u);
                        h[4] = __uint_as_float(a.z << 16) + __uint_as_float(b.z << 16); h[5] = __uint_as_float(a.z & 0xffff0000u) + __uint_as_float(b.z & 0xffff0000u);
                        h[6] = __uint_as_float(a.w << 16) + __uint_as_float(b.w << 16); h[7] = __uint_as_float(a.w & 0xffff0000u) + __uint_as_float(b.w & 0xffff0000u); }
                    float o[8];
#pragma unroll
                    for (int e = 0; e < 8; ++e) { o[e] = h[e] + acc[ai][bj][mh + m][e >> 2][e & 3] * rs1; sq += o[e] * o[e]; }
                    u32x4 hi; hi.x = cvt_pk_bf16(o[0], o[1]); hi.y = cvt_pk_bf16(o[2], o[3]); hi.z = cvt_pk_bf16(o[4], o[5]); hi.w = cvt_pk_bf16(o[6], o[7]);
                    u32x4 lo;
                    lo.x = cvt_pk_bf16(o[0] - __uint_as_float(hi.x << 16), o[1] - __uint_as_float(hi.x & 0xffff0000u));
                    lo.y = cvt_pk_bf16(o[2] - __uint_as_float(hi.y << 16), o[3] - __uint_as_float(hi.y & 0xffff0000u));
                    lo.z = cvt_pk_bf16(o[4] - __uint_as_float(hi.z << 16), o[5] - __uint_as_float(hi.z & 0xffff0000u));
                    lo.w = cvt_pk_bf16(o[6] - __uint_as_float(hi.w << 16), o[7] - __uint_as_float(hi.w & 0xffff0000u));
                    *(u32x4*)(Hb + idx) = hi; *(u32x4*)(Hl + idx) = lo; }
                sq += __shfl_xor(sq, 16); sq += __shfl_xor(sq, 32); if (fq == 0) ss[(size_t)row * 32 + u.pn * 4 + wc] = sq; }
        }
    }
    __device__ __forceinline__ void operator()(const f32x4 (&acc)[2][2][4][2], const Unit& u, int wr, int wc, int fr, int fq) const {
        const int row0 = u.pm * BM + wr * 64 + fr;
        float rsc[2][4];
        if (ssin) {
#pragma unroll
            for (int ai = 0; ai < 2; ++ai) {
                f32x4 q0[4], q1[4];
#pragma unroll
                for (int m = 0; m < 4; ++m) { const float* sp = ssin + (size_t)(row0 + ai * HALF + m * 16) * 32 + fq * 8; q0[m] = *(const f32x4*)sp; q1[m] = *(const f32x4*)(sp + 4); }
#pragma unroll
                for (int m = 0; m < 4; ++m) { float t = ((q0[m][0] + q0[m][1]) + (q0[m][2] + q0[m][3])) + ((q1[m][0] + q1[m][1]) + (q1[m][2] + q1[m][3]));
                    t += __shfl_xor(t, 16); t += __shfl_xor(t, 32); rsc[ai][m] = 1.0f / (t * (1.0f / D) + EPS); }
                asm volatile("" ::: "memory");
            }
        } else {
#pragma unroll
            for (int ai = 0; ai < 2; ++ai)
#pragma unroll
                for (int m = 0; m < 4; ++m) rsc[ai][m] = 1.0f;
        }
        core(acc, u, wr, wc, fr, fq, rsc);
    }
    __device__ __forceinline__ void gs(const f32x4 (&acc)[2][2][4][2], const Unit& u, int wr, int wc, int fr, int fq, const PG8_LAS float* rtab) const {
        float rsc[2][4];
#pragma unroll
        for (int ai = 0; ai < 2; ++ai)
#pragma unroll
            for (int m = 0; m < 4; ++m) rsc[ai][m] = rtab[3 * 256 + ai * HALF + wr * 64 + m * 16 + fr];
        core(acc, u, wr, wc, fr, fq, rsc);
    }
};
struct EpiPart {
    static constexpr bool PERM = true;
    bf16_t* Q;
    __device__ __forceinline__ void operator()(const f32x4 (&acc)[2][2][4][2], const Unit& u, int wr, int wc, int fr, int fq) const {
        const int row0 = u.pm * BM + wr * 64 + fr, col0 = (u.pn & 1) * BM + wc * 32 + 8 * fq;
        bf16_t* base = Q + (size_t)(u.pn >> 1) * ((size_t)T * 512);
#pragma unroll
        for (int ai = 0; ai < 2; ++ai)
#pragma unroll
            for (int m = 0; m < 4; ++m) { bf16_t* rowp = base + (size_t)(row0 + ai * HALF + m * 16) * 512 + col0;
#pragma unroll
                for (int bj = 0; bj < 2; ++bj) { const f32x4 v0 = acc[ai][bj][m][0], v1 = acc[ai][bj][m][1];
                    u32x4 o; o.x = cvt_pk_bf16(v0[0], v0[1]); o.y = cvt_pk_bf16(v0[2], v0[3]); o.z = cvt_pk_bf16(v1[0], v1[1]); o.w = cvt_pk_bf16(v1[2], v1[3]);
                    *(u32x4*)(rowp + bj * HALF) = o; } }
    }
};
struct EpiSmall {
    static constexpr bool PERM = true;
    bf16_t* Y; const bf16_t* Gm; const float* pscale; float* ssg;
    __device__ __forceinline__ void operator()(const f32x4 (&acc)[2][2][4][2], const Unit& u, int wr, int wc, int fr, int fq) const {
        const int kind = u.pn >> 1;
        const int row0 = u.pm * BM + wr * 64 + fr, colk = (u.pn & 1) * BM + wc * 32 + 8 * fq;
        f32x4 ps[2][2];
        if (kind == 1) {
#pragma unroll
            for (int bj = 0; bj < 2; ++bj) { ps[bj][0] = *(const f32x4*)(pscale + colk + bj * HALF); ps[bj][1] = *(const f32x4*)(pscale + colk + bj * HALF + 4); } }
#pragma unroll
        for (int ai = 0; ai < 2; ++ai) {
            u32x4 gv[4][2];
            if (kind == 0) {
#pragma unroll
                for (int m = 0; m < 4; ++m)
#pragma unroll
                    for (int bj = 0; bj < 2; ++bj) gv[m][bj] = *(const u32x4*)(Gm + (size_t)(row0 + ai * HALF + m * 16) * 512 + colk + bj * HALF); }
#pragma unroll
            for (int m = 0; m < 4; ++m) { const int row = row0 + ai * HALF + m * 16; float sq = 0.f;
#pragma unroll
                for (int bj = 0; bj < 2; ++bj) { f32x4 v0 = acc[ai][bj][m][0], v1 = acc[ai][bj][m][1]; const int c = colk + bj * HALF;
                    if (kind == 0) { const u32x4 g4 = gv[m][bj];
                        float g[8]; g[0] = __uint_as_float(g4.x << 16); g[1] = __uint_as_float(g4.x & 0xffff0000u); g[2] = __uint_as_float(g4.y << 16); g[3] = __uint_as_float(g4.y & 0xffff0000u);
                        g[4] = __uint_as_float(g4.z << 16); g[5] = __uint_as_float(g4.z & 0xffff0000u); g[6] = __uint_as_float(g4.w << 16); g[7] = __uint_as_float(g4.w & 0xffff0000u);
#pragma unroll
                        for (int e = 0; e < 4; ++e) { v0[e] = g[e] * sigmoidf_(v0[e]); v1[e] = g[4 + e] * sigmoidf_(v1[e]); } }
                    else if (kind == 1) { v0 = v0 * ps[bj][0]; v1 = v1 * ps[bj][1]; }
                    sq += (v0[0] * v0[0] + v0[1] * v0[1]) + (v0[2] * v0[2] + v0[3] * v0[3]) + (v1[0] * v1[0] + v1[1] * v1[1]) + (v1[2] * v1[2] + v1[3] * v1[3]);
                    u32x4 o; o.x = cvt_pk_bf16(v0[0], v0[1]); o.y = cvt_pk_bf16(v0[2], v0[3]); o.z = cvt_pk_bf16(v1[0], v1[1]); o.w = cvt_pk_bf16(v1[2], v1[3]);
                    *(u32x4*)(Y + (size_t)row * D + kind * 512 + c) = o; }
                sq += __shfl_xor(sq, 16); sq += __shfl_xor(sq, 32);
                if (fq == 0) ssg[(size_t)row * 32 + kind * 8 + (u.pn & 1) * 4 + wc] = sq; }
        }
    }
};

struct WinKvOrder {
    StaticOrder so; size_t a_delta, b_delta;
    __device__ bool next(int i, Unit& u) const {
        if (so.next(i, u)) return true;
        const int L = i * so.G + so.c - so.nwg; if (L >= 64) return false;
        u.pm = L & 3; u.pn = 14 + (L >> 2); return true;
    }
    __device__ __forceinline__ size_t a_extra(const Unit& u) const { return u.pn >= 14 ? a_delta : 0; }
    __device__ __forceinline__ size_t b_extra(const Unit& u) const { return u.pn >= 14 ? b_delta - (size_t)14 * ((size_t)256 * D * 2) : 0; }
};
struct EpiWinKv {
    static constexpr bool PERM = true;
    EpiWin win; EpiBf16<0> kv;
    __device__ __forceinline__ void operator()(const f32x4 (&acc)[2][2][4][2], const Unit& u, int wr, int wc, int fr, int fq) const {
        if (u.pn >= 14) { Unit v; v.pm = u.pm; v.pn = u.pn - 14; kv(acc, v, wr, wc, fr, fq); } else win(acc, u, wr, wc, fr, fq);
    }
};
template <class Epi, class Sched, bool ALIGN_EPI = true, bool SP2 = true, bool GS = false>
__device__ __forceinline__ void gemm_phase(PG8_LAS unsigned char* lds, const Gemm g, const Sched& S, const Epi& E, const float* gs_ss = nullptr) {
    const int tid = tid_fresh(), wid = __builtin_amdgcn_readfirstlane(tid >> 6), lane = tid & 63, wr = wid >> 2, wc = wid & 3, fr = lane & 15, fq = lane >> 4;
    const int K = g.K, nt = g.Kloop / BK;
    unsigned voffA[2], voffB[2];
#pragma unroll
    for (int i = 0; i < 2; ++i) { int R, C; stage_rc(tid * 16 + i * 8192, R, C); const int Rb = Epi::PERM ? ((R & ~31) + perm32(R & 31)) : R;
        voffA[i] = (unsigned)(R * K + C) * 2u; voffB[i] = (unsigned)(Rb * K + C) * 2u; }
    const size_t kstep = (size_t)(BK * 2);
    const size_t hstep = (size_t)HALF * K * 2;
    const size_t tstep = 2 * hstep;
    const unsigned ldsw = (unsigned)wid * 1024u;
    const int aoff = lds_byte(wr * 64 + fr, fq * 8), boff = lds_byte(wc * 32 + fr, fq * 8);
#define PG8_GS_BUILD(uu, par) do { if constexpr (GS) { const int _row = tid >> 1, _g0 = (tid & 1) * 2; \
        const float* _sp = gs_ss + ((size_t)((uu).pm * BM + _row)) * 32 + _g0 * 8; \
        const f32x4 _a0 = *(const f32x4*)_sp, _a1 = *(const f32x4*)(_sp + 4), _b0 = *(const f32x4*)(_sp + 8), _b1 = *(const f32x4*)(_sp + 12); \
        const float _s0 = ((_a0[0] + _a0[1]) + (_a0[2] + _a0[3])) + ((_a1[0] + _a1[1]) + (_a1[2] + _a1[3])), _s1 = ((_b0[0] + _b0[1]) + (_b0[2] + _b0[3])) + ((_b1[0] + _b1[1]) + (_b1[2] + _b1[3])); \
        PG8_LAS float* _t = (PG8_LAS float*)(lds + STAGE_BYTES + (par) * 4096); \
        _t[_g0 * 256 + _row] = 1.0f / sqrtf(_s0 * (1.0f / 512.0f) + EPS); _t[(_g0 + 1) * 256 + _row] = 1.0f / sqrtf(_s1 * (1.0f / 512.0f) + EPS); } } while (0)
#define PG8_GS_SCALE(gb, par) do { if constexpr (GS) { const PG8_LAS float* _t = (const PG8_LAS float*)(lds + STAGE_BYTES + (par) * 4096); \
        _Pragma("unroll") for (int _ai = 0; _ai < 2; ++_ai) _Pragma("unroll") for (int _m = 0; _m < 4; ++_m) { const int _rl = _ai * HALF + wr * 64 + _m * 16 + fr; \
            const float _f = _t[(gb) * 256 + _rl] / _t[((gb) + 1) * 256 + _rl]; \
            _Pragma("unroll") for (int _bj = 0; _bj < 2; ++_bj) _Pragma("unroll") for (int _n = 0; _n < 2; ++_n) acc[_ai][_bj][_m][_n] = acc[_ai][_bj][_m][_n] * _f; } } } while (0)
#define PG8_SA(b, h) (((b) * 2 + (h)) * HTB)
#define PG8_SB(b, h) ((4 + (b) * 2 + (h)) * HTB)
#define PG8_STAGE(bufoff, gbase, voff) do { _Pragma("unroll") for (int _i = 0; _i < 2; ++_i) \
        __builtin_amdgcn_global_load_lds((const unsigned*)((const char*)(gbase) + (voff)[_i]), (PG8_LAS unsigned*)(lds + (bufoff) + ldsw + _i * 8192), 16, 0, 0); } while (0)
#define PG8_LDA(dst, b, h) do { _Pragma("unroll") for (int m = 0; m < 4; ++m) _Pragma("unroll") for (int k = 0; k < 2; ++k) dst[m][k] = *(const PG8_LAS bf16x8*)(lds + PG8_SA(b, h) + aoff + m * 2048 + k * 1024); } while (0)
#define PG8_LDB(dst, b, h) do { _Pragma("unroll") for (int n = 0; n < 2; ++n) _Pragma("unroll") for (int k = 0; k < 2; ++k) dst[n][k] = *(const PG8_LAS bf16x8*)(lds + PG8_SB(b, h) + boff + n * 2048 + k * 1024); } while (0)
#define PG8_MMA(ai, bj, At, Bt) do { __builtin_amdgcn_s_setprio(1); _Pragma("unroll") for (int m = 0; m < 4; ++m) _Pragma("unroll") for (int n = 0; n < 2; ++n) _Pragma("unroll") for (int k = 0; k < 2; ++k) \
        acc[ai][bj][m][n] = __builtin_amdgcn_mfma_f32_16x16x32_bf16(Bt[n][k], At[m][k], acc[ai][bj][m][n], 0, 0, 0); __builtin_amdgcn_s_setprio(0); } while (0)
#define PG8_WAIT_V(n) asm volatile("s_waitcnt vmcnt(" #n ")" ::: "memory")
#define PG8_WAIT_L(n) asm volatile("s_waitcnt lgkmcnt(" #n ")" ::: "memory")
#define PG8_BAR __builtin_amdgcn_s_barrier()
#define PG8_SCHED __builtin_amdgcn_sched_barrier(0)
    Unit cur, nxt; int ui = 0;
    if (!S.next(0, cur)) return;
    f32x4 acc[2][2][4][2];
#pragma unroll
    for (int a = 0; a < 2; ++a)
#pragma unroll
        for (int b = 0; b < 2; ++b)
#pragma unroll
            for (int m = 0; m < 4; ++m)
#pragma unroll
                for (int n = 0; n < 2; ++n) acc[a][b][m][n] = (f32x4){0.f, 0.f, 0.f, 0.f};
    bf16x8 At[4][2], B0[2][2], B1[2][2];
    const char* cA = (const char*)g.A + S.a_extra(cur) + (size_t)cur.pm * tstep; const char* cB = (const char*)g.Bt + S.b_extra(cur) + (size_t)cur.pn * tstep;
    int gpar = 0;
    PG8_GS_BUILD(cur, 0);
    if constexpr (SP2) {
        PG8_STAGE(PG8_SB(0, 0), cB, voffB); PG8_STAGE(PG8_SB(0, 1), cB + hstep, voffB); PG8_STAGE(PG8_SA(0, 0), cA, voffA); PG8_STAGE(PG8_SA(0, 1), cA + hstep, voffA);
        if (wr == 1) PG8_BAR;
        PG8_WAIT_V(2); PG8_BAR;
        PG8_STAGE(PG8_SB(1, 0), cB + kstep, voffB); PG8_STAGE(PG8_SA(1, 0), cA + kstep, voffA); PG8_STAGE(PG8_SB(1, 1), cB + hstep + kstep, voffB);
        PG8_WAIT_V(6); PG8_BAR;
    } else {
        PG8_STAGE(PG8_SB(0, 0), cB, voffB); PG8_STAGE(PG8_SA(0, 0), cA, voffA); PG8_STAGE(PG8_SB(0, 1), cB + hstep, voffB); PG8_STAGE(PG8_SA(0, 1), cA + hstep, voffA);
        if (wr == 1) PG8_BAR;
        PG8_WAIT_V(4); PG8_BAR;
        PG8_STAGE(PG8_SB(1, 0), cB + kstep, voffB); PG8_STAGE(PG8_SA(1, 0), cA + kstep, voffA); PG8_STAGE(PG8_SB(1, 1), cB + hstep + kstep, voffB);
        PG8_WAIT_V(6); PG8_BAR;
    }
    for (;;) {
        const bool has_next = S.next(ui + 1, nxt);
        const char* nA = has_next ? (const char*)g.A + S.a_extra(nxt) + (size_t)nxt.pm * tstep : cA; const char* nB = has_next ? (const char*)g.Bt + S.b_extra(nxt) + (size_t)nxt.pn * tstep : cB;
        for (int t = 0; t < nt; t += 2) {
            const bool last = (t == nt - 2);
            const char* a1 = cA + (size_t)(t + 1) * kstep;
            const char* a2 = last ? nA : cA + (size_t)(t + 2) * kstep; const char* b2 = last ? nB : cB + (size_t)(t + 2) * kstep;
            const char* a3 = a2 + kstep; const char* b3 = b2 + kstep;
            if constexpr (SP2) {
            PG8_LDB(B0, 0, 0); PG8_LDB(B1, 0, 1); PG8_SCHED; PG8_LDA(At, 0, 0); PG8_STAGE(PG8_SA(1, 1), a1 + hstep, voffA);
            PG8_WAIT_V(8); PG8_WAIT_L(0); PG8_BAR; PG8_MMA(0, 0, At, B0); PG8_MMA(0, 1, At, B1); PG8_BAR; PG8_SCHED;
            PG8_LDA(At, 0, 1); PG8_STAGE(PG8_SB(0, 0), b2, voffB); PG8_STAGE(PG8_SB(0, 1), b2 + hstep, voffB); PG8_STAGE(PG8_SA(0, 0), a2, voffA);
            PG8_WAIT_V(8); PG8_WAIT_L(0); PG8_BAR; PG8_MMA(1, 0, At, B0); PG8_MMA(1, 1, At, B1); PG8_BAR; PG8_SCHED;
            PG8_LDB(B0, 1, 0); PG8_LDB(B1, 1, 1); PG8_SCHED; PG8_LDA(At, 1, 0); PG8_STAGE(PG8_SA(0, 1), a2 + hstep, voffA);
            PG8_WAIT_V(8); PG8_WAIT_L(0); PG8_BAR; PG8_MMA(0, 0, At, B0); PG8_MMA(0, 1, At, B1); PG8_BAR; PG8_SCHED;
            PG8_LDA(At, 1, 1); PG8_STAGE(PG8_SB(1, 0), b3, voffB); PG8_STAGE(PG8_SB(1, 1), b3 + hstep, voffB); PG8_STAGE(PG8_SA(1, 0), a3, voffA);
            PG8_WAIT_V(8); PG8_WAIT_L(0); PG8_BAR; PG8_MMA(1, 0, At, B0); PG8_MMA(1, 1, At, B1); PG8_BAR; PG8_SCHED;
            } else {
            PG8_LDB(B0, 0, 0); PG8_SCHED; PG8_LDA(At, 0, 0); PG8_STAGE(PG8_SA(1, 1), a1 + hstep, voffA);
            PG8_WAIT_L(8); PG8_BAR; PG8_WAIT_L(0); PG8_MMA(0, 0, At, B0); PG8_BAR; PG8_SCHED;
            PG8_LDB(B1, 0, 1); PG8_STAGE(PG8_SB(0, 0), b2, voffB);
            PG8_BAR; PG8_WAIT_L(0); PG8_MMA(0, 1, At, B1); PG8_BAR;
            PG8_LDA(At, 0, 1); PG8_STAGE(PG8_SA(0, 0), a2, voffA);
            PG8_BAR; PG8_WAIT_L(0); PG8_MMA(1, 0, At, B0); PG8_BAR; PG8_SCHED;
            PG8_STAGE(PG8_SB(0, 1), b2 + hstep, voffB);
            PG8_WAIT_V(6); PG8_BAR; PG8_MMA(1, 1, At, B1); PG8_BAR;
            PG8_LDB(B0, 1, 0); PG8_SCHED; PG8_LDA(At, 1, 0); PG8_STAGE(PG8_SA(0, 1), a2 + hstep, voffA);
            PG8_WAIT_L(8); PG8_BAR; PG8_WAIT_L(0); PG8_MMA(0, 0, At, B0); PG8_BAR; PG8_SCHED;
            PG8_LDB(B1, 1, 1); PG8_STAGE(PG8_SB(1, 0), b3, voffB);
            PG8_BAR; PG8_WAIT_L(0); PG8_MMA(0, 1, At, B1); PG8_BAR;
            PG8_LDA(At, 1, 1); PG8_STAGE(PG8_SA(1, 0), a3, voffA);
            PG8_BAR; PG8_WAIT_L(0); PG8_MMA(1, 0, At, B0); PG8_BAR; PG8_SCHED;
            PG8_STAGE(PG8_SB(1, 1), b3 + hstep, voffB);
            PG8_WAIT_V(6); PG8_BAR; PG8_MMA(1, 1, At, B1); PG8_BAR;
                    }
            if constexpr (GS) { if ((t & 7) == 6 && !last) { PG8_GS_SCALE(t >> 3, gpar); } }
        }
        if constexpr (ALIGN_EPI) { if (wr == 0) PG8_BAR; }
        if constexpr (GS) E.gs(acc, cur, wr, wc, fr, fq, (const PG8_LAS float*)(lds + STAGE_BYTES + gpar * 4096)); else E(acc, cur, wr, wc, fr, fq);
        if (!has_next) break;
#pragma unroll
        for (int a = 0; a < 2; ++a)
#pragma unroll
            for (int b = 0; b < 2; ++b)
#pragma unroll
                for (int m = 0; m < 4; ++m)
#pragma unroll
                    for (int n = 0; n < 2; ++n) acc[a][b][m][n] = (f32x4){0.f, 0.f, 0.f, 0.f};
        cur = nxt; cA = nA; cB = nB; ++ui;
        if constexpr (GS) { gpar ^= 1; PG8_GS_BUILD(cur, gpar); }
        if constexpr (ALIGN_EPI) { if (wr == 1) PG8_BAR; }
    }
    PG8_WAIT_V(0);
    if constexpr (!ALIGN_EPI) { if (wr == 0) PG8_BAR; }
    PG8_BAR;
#undef PG8_GS_BUILD
#undef PG8_GS_SCALE
#undef PG8_SA
#undef PG8_SB
#undef PG8_STAGE
#undef PG8_LDA
#undef PG8_LDB
#undef PG8_MMA
#undef PG8_WAIT_V
#undef PG8_WAIT_L
#undef PG8_BAR
#undef PG8_SCHED
}
}

template <class Epi>
__device__ __forceinline__ void run_gemm(unsigned char* shm, const bf16_t* A, const bf16_t* Bt, int M, int N, int K, const Epi& E) {
    pg8::StaticOrder S; S.init(M, N, (int)gridDim.x, (int)bid_fresh());
    pg8::Gemm g{A, Bt, M, N, K, K};
    pg8::gemm_phase<Epi, pg8::StaticOrder>((PG8_LAS unsigned char*)shm, g, S, E);
}

__device__ __forceinline__ void tconv_tile(const float* src, int N, int kb, int nb, bf16_t* dst, int ldd, float* tile, const float* kscale = nullptr) {
    const int tid = tid_fresh();
#pragma unroll
    for (int p = 0; p < 2; ++p) {
        const int r = (tid >> 4) + p * 32, c4 = tid & 15;
        f32x4 v = *(const f32x4*)(src + (size_t)(kb * 64 + r) * N + nb * 64 + c4 * 4);
        if (kscale) v = v * kscale[kb * 64 + r];
        float* t = tile + r * 65 + c4 * 4; t[0] = v[0]; t[1] = v[1]; t[2] = v[2]; t[3] = v[3];
    }
    __syncthreads();
    const int n = tid >> 3, k8 = tid & 7;
    const float* s = tile + (k8 * 8) * 65 + n;
    u32x4 o; o.x = pk2(s[0], s[65]); o.y = pk2(s[2 * 65], s[3 * 65]); o.z = pk2(s[4 * 65], s[5 * 65]); o.w = pk2(s[6 * 65], s[7 * 65]);
    *(u32x4*)(dst + (size_t)(nb * 64 + n) * ldd + kb * 64 + k8 * 8) = o;
    __syncthreads();
}

__device__ __forceinline__ void tconv_tile_w(const float* src, int N, int kb, int nb, bf16_t* dst, int ldd, float* tile, const float* kscale = nullptr) {
    const int tid = tid_fresh();
    f32x4 v[8];
#pragma unroll
    for (int p = 0; p < 8; ++p) { const int idx = tid + 512 * p, r = idx >> 6, c4 = idx & 63;
        v[p] = __builtin_nontemporal_load((const f32x4*)(src + (size_t)(kb * 64 + r) * N + nb * 256 + c4 * 4)); }
    if (kscale) {
#pragma unroll
        for (int p = 0; p < 8; ++p) v[p] = v[p] * kscale[kb * 64 + ((tid + 512 * p) >> 6)];
    }
#pragma unroll
    for (int p = 0; p < 8; ++p) { const int idx = tid + 512 * p, r = idx >> 6, c4 = idx & 63;
        float* t = tile + r * 257 + c4 * 4; t[0] = v[p][0]; t[1] = v[p][1]; t[2] = v[p][2]; t[3] = v[p][3]; }
    __syncthreads();
#pragma unroll
    for (int q = 0; q < 4; ++q) { const int id = tid + 512 * q, n = id >> 3, k8 = id & 7;
        const float* s = tile + (k8 * 8) * 257 + n;
        u32x4 o; o.x = pk2(s[0], s[257]); o.y = pk2(s[2 * 257], s[3 * 257]); o.z = pk2(s[4 * 257], s[5 * 257]); o.w = pk2(s[6 * 257], s[7 * 257]);
        *(u32x4*)(dst + (size_t)(nb * 256 + n) * ldd + kb * 64 + k8 * 8) = o; }
    __syncthreads();
}

__device__ __forceinline__ void rms_row_bf16(const float* x, const float* g, bf16_t* o, int lane) {
    f32x4 v[8]; float ss = 0.f;
#pragma unroll
    for (int j = 0; j < 8; ++j) { v[j] = ((const f32x4*)x)[lane + 64 * j]; ss += v[j][0] * v[j][0] + v[j][1] * v[j][1] + v[j][2] * v[j][2] + v[j][3] * v[j][3]; }
    ss = wave_sum(ss);
    const float rs = 1.0f / sqrtf(ss * (1.0f / D) + EPS);
#pragma unroll
    for (int j = 0; j < 8; ++j) { const f32x4 gg = ((const f32x4*)g)[lane + 64 * j];
        u32x2 w; w.x = pk2(v[j][0] * rs * gg[0], v[j][1] * rs * gg[1]); w.y = pk2(v[j][2] * rs * gg[2], v[j][3] * rs * gg[3]);
        ((u32x2*)o)[lane + 64 * j] = w; }
}
__device__ __forceinline__ void rms_row_f32(const float* x, const float* g, float* o, int lane) {
    f32x4 v[8]; float ss = 0.f;
#pragma unroll
    for (int j = 0; j < 8; ++j) { v[j] = ((const f32x4*)x)[lane + 64 * j]; ss += v[j][0] * v[j][0] + v[j][1] * v[j][1] + v[j][2] * v[j][2] + v[j][3] * v[j][3]; }
    ss = wave_sum(ss);
    const float rs = 1.0f / sqrtf(ss * (1.0f / D) + EPS);
#pragma unroll
    for (int j = 0; j < 8; ++j) { const f32x4 gg = ((const f32x4*)g)[lane + 64 * j]; ((f32x4*)o)[lane + 64 * j] = v[j] * rs * gg; }
}

__device__ __forceinline__ void phase_rms(const float* h, const float* g, bf16_t* xn, int nrows) {
    const int lane = tid_fresh() & 63, gw = bid_fresh() * 8 + (tid_fresh() >> 6), NGW = gridDim.x * 8;
    for (int r = gw; r < nrows; r += NGW) rms_row_bf16(h + (size_t)r * D, g, xn + (size_t)r * D, lane);
}

__device__ __forceinline__ void phase0(PP p, unsigned char* shm) {
    unsigned char* ws = p->ws;
    float* tile = (float*)shm;
    constexpr int C_IN = 32 * 14, C_OUT = 32 * 8, C_XQ = 32 * 2, C_XO = 8 * 8, C_UP = 32 * 32, C_DN = 128 * 8, C_GLU = 8 * 2, C_POOL = 16, C_PW = 8 * 2;
    constexpr int C_LAYER = C_IN + C_OUT + 3 * C_XQ + C_XO + C_UP + C_DN + C_GLU + C_POOL + C_PW;
    for (int it = bid_fresh(); it < DEPTH * C_LAYER; it += gridDim.x) {
        const int l = it / C_LAYER; int r = it % C_LAYER;
        if (r < C_IN) { tconv_tile_w(p->in[5] + (size_t)l * D * INW, INW, r / 14, r % 14, (bf16_t*)(ws + WS_WIN) + (size_t)l * INW * D, D, tile, p->in[4] + (size_t)l * D); continue; } r -= C_IN;
        if (r < C_OUT) { tconv_tile_w(p->in[23] + (size_t)l * D * D, D, r / 8, r % 8, (bf16_t*)(ws + WS_WOUT) + (size_t)l * D * D, D, tile, p->in[22] + (size_t)l * D); continue; } r -= C_OUT;
        if (r < C_XQ) { tconv_tile_w(p->in[25] + (size_t)l * D * 512, 512, r / 2, r % 2, (bf16_t*)(ws + WS_WXQ) + (size_t)l * 512 * D, D, tile, p->in[24] + (size_t)l * D); continue; } r -= C_XQ;
        if (r < C_XQ) { tconv_tile_w(p->in[26] + (size_t)l * D * 512, 512, r / 2, r % 2, (bf16_t*)(ws + WS_WKV) + (size_t)(l * 1024) * D, D, tile); continue; } r -= C_XQ;
        if (r < C_XQ) { tconv_tile_w(p->in[27] + (size_t)l * D * 512, 512, r / 2, r % 2, (bf16_t*)(ws + WS_WKV) + (size_t)(l * 1024 + 512) * D, D, tile); continue; } r -= C_XQ;
        if (r < C_XO) { tconv_tile_w(p->in[28] + (size_t)l * 512 * D, D, r / 8, r % 8, (bf16_t*)(ws + WS_WXO) + (size_t)l * D * 512, 512, tile); continue; } r -= C_XO;
        if (r < C_UP) { tconv_tile_w(p->in[30] + (size_t)l * D * DFF, DFF, r / 32, r % 32, (bf16_t*)(ws + WS_WUP) + (size_t)l * DFF * D, D, tile, p->in[29] + (size_t)l * D); continue; } r -= C_UP;
        if (r < C_DN) { tconv_tile_w(p->in[31] + (size_t)l * DFF * D, D, r / 8, r % 8, (bf16_t*)(ws + WS_WDN) + (size_t)l * D * DFF, DFF, tile); continue; } r -= C_DN;
        bf16_t* wsm = (bf16_t*)(ws + WS_WSM) + (size_t)l * 1536 * 512;
        if (r < C_GLU) { tconv_tile_w(p->in[14] + (size_t)l * 512 * 512, 512, r / 2, r % 2, wsm, 512, tile); continue; } r -= C_GLU;
        if (r < C_POOL) { const int gi = r >> 2, q = r & 3; tconv_tile(p->in[15] + (size_t)(l * 4 + gi) * 128 * 128, 128, q >> 1, q & 1, wsm + (size_t)(512 + gi * 128) * 512 + gi * 128, 512, tile); continue; } r -= C_POOL;
        tconv_tile_w(p->in[21] + (size_t)l * 512 * 512, 512, r / 2, r % 2, wsm + (size_t)1024 * 512, 512, tile);
    }
    {
        const int gt = bid_fresh() * 512 + tid_fresh(), NT = gridDim.x * 512;
        for (int i = gt; i < DEPTH * 512 * 64; i += NT) {
            const int l = i / (512 * 64), rr = (i / 64) % 512, ch = i % 64;
            if ((rr >> 7) != (ch >> 4)) { bf16_t* wsm = (bf16_t*)(ws + WS_WSM) + (size_t)l * 1536 * 512; *(u32x4*)(wsm + (size_t)(512 + rr) * 512 + ch * 8) = (u32x4){0u, 0u, 0u, 0u}; }
        }
    }
    phase_rms(p->in[1], p->in[3], (bf16_t*)(ws + WS_MEMN), 1024);
    {
        const int lane = tid_fresh() & 63, gw = bid_fresh() * 8 + (tid_fresh() >> 6), NGW = gridDim.x * 8;
        float* ssb = (float*)(ws + WS_SS);
        for (int r = gw; r < T; r += NGW) {
            const float* x = p->in[0] + (size_t)r * D; bf16_t* o = (bf16_t*)(ws + WS_XN) + (size_t)r * D; float sq = 0.f;
#pragma unroll
            for (int j = 0; j < 8; ++j) { const f32x4 v = ((const f32x4*)x)[lane + 64 * j]; sq += v[0] * v[0] + v[1] * v[1] + v[2] * v[2] + v[3] * v[3];
                u32x2 w; w.x = pk2(v[0], v[1]); w.y = pk2(v[2], v[3]); ((u32x2*)o)[lane + 64 * j] = w; }
            sq = wave_sum(sq);
            if (lane < 32) ssb[(size_t)r * 32 + lane] = (lane == 0) ? sq : 0.f;
        }
    }
}

constexpr int VS = 268;
template <int HD, bool DIL>
__device__ __forceinline__ void attn_compute(const bf16_t* Ks, const bf16_t* Vt, const bf16x8 (&qf)[HD / 32], int a, int quad, int fr,
                                             const float* biasT, int kmin, f32x4 (&oacc)[HD / 16], float& mx_out, float& den_out) {
    f32x4 s[16];
#pragma unroll
    for (int nt = 0; nt < 16; ++nt) {
        s[nt] = (f32x4){0.f, 0.f, 0.f, 0.f};
#pragma unroll
        for (int ks = 0; ks < HD / 32; ++ks) {
            const bf16x8 kf = *(const bf16x8*)(Ks + (16 * nt + fr) * (HD + 8) + quad * 8 + 32 * ks);
            s[nt] = __builtin_amdgcn_mfma_f32_16x16x32_bf16(kf, qf[ks], s[nt], 0, 0, 0);
        }
    }
    float mx = -3.0e38f;
    const float* tb = DIL ? (biasT + (127 - a + 4 * quad)) : nullptr;
#pragma unroll
    for (int nt = 0; nt < 16; ++nt)
#pragma unroll
        for (int j = 0; j < 4; ++j) {
            float v = s[nt][j];
            if (DIL) {
                v = v * 0.18033688011112042f + tb[16 * nt + j];
                if (nt < 8) v = kmin ? -1.0e30f : v;
            }
            s[nt][j] = v; mx = fmaxf(mx, v);
        }
    mx = fmaxf(mx, __shfl_xor(mx, 16)); mx = fmaxf(mx, __shfl_xor(mx, 32));
    float sum = 0.f;
#pragma unroll
    for (int nt = 0; nt < 16; ++nt)
#pragma unroll
        for (int j = 0; j < 4; ++j) { const float pv = __builtin_amdgcn_exp2f(s[nt][j] - mx); s[nt][j] = pv; sum += pv; }
    sum += __shfl_xor(sum, 16); sum += __shfl_xor(sum, 32);
#pragma unroll
    for (int dt = 0; dt < HD / 16; ++dt) oacc[dt] = (f32x4){0.f, 0.f, 0.f, 0.f};
#pragma unroll
    for (int k2 = 0; k2 < 8; ++k2) {
        u32x4 pp; pp.x = pk2(s[2 * k2][0], s[2 * k2][1]); pp.y = pk2(s[2 * k2][2], s[2 * k2][3]); pp.z = pk2(s[2 * k2 + 1][0], s[2 * k2 + 1][1]); pp.w = pk2(s[2 * k2 + 1][2], s[2 * k2 + 1][3]);
        const bf16x8 pf = __builtin_bit_cast(bf16x8, pp);
#pragma unroll
        for (int dt = 0; dt < HD / 16; ++dt) {
            const bf16_t* vp = Vt + (16 * dt + fr) * VS + 32 * k2 + quad * 4;
            const u32x2 lo = *(const u32x2*)vp, hi = *(const u32x2*)(vp + 16);
            u32x4 vv; vv.x = lo.x; vv.y = lo.y; vv.z = hi.x; vv.w = hi.y;
            oacc[dt] = __builtin_amdgcn_mfma_f32_16x16x32_bf16(__builtin_bit_cast(bf16x8, vv), pf, oacc[dt], 0, 0, 0);
        }
    }
    mx_out = mx; den_out = sum;
}

__device__ __forceinline__ void attn_band64(const bf16_t* Ks, const bf16_t* Vt, const bf16x8 (&qf)[2], int a, int w, int quad, int fr,
                                            const float* biasT, int kmin, f32x4 (&oacc)[4], float& mx_out, float& den_out) {
    f32x4 s[10];
#pragma unroll
    for (int i = 0; i < 10; ++i) {
        const int nt = (w + i) > 15 ? 15 : (w + i);
        s[i] = (f32x4){0.f, 0.f, 0.f, 0.f};
#pragma unroll
        for (int ks = 0; ks < 2; ++ks) {
            const bf16x8 kf = *(const bf16x8*)(Ks + (16 * nt + fr) * 72 + quad * 8 + 32 * ks);
            s[i] = __builtin_amdgcn_mfma_f32_16x16x32_bf16(kf, qf[ks], s[i], 0, 0, 0);
        }
    }
    float mx = -3.0e38f;
    const float* tb = biasT + (127 - a + 4 * quad + 16 * w);
#pragma unroll
    for (int i = 0; i < 10; ++i) {
        const bool dead = (kmin != 0) && ((w + i) < 8);
#pragma unroll
        for (int j = 0; j < 4; ++j) {
            float v = s[i][j] * 0.18033688011112042f + tb[16 * i + j];
            v = dead ? -1.0e30f : v;
            s[i][j] = v; mx = fmaxf(mx, v);
        }
    }
    mx = fmaxf(mx, __shfl_xor(mx, 16)); mx = fmaxf(mx, __shfl_xor(mx, 32));
    float sum = 0.f;
#pragma unroll
    for (int i = 0; i < 10; ++i)
#pragma unroll
        for (int j = 0; j < 4; ++j) { const float pv = __builtin_amdgcn_exp2f(s[i][j] - mx); s[i][j] = pv; sum += pv; }
    sum += __shfl_xor(sum, 16); sum += __shfl_xor(sum, 32);
#pragma unroll
    for (int dt = 0; dt < 4; ++dt) oacc[dt] = (f32x4){0.f, 0.f, 0.f, 0.f};
#pragma unroll
    for (int k2 = 0; k2 < 5; ++k2) {
        u32x4 pp; pp.x = pk2(s[2 * k2][0], s[2 * k2][1]); pp.y = pk2(s[2 * k2][2], s[2 * k2][3]); pp.z = pk2(s[2 * k2 + 1][0], s[2 * k2 + 1][1]); pp.w = pk2(s[2 * k2 + 1][2], s[2 * k2 + 1][3]);
        const bf16x8 pf = __builtin_bit_cast(bf16x8, pp);
        const int t0 = w + 2 * k2, t1 = (t0 + 1) > 15 ? 15 : (t0 + 1);
#pragma unroll
        for (int dt = 0; dt < 4; ++dt) {
            const bf16_t* vp = Vt + (16 * dt + fr) * VS + quad * 4;
            const u32x2 lo = *(const u32x2*)(vp + 16 * t0), hi = *(const u32x2*)(vp + 16 * t1);
            u32x4 vv; vv.x = lo.x; vv.y = lo.y; vv.z = hi.x; vv.w = hi.y;
            oacc[dt] = __builtin_amdgcn_mfma_f32_16x16x32_bf16(__builtin_bit_cast(bf16x8, vv), pf, oacc[dt], 0, 0, 0);
        }
    }
    mx_out = mx; den_out = sum;
}

__device__ __forceinline__ void vt_store_pair(bf16_t* Vt, int dim0, int bi, const u32x4 a, const u32x4 b) {
    unsigned* vd = (unsigned*)(Vt + dim0 * VS + bi);
    constexpr int RS = VS / 2;
    vd[0 * RS] = (a.x & 0xffffu) | (b.x << 16); vd[1 * RS] = (a.x >> 16) | (b.x & 0xffff0000u);
    vd[2 * RS] = (a.y & 0xffffu) | (b.y << 16); vd[3 * RS] = (a.y >> 16) | (b.y & 0xffff0000u);
    vd[4 * RS] = (a.z & 0xffffu) | (b.z << 16); vd[5 * RS] = (a.z >> 16) | (b.z & 0xffff0000u);
    vd[6 * RS] = (a.w & 0xffffu) | (b.w << 16); vd[7 * RS] = (a.w >> 16) | (b.w & 0xffff0000u);
}
__device__ __forceinline__ int t5_bucket(int n) {
    if (n < 16) return n;
    int b = 16;
    b += (n >= 22); b += (n >= 30); b += (n >= 40); b += (n >= 54); b += (n >= 73); b += (n >= 99); b += (n >= 134); b += (n >= 182);
    b += (n >= 246); b += (n >= 332); b += (n >= 450); b += (n >= 609); b += (n >= 825); b += (n >= 1117); b += (n >= 1513);
    return b;
}

constexpr int AT_KS = 0, AT_VT = 69632, AT_BIAS = 137216;
constexpr int DA_KS = 0, DA_VT = 36864, DA_BIAS = 36864 + 64 * VS * 2, DA_BUF = 73728;

struct DilUnit { int br, b, h, d, r, n; };
__device__ __forceinline__ DilUnit dil_decode(int u0) {
    const int u = (u0 & 7) * 192 + (u0 >> 3);
    DilUnit q; q.br = u / 512; const int rem = u % 512; q.b = rem / 128; q.h = (rem / 16) % 8; const int rn = rem % 16;
    q.d = (q.br == 0) ? 1 : (q.br == 1 ? 4 : 16); const int nbk = 16 / q.d; q.r = rn / nbk; q.n = rn % nbk; return q;
}
struct DilRegs { u32x4 kv[4], vv[4]; float bias; bf16x8 qf[2]; };
__device__ __forceinline__ void dil_issue(PP p, const DilUnit& q, DilRegs& R, int tid) {
    const bf16_t* proj = (const bf16_t*)(p->ws + WS_PROJ);
#pragma unroll
    for (int i = 0; i < 4; ++i) {
        const int bi = 2 * (tid >> 3) + (i & 1) + 128 * (i >> 1), ch = tid & 7, sp = 128 * (q.n - 1) + bi;
        R.kv[i] = (u32x4){0u, 0u, 0u, 0u}; R.vv[i] = R.kv[i];
        if (sp >= 0) { const size_t hp = ((size_t)((q.b * 8 + q.h) * SEQ + sp * q.d + q.r)) * 64 + ch * 8; R.kv[i] = *(const u32x4*)(proj + PJ_QKV + (size_t)1 * 4 * 8 * SEQ * 64 + hp); R.vv[i] = *(const u32x4*)(proj + PJ_QKV + (size_t)2 * 4 * 8 * SEQ * 64 + hp); }
    }
    { const int w = tid >> 6, lane = tid & 63, fr = lane & 15, quad = lane >> 4, a = 16 * w + fr;
      const size_t rowq = (size_t)(q.b * SEQ + (128 * q.n + a) * q.d + q.r);
      const bf16_t* qp = proj + PJ_QKV + ((size_t)((q.b * 8 + q.h) * SEQ) + (rowq - (size_t)q.b * SEQ)) * 64 + quad * 8;
      R.qf[0] = *(const bf16x8*)qp; R.qf[1] = *(const bf16x8*)(qp + 32); }
    R.bias = -1.0e30f;
    if (tid < 383) { const int sd = 255 - tid; if (sd >= 0 && sd <= 128) R.bias = p->in[2][t5_bucket(sd * q.d) * 8 + q.h] * 1.4426950408889634f; }
}
__device__ __forceinline__ void dil_stage(const DilRegs& R, unsigned char* buf, int tid) {
    bf16_t* Ks = (bf16_t*)(buf + DA_KS); bf16_t* Vt = (bf16_t*)(buf + DA_VT); float* biasT = (float*)(buf + DA_BIAS);
#pragma unroll
    for (int i = 0; i < 4; ++i) { const int bi = 2 * (tid >> 3) + (i & 1) + 128 * (i >> 1), ch = tid & 7; *(u32x4*)(Ks + bi * 72 + ch * 8) = R.kv[i]; }
#pragma unroll
    for (int i = 0; i < 4; i += 2) { const int bi = 2 * (tid >> 3) + 128 * (i >> 1), ch = tid & 7; vt_store_pair(Vt, ch * 8, bi, R.vv[i], R.vv[i + 1]); }
    if (tid < 383) biasT[tid] = R.bias;
}
__device__ __forceinline__ void dil_compute(PP p, const DilUnit& q, const unsigned char* buf, int tid, const bf16x8 (&qf)[2]) {
    const bf16_t* Ks = (const bf16_t*)(buf + DA_KS); const bf16_t* Vt = (const bf16_t*)(buf + DA_VT); const float* biasT = (const float*)(buf + DA_BIAS);
    const int w = tid >> 6, lane = tid & 63, fr = lane & 15, quad = lane >> 4;
    const int a = 16 * w + fr;
    const size_t rowq = (size_t)(q.b * SEQ + (128 * q.n + a) * q.d + q.r);
    f32x4 oacc[4]; float mx, den;
    attn_band64(Ks, Vt, qf, a, w, quad, fr, biasT, (q.n == 0) ? 128 : 0, oacc, mx, den);
    const float inv = 1.0f / den;
    bf16_t* ob = (bf16_t*)(p->ws + WS_OB) + ((size_t)q.br * T + rowq) * 512 + q.h * 64 + quad * 4;
#pragma unroll
    for (int dt = 0; dt < 4; ++dt) { u32x2 o; o.x = pk2(oacc[dt][0] * inv, oacc[dt][1] * inv); o.y = pk2(oacc[dt][2] * inv, oacc[dt][3] * inv); *(u32x2*)(ob + 16 * dt) = o; }
    if (quad == 0) ((float*)(p->ws + WS_LSE))[((size_t)q.br * T + rowq) * 8 + q.h] = mx * 0.6931471805599453f + __logf(den);
}
__device__ __forceinline__ void dil_attn_units(unsigned char* shm, int first, int stride) {
    const int tid = tid_fresh();
    if (first >= 1536) return;
    bf16x8 qcur[2];
    { PP p = get_pp(); DilRegs R; const DilUnit q = dil_decode(first); dil_issue(p, q, R, tid); dil_stage(R, shm, tid); qcur[0] = R.qf[0]; qcur[1] = R.qf[1]; }
    __syncthreads();
    int par = 0;
    for (int u = first; u < 1536; u += stride) {
        PP p = get_pp();
        const bool more = (u + stride) < 1536;
        DilRegs R; DilUnit qn = dil_decode(more ? u + stride : u);
        if (more) dil_issue(p, qn, R, tid);
        const DilUnit q = dil_decode(u);
        dil_compute(p, q, shm + par * DA_BUF, tid, qcur);
        if (more) { dil_stage(R, shm + (par ^ 1) * DA_BUF, tid); qcur[0] = R.qf[0]; qcur[1] = R.qf[1]; }
        __syncthreads();
        par ^= 1;
    }
}

__device__ __forceinline__ void cross_attn_unit(PP p, unsigned char* shm, int u, int l) {
    const bf16_t* kvb = (const bf16_t*)(p->ws + WS_KV);
    bf16_t* Ks = (bf16_t*)(shm + AT_KS); bf16_t* Vt = (bf16_t*)(shm + AT_VT);
    const int tid = tid_fresh(), w = tid >> 6, lane = tid & 63, fr = lane & 15, quad = lane >> 4;
    const int b = u / 64, xh = (u / 16) % 4, qt = u % 16;
    const size_t rowq = (size_t)(b * SEQ + qt * 128 + 16 * w + fr);
    float qs;
    { const float* sp = (const float*)(p->ws + WS_SS) + ((size_t)(1 + 3 * l) * T + rowq) * 32 + quad * 8;
      const f32x4 a0 = *(const f32x4*)sp, a1 = *(const f32x4*)(sp + 4);
      float t = ((a0[0] + a0[1]) + (a0[2] + a0[3])) + ((a1[0] + a1[1]) + (a1[2] + a1[3]));
      t += __shfl_xor(t, 16); t += __shfl_xor(t, 32);
      qs = (0.08838834764831845f * 1.4426950408889634f) / sqrtf(t * (1.0f / D) + EPS); }
    bf16x8 qf[4];
    const bf16_t* qp = (const bf16_t*)(p->ws + WS_QP) + rowq * 512 + xh * 128 + quad * 8;
#pragma unroll
    for (int ks = 0; ks < 4; ++ks) {
        float acc8[8], t8[8];
        unpack8(*(const u32x4*)(qp + 32 * ks), acc8);
#pragma unroll
        for (int sp = 1; sp < 4; ++sp) { unpack8(*(const u32x4*)(qp + (size_t)sp * T * 512 + 32 * ks), t8);
#pragma unroll
            for (int e = 0; e < 8; ++e) acc8[e] += t8[e]; }
        u32x4 pk; pk.x = pk2(acc8[0] * qs, acc8[1] * qs); pk.y = pk2(acc8[2] * qs, acc8[3] * qs); pk.z = pk2(acc8[4] * qs, acc8[5] * qs); pk.w = pk2(acc8[6] * qs, acc8[7] * qs);
        qf[ks] = __builtin_bit_cast(bf16x8, pk);
    }
    {
        u32x4 kq[8], vq[8];
#pragma unroll
        for (int i = 0; i < 8; ++i) { const int m = 2 * (tid >> 4) + (i & 1) + 64 * (i >> 1), ch = tid & 15;
            const bf16_t* rowp = kvb + (size_t)(b * 256 + m) * 4096 + l * 1024 + xh * 128 + ch * 8; kq[i] = *(const u32x4*)rowp; vq[i] = *(const u32x4*)(rowp + 512); }
#pragma unroll
        for (int i = 0; i < 8; ++i) { const int m = 2 * (tid >> 4) + (i & 1) + 64 * (i >> 1), ch = tid & 15; *(u32x4*)(Ks + m * 136 + ch * 8) = kq[i]; }
#pragma unroll
        for (int i = 0; i < 8; i += 2) { const int m = 2 * (tid >> 4) + 64 * (i >> 1), ch = tid & 15; vt_store_pair(Vt, ch * 8, m, vq[i], vq[i + 1]); }
    }
    __syncthreads();
    f32x4 oacc[8]; float mx, den;
    attn_compute<128, false>(Ks, Vt, qf, 0, quad, fr, nullptr, 0, oacc, mx, den);
    const float inv = 1.0f / den;
    bf16_t* ox = (bf16_t*)(p->ws + WS_OX) + rowq * 512 + xh * 128 + quad * 4;
#pragma unroll
    for (int dt = 0; dt < 8; ++dt) { u32x2 o; o.x = pk2(oacc[dt][0] * inv, oacc[dt][1] * inv); o.y = pk2(oacc[dt][2] * inv, oacc[dt][3] * inv); *(u32x2*)(ox + 16 * dt) = o; }
    __syncthreads();
}

typedef float f32x2 __attribute__((ext_vector_type(2)));
struct S5Lane { float ar, ai; f32x2 bb[16]; };
__device__ __forceinline__ void s5_lane_params(PP p, int l, int g, int n, S5Lane& q) {
    const int gi = (l * 32 + g) * 64 + n;
    const float lr = p->in[6][gi], li = p->in[7][gi], dt = expf(p->in[8][l * 32 + g]);
    const float mag = expf(lr * dt);
    float sn, cs; sincosf(li * dt, &sn, &cs);
    q.ar = mag * cs; q.ai = mag * sn;
    const float den = lr * lr + li * li, nr = q.ar - 1.0f, ni = q.ai;
    const float fr_ = (nr * lr + ni * li) / den, fi_ = (ni * lr - nr * li) / den;
    const f32x4* bre = (const f32x4*)(p->in[9] + (size_t)gi * 16); const f32x4* bim = (const f32x4*)(p->in[10] + (size_t)gi * 16);
#pragma unroll
    for (int c4 = 0; c4 < 4; ++c4) { const f32x4 br = bre[c4], bi = bim[c4];
#pragma unroll
        for (int e = 0; e < 4; ++e) { q.bb[c4 * 4 + e] = (f32x2){fr_ * br[e] - fi_ * bi[e], fr_ * bi[e] + fi_ * br[e]}; } }
}
__device__ __forceinline__ void s5_load_u(const bf16_t* proj, int b, int l0, int g, float* ub, int lane) {
    const bf16_t* src = proj + PJ_UA + (size_t)(b * SEQ + l0 + lane) * 512 + g * 16;
    const u32x4 a = *(const u32x4*)src, c = *(const u32x4*)(src + 8);
    f32x4* d = (f32x4*)(ub + lane * 16);
    d[0] = (f32x4){__uint_as_float(a.x << 16), __uint_as_float(a.x & 0xffff0000u), __uint_as_float(a.y << 16), __uint_as_float(a.y & 0xffff0000u)};
    d[1] = (f32x4){__uint_as_float(a.z << 16), __uint_as_float(a.z & 0xffff0000u), __uint_as_float(a.w << 16), __uint_as_float(a.w & 0xffff0000u)};
    d[2] = (f32x4){__uint_as_float(c.x << 16), __uint_as_float(c.x & 0xffff0000u), __uint_as_float(c.y << 16), __uint_as_float(c.y & 0xffff0000u)};
    d[3] = (f32x4){__uint_as_float(c.z << 16), __uint_as_float(c.z & 0xffff0000u), __uint_as_float(c.w << 16), __uint_as_float(c.w & 0xffff0000u)};
}
__device__ __forceinline__ void s5_step(const S5Lane& q, const float* urow, f32x2& x) {
    const f32x4* u4 = (const f32x4*)urow;
    f32x2 b0 = (f32x2){0.f, 0.f}, b1 = b0;
#pragma unroll
    for (int c4 = 0; c4 < 4; ++c4) { const f32x4 uv = u4[c4];
        b0 += q.bb[c4 * 4 + 0] * uv[0]; b1 += q.bb[c4 * 4 + 1] * uv[1]; b0 += q.bb[c4 * 4 + 2] * uv[2]; b1 += q.bb[c4 * 4 + 3] * uv[3]; }
    const f32x2 rot = (f32x2){-x.y, x.x};
    x = (x * q.ar + rot * q.ai) + (b0 + b1);
}
constexpr int S5_BBL = 0, S5_BUL = 4096, S5_XS = 4096 + 65536;
struct S5Frag { bf16x8 bfr[8]; };
__device__ __forceinline__ void s5_write_bbl(const S5Lane& q, bf16_t* bbL, int lane) {
    u32x4 re0, re1, im0, im1;
    re0.x = pk2(q.bb[0].x, q.bb[1].x); re0.y = pk2(q.bb[2].x, q.bb[3].x); re0.z = pk2(q.bb[4].x, q.bb[5].x); re0.w = pk2(q.bb[6].x, q.bb[7].x);
    re1.x = pk2(q.bb[8].x, q.bb[9].x); re1.y = pk2(q.bb[10].x, q.bb[11].x); re1.z = pk2(q.bb[12].x, q.bb[13].x); re1.w = pk2(q.bb[14].x, q.bb[15].x);
    im0.x = pk2(q.bb[0].y, q.bb[1].y); im0.y = pk2(q.bb[2].y, q.bb[3].y); im0.z = pk2(q.bb[4].y, q.bb[5].y); im0.w = pk2(q.bb[6].y, q.bb[7].y);
    im1.x = pk2(q.bb[8].y, q.bb[9].y); im1.y = pk2(q.bb[10].y, q.bb[11].y); im1.z = pk2(q.bb[12].y, q.bb[13].y); im1.w = pk2(q.bb[14].y, q.bb[15].y);
    *(u32x4*)(bbL + lane * 16) = re0; *(u32x4*)(bbL + lane * 16 + 8) = re1;
    *(u32x4*)(bbL + (64 + lane) * 16) = im0; *(u32x4*)(bbL + (64 + lane) * 16 + 8) = im1;
}
__device__ __forceinline__ void s5_load_frags(const bf16_t* bbL, S5Frag& f, int lane) {
    const int jj = lane & 15, quad = lane >> 4;
#pragma unroll
    for (int nt = 0; nt < 8; ++nt) { u32x4 v = (u32x4){0u, 0u, 0u, 0u}; if (quad < 2) v = *(const u32x4*)(bbL + (16 * nt + jj) * 16 + quad * 8); f.bfr[nt] = __builtin_bit_cast(bf16x8, v); }
}
__device__ __forceinline__ bf16x8 s5_ufrag(const bf16_t* proj, size_t row, int g, int lane) {
    const int tt = lane & 15, quad = lane >> 4;
    u32x4 v = (u32x4){0u, 0u, 0u, 0u};
    if (quad < 2) v = *(const u32x4*)(proj + PJ_UA + (row + tt) * 512 + g * 16 + quad * 8);
    return __builtin_bit_cast(bf16x8, v);
}
__device__ __forceinline__ void s5_bu16(const S5Frag& f, const bf16x8 uf, float* buL, int lane) {
    const int jj = lane & 15, quad = lane >> 4;
#pragma unroll
    for (int nt = 0; nt < 4; ++nt) {
        const f32x4 z = (f32x4){0.f, 0.f, 0.f, 0.f};
        const f32x4 dre = __builtin_amdgcn_mfma_f32_16x16x32_bf16(uf, f.bfr[nt], z, 0, 0, 0);
        const f32x4 dim = __builtin_amdgcn_mfma_f32_16x16x32_bf16(uf, f.bfr[nt + 4], z, 0, 0, 0);
#pragma unroll
        for (int r = 0; r < 4; ++r) *(f32x2*)(buL + ((4 * quad + r) * 64 + 16 * nt + jj) * 2) = (f32x2){dre[r], dim[r]};
    }
}
__device__ __forceinline__ void s5_rec(const S5Lane& q, f32x2 bu, f32x2& x) { const f32x2 rot = (f32x2){-x.y, x.x}; x = (x * q.ar + rot * q.ai) + bu; }

__device__ __forceinline__ void s5_pass1_item(PP p, unsigned char* shm, int item, int l) {
    const int tid = tid_fresh(), w = tid >> 6, lane = tid & 63;
    const int b = item / 128, g = (item / 4) % 32, jg = item % 4, j = jg * 8 + w;
    const bf16_t* proj = (const bf16_t*)(p->ws + WS_PROJ);
    bf16_t* bbL = (bf16_t*)(shm + S5_BBL); float* buL = (float*)(shm + S5_BUL) + w * 2048;
    S5Lane q; s5_lane_params(p, l, g, lane, q);
    const size_t row0 = (size_t)b * SEQ + j * 64;
    bf16x8 uf[4];
#pragma unroll
    for (int sc = 0; sc < 4; ++sc) uf[sc] = s5_ufrag(proj, row0 + sc * 16, g, lane);
    s5_write_bbl(q, bbL, lane);
    __syncthreads();
    S5Frag f; s5_load_frags(bbL, f, lane);
    f32x2 x = (f32x2){0.f, 0.f};
#pragma unroll
    for (int sc = 0; sc < 4; ++sc) {
        s5_bu16(f, uf[sc], buL, lane);
        __syncthreads();
#pragma unroll
        for (int t = 0; t < 16; ++t) s5_rec(q, *(const f32x2*)(buL + (t * 64 + lane) * 2), x);
        __syncthreads();
    }
    *(f32x2*)((float*)(p->ws + WS_CARRY) + ((size_t)((b * 32 + g) * 32 + j) * 64 + lane) * 2) = x;
}
__device__ __forceinline__ void s5_pass2_item(PP p, unsigned char* shm, int item, int l) {
    const int tid = tid_fresh(), w = tid >> 6, lane = tid & 63;
    const int b = item / 128, g = (item / 4) % 32, jg = item % 4, j = jg * 8 + w;
    const bf16_t* proj = (const bf16_t*)(p->ws + WS_PROJ);
    bf16_t* bbL = (bf16_t*)(shm + S5_BBL); float* buL = (float*)(shm + S5_BUL) + w * 2048; float* xs = (float*)(shm + S5_XS) + w * (16 * 132);
    const int cc = lane & 15, quad = lane >> 4;
    float cmr[32];
    { const float* src = ((quad < 2) ? p->in[11] : p->in[12]) + ((size_t)(l * 32 + g) * 16 + cc) * 64 + (quad & 1) * 32;
      const float sgn = (quad < 2) ? 1.0f : -1.0f;
#pragma unroll
      for (int i = 0; i < 8; ++i) { const f32x4 v = *(const f32x4*)(src + 4 * i); cmr[4 * i] = v[0] * sgn; cmr[4 * i + 1] = v[1] * sgn; cmr[4 * i + 2] = v[2] * sgn; cmr[4 * i + 3] = v[3] * sgn; } }
    S5Lane q; s5_lane_params(p, l, g, lane, q);
    const size_t row0 = (size_t)b * SEQ + j * 64;
    bf16x8 uf[4];
#pragma unroll
    for (int sc = 0; sc < 4; ++sc) uf[sc] = s5_ufrag(proj, row0 + sc * 16, g, lane);
    s5_write_bbl(q, bbL, lane);
    float pr = q.ar, pi = q.ai;
#pragma unroll
    for (int s = 0; s < 6; ++s) { const float nr = pr * pr - pi * pi, ni = 2.f * pr * pi; pr = nr; pi = ni; }
    f32x2 x = (f32x2){0.f, 0.f};
    const f32x2* carry = (const f32x2*)((const float*)(p->ws + WS_CARRY) + ((size_t)((b * 32 + g) * 32) * 64 + lane) * 2);
    for (int i0 = 0; i0 < j; i0 += 8) {
        f32x2 sv[8];
#pragma unroll
        for (int e = 0; e < 8; ++e) sv[e] = (i0 + e < j) ? carry[(size_t)(i0 + e) * 64] : (f32x2){0.f, 0.f};
#pragma unroll
        for (int e = 0; e < 8; ++e) if (i0 + e < j) { const f32x2 rot = (f32x2){-x.y, x.x}; x = (x * pr + rot * pi) + sv[e]; }
    }
    __syncthreads();
    S5Frag f; s5_load_frags(bbL, f, lane);
    const float dsk = p->in[13][(size_t)l * 512 + g * 16 + cc];
    bf16_t* Gout = (bf16_t*)(p->ws + WS_GPH);
    for (int sc = 0; sc < 4; ++sc) {
        s5_bu16(f, uf[sc], buL, lane);
        __syncthreads();
#pragma unroll
        for (int t = 0; t < 16; ++t) { s5_rec(q, *(const f32x2*)(buL + (t * 64 + lane) * 2), x); xs[t * 132 + lane] = x.x; xs[t * 132 + 64 + lane] = x.y; }
        __syncthreads();
        f32x4 y0 = (f32x4){0.f, 0.f, 0.f, 0.f}, y1 = y0;
        const f32x4* xrow = (const f32x4*)(xs + cc * 132 + quad * 32);
#pragma unroll
        for (int i = 0; i < 8; ++i) { const f32x4 xv = xrow[i];
            y0 = __builtin_amdgcn_mfma_f32_16x16x4f32(xv[0], cmr[4 * i + 0], y0, 0, 0, 0);
            y1 = __builtin_amdgcn_mfma_f32_16x16x4f32(xv[1], cmr[4 * i + 1], y1, 0, 0, 0);
            y0 = __builtin_amdgcn_mfma_f32_16x16x4f32(xv[2], cmr[4 * i + 2], y0, 0, 0, 0);
            y1 = __builtin_amdgcn_mfma_f32_16x16x4f32(xv[3], cmr[4 * i + 3], y1, 0, 0, 0); }
        const f32x4 y = y0 + y1;
#pragma unroll
        for (int r = 0; r < 4; ++r) { const int tl = sc * 16 + quad * 4 + r;
            const float v = y[r] + dsk * bf2f(proj[PJ_UA + (row0 + tl) * 512 + g * 16 + cc]);
            const float z = 0.7978845608028654f * (v + 0.044715f * v * v * v);
            const float th = 1.0f - 2.0f / (__expf(2.0f * z) + 1.0f);
            Gout[(row0 + tl) * 512 + g * 16 + cc] = f2bf(0.5f * v * (1.0f + th)); }
        __syncthreads();
    }
}

__device__ __forceinline__ void pool_item(PP p, unsigned char* shm, int item) {
    const bf16_t* proj = (const bf16_t*)(p->ws + WS_PROJ);
    bf16_t* P = (bf16_t*)(p->ws + WS_GPH) + (size_t)T * 512;
    float* ut = (float*)shm;
    const int tid = tid_fresh(), ch = tid, gi = ch >> 7, w = 2 << gi;
    const int row0 = item * 32, b = row0 / SEQ, l0 = row0 % SEQ;
#pragma unroll
    for (int i = 0; i < 6; ++i) {
        const int ci = tid + i * 512, rr = ci >> 6, c8 = ci & 63, ll = l0 - 16 + rr;
        u32x4 v = (u32x4){0u, 0u, 0u, 0u};
        if (ll >= 0) v = *(const u32x4*)(proj + PJ_UB + (size_t)(b * SEQ + ll) * 512 + c8 * 8);
        f32x4* d = (f32x4*)(ut + rr * 512 + c8 * 8);
        d[0] = (f32x4){__uint_as_float(v.x << 16), __uint_as_float(v.x & 0xffff0000u), __uint_as_float(v.y << 16), __uint_as_float(v.y & 0xffff0000u)};
        d[1] = (f32x4){__uint_as_float(v.z << 16), __uint_as_float(v.z & 0xffff0000u), __uint_as_float(v.w << 16), __uint_as_float(v.w & 0xffff0000u)};
    }
    __syncthreads();
    float sum = 0.f;
    for (int s = 1; s <= w; ++s) sum += ut[(16 - s) * 512 + ch];
    for (int t = 0; t < 32; ++t) {
        const int l = l0 + t;
        const float cur = ut[(16 + t) * 512 + ch];
        sum += cur - ut[(16 + t - w) * 512 + ch];
        const int cnt = (l + 1 < w) ? (l + 1) : w;
        P[(size_t)(row0 + t) * 512 + ch] = f2bf(sum / (float)cnt - cur);
    }
    __syncthreads();
}
constexpr int CV_HG = 0, CV_CV = 46 * 512 * 4;
__device__ __forceinline__ void conv_item(PP p, unsigned char* shm, int item, int l) {
    const bf16_t* proj = (const bf16_t*)(p->ws + WS_PROJ);
    bf16_t* HC = (bf16_t*)(p->ws + WS_GPH) + (size_t)2 * T * 512;
    float* hg = (float*)(shm + CV_HG); float* cv = (float*)(shm + CV_CV);
    const int tid = tid_fresh(), c = tid, row0 = item * 16, b = row0 / SEQ, l0 = row0 % SEQ;
#pragma unroll
    for (int i = 0; i < 6; ++i) {
        const int ci = tid + i * 512, rr = ci >> 6, c8 = ci & 63, ll = l0 - 30 + rr;
        if (rr < 46) {
            u32x4 v = (u32x4){0u, 0u, 0u, 0u}, gt = v;
            if (ll >= 0) { const bf16_t* rp = proj + PJ_UC + (size_t)(b * SEQ + ll) * 1024 + c8 * 8; v = *(const u32x4*)rp; gt = *(const u32x4*)(rp + 512); }
            float vf[8], gf[8];
            vf[0] = __uint_as_float(v.x << 16); vf[1] = __uint_as_float(v.x & 0xffff0000u); vf[2] = __uint_as_float(v.y << 16); vf[3] = __uint_as_float(v.y & 0xffff0000u);
            vf[4] = __uint_as_float(v.z << 16); vf[5] = __uint_as_float(v.z & 0xffff0000u); vf[6] = __uint_as_float(v.w << 16); vf[7] = __uint_as_float(v.w & 0xffff0000u);
            gf[0] = __uint_as_float(gt.x << 16); gf[1] = __uint_as_float(gt.x & 0xffff0000u); gf[2] = __uint_as_float(gt.y << 16); gf[3] = __uint_as_float(gt.y & 0xffff0000u);
            gf[4] = __uint_as_float(gt.z << 16); gf[5] = __uint_as_float(gt.z & 0xffff0000u); gf[6] = __uint_as_float(gt.w << 16); gf[7] = __uint_as_float(gt.w & 0xffff0000u);
            f32x4* d = (f32x4*)(hg + rr * 512 + c8 * 8);
            d[0] = (f32x4){vf[0] * sigmoidf_(gf[0]), vf[1] * sigmoidf_(gf[1]), vf[2] * sigmoidf_(gf[2]), vf[3] * sigmoidf_(gf[3])};
            d[1] = (f32x4){vf[4] * sigmoidf_(gf[4]), vf[5] * sigmoidf_(gf[5]), vf[6] * sigmoidf_(gf[6]), vf[7] * sigmoidf_(gf[7])};
        }
    }
    float wdw[31];
#pragma unroll
    for (int j = 0; j < 31; ++j) wdw[j] = p->in[17][((size_t)l * 31 + j) * 512 + c];
    const float bias = p->in[18][(size_t)l * 512 + c];
    __syncthreads();
    for (int t = 0; t < 16; ++t) {
        float acc = bias, acc2 = 0.f;
#pragma unroll
        for (int j = 0; j < 30; j += 2) { acc += wdw[j] * hg[(t + j) * 512 + c]; acc2 += wdw[j + 1] * hg[(t + j + 1) * 512 + c]; }
        acc += wdw[30] * hg[(t + 30) * 512 + c];
        cv[t * 512 + c] = acc + acc2;
    }
    __syncthreads();
    const int w = c >> 6, lane = c & 63;
    for (int tk = 0; tk < 2; ++tk) {
        const int t = w * 2 + tk;
        const f32x4 v0 = *(const f32x4*)(cv + t * 512 + lane * 8), v1 = *(const f32x4*)(cv + t * 512 + lane * 8 + 4);
        float s = v0[0] + v0[1] + v0[2] + v0[3] + v1[0] + v1[1] + v1[2] + v1[3];
        const float mean = wave_sum(s) * (1.0f / 512.0f);
        const f32x4 d0 = v0 - mean, d1 = v1 - mean;
        float s2 = d0[0] * d0[0] + d0[1] * d0[1] + d0[2] * d0[2] + d0[3] * d0[3] + d1[0] * d1[0] + d1[1] * d1[1] + d1[2] * d1[2] + d1[3] * d1[3];
        const float rstd = 1.0f / sqrtf(wave_sum(s2) * (1.0f / 512.0f) + EPS);
        const f32x4 g0 = *(const f32x4*)(p->in[19] + (size_t)l * 512 + lane * 8), g1 = *(const f32x4*)(p->in[19] + (size_t)l * 512 + lane * 8 + 4);
        const f32x4 b0 = *(const f32x4*)(p->in[20] + (size_t)l * 512 + lane * 8), b1 = *(const f32x4*)(p->in[20] + (size_t)l * 512 + lane * 8 + 4);
        float o[8];
#pragma unroll
        for (int e = 0; e < 4; ++e) { const float y0 = d0[e] * rstd * g0[e] + b0[e], y1 = d1[e] * rstd * g1[e] + b1[e]; o[e] = y0 * sigmoidf_(y0); o[4 + e] = y1 * sigmoidf_(y1); }
        u32x4 ov; ov.x = pk2(o[0], o[1]); ov.y = pk2(o[2], o[3]); ov.z = pk2(o[4], o[5]); ov.w = pk2(o[6], o[7]);
        *(u32x4*)(HC + (size_t)(row0 + t) * 512 + lane * 8) = ov;
    }
    __syncthreads();
}

struct CbTok { u32x4 ob[3]; float ls[3]; };
__device__ __forceinline__ void cb_load(CbTok& k, const bf16_t* ob, const float* lse, int t, int lane) {
#pragma unroll
    for (int g = 0; g < 3; ++g) { k.ob[g] = *(const u32x4*)(ob + ((size_t)g * T + t) * 512 + lane * 8); k.ls[g] = lse[((size_t)g * T + t) * 8 + (lane >> 3)]; }
}
__device__ __forceinline__ void phase_combine(PP p) {
    const int lane = tid_fresh() & 63, gw = bid_fresh() * 8 + (tid_fresh() >> 6), NGW = gridDim.x * 8;
    const bf16_t* ob = (const bf16_t*)(p->ws + WS_OB); const float* lse = (const float*)(p->ws + WS_LSE);
    bf16_t* y = (bf16_t*)(p->ws + WS_YN); float* ssg = (float*)(p->ws + WS_SSG);
    CbTok cur, nxt;
    if (gw < T) cb_load(cur, ob, lse, gw, lane);
    for (int t = gw; t < T; t += NGW) {
        const bool more = (t + NGW) < T;
        if (more) cb_load(nxt, ob, lse, t + NGW, lane);
        const float lm = fmaxf(cur.ls[0], fmaxf(cur.ls[1], cur.ls[2]));
        const float e0 = __expf(cur.ls[0] - lm), e1 = __expf(cur.ls[1] - lm), e2 = __expf(cur.ls[2] - lm), ei = 1.0f / (e0 + e1 + e2);
        float o0[8], o1[8], o2[8], v[8];
        unpack8(cur.ob[0], o0); unpack8(cur.ob[1], o1); unpack8(cur.ob[2], o2);
        float sq = 0.f;
#pragma unroll
        for (int e = 0; e < 8; ++e) { v[e] = (e0 * o0[e] + e1 * o1[e] + e2 * o2[e]) * ei; sq += v[e] * v[e]; }
        sq = wave_sum(sq);
        u32x4 ov; ov.x = pk2(v[0], v[1]); ov.y = pk2(v[2], v[3]); ov.z = pk2(v[4], v[5]); ov.w = pk2(v[6], v[7]);
        *(u32x4*)(y + (size_t)t * D + 1536 + lane * 8) = ov;
        if (lane < 8) ssg[(size_t)t * 32 + 24 + lane] = (lane == 0) ? sq : 0.f;
        if (more) cur = nxt;
    }
}

__global__ void __launch_bounds__(512, 2) hymba_fwd(Params p_unused) {
    extern __shared__ __attribute__((aligned(16))) unsigned char shm[];
    cg::grid_group grid = cg::this_grid();
    volatile LAS unsigned* xst = (volatile LAS unsigned*)(LAS unsigned char*)(shm + LDS_BYTES - 16);
    if (threadIdx.x == 0) { xst[0] = 0u; xst[1] = 0u; }
    __syncthreads();
    XcdBarrier xbar;
    { PP p = get_pp(); unsigned* barw = (unsigned*)(p->ws + WS_BAR); xbar = xcd_barrier_post(barw, xst);
      if (p->ws == nullptr) grid.sync(); }

    for (int rep = 0; rep < P0_REPS; ++rep) phase0(get_pp(), shm);
    GSYNC();

    for (int l = 0; l < N_LAYERS_RUN; ++l) {
        if (l == 0) { PP p = get_pp(); unsigned char* ws = p->ws;
          pg8::WinKvOrder S; S.so.init(T, INW, (int)gridDim.x, (int)bid_fresh()); S.a_delta = WS_MEMN - WS_XN; S.b_delta = WS_WKV - WS_WIN;
          pg8::Gemm g{(const bf16_t*)(ws + WS_XN), (const bf16_t*)(ws + WS_WIN), T, INW, D, D};
          pg8::EpiWinKv E{{(bf16_t*)(ws + WS_PROJ), (const float*)(ws + WS_SS)}, {(bf16_t*)(ws + WS_KV), 4096, 1.0f, nullptr}};
          pg8::gemm_phase<pg8::EpiWinKv, pg8::WinKvOrder>((PG8_LAS unsigned char*)shm, g, S, E); }
        else { PP p = get_pp(); unsigned char* ws = p->ws;
          pg8::EpiWin E{(bf16_t*)(ws + WS_PROJ), (const float*)(ws + WS_SS) + (size_t)(3 * l) * T * 32};
          run_gemm(shm, (const bf16_t*)(ws + WS_XN), (const bf16_t*)(ws + WS_WIN) + (size_t)l * INW * D, T, INW, D, E); }
        GSYNC();
        for (int rep = 0; rep < MIX_REPS; ++rep) {
            dil_attn_units(shm, bid_fresh(), (int)gridDim.x);
            int it0 = bid_fresh(); while (it0 < 1536) it0 += gridDim.x;
            for (int it = it0; it < 1536 + 512 + 256 + 512; it += gridDim.x) {
                PP p = get_pp();
                if (it < 2048) s5_pass1_item(p, shm, it - 1536, l);
                else if (it < 2304) pool_item(p, shm, it - 2048);
                else conv_item(p, shm, it - 2304, l);
            }
        }
        GSYNC();
        for (int rep = 0; rep < P3_REPS; ++rep) for (int it = bid_fresh(); it < 512; it += gridDim.x) s5_pass2_item(get_pp(), shm, it, l);
        for (int rep = 0; rep < NORM_REPS; ++rep) phase_combine(get_pp());
        GSYNC();
        { PP p = get_pp(); unsigned char* ws = p->ws;
          pg8::SmallOrder S{(int)gridDim.x, (int)bid_fresh()};
          pg8::Gemm g{(const bf16_t*)(ws + WS_GPH), (const bf16_t*)(ws + WS_WSM) + (size_t)l * 1536 * 512, T, 1536, 512, 512};
          pg8::EpiSmall E{(bf16_t*)(ws + WS_YN), (const bf16_t*)(ws + WS_GPH), p->in[16] + (size_t)l * 512, (float*)(ws + WS_SSG)};
          pg8::gemm_phase<pg8::EpiSmall, pg8::SmallOrder>((PG8_LAS unsigned char*)shm, g, S, E); }
        GSYNC();
        { PP p = get_pp(); unsigned char* ws = p->ws;
          pg8::StaticOrder S; S.init(T, D, (int)gridDim.x, (int)bid_fresh());
          pg8::Gemm g{(const bf16_t*)(ws + WS_YN), (const bf16_t*)(ws + WS_WOUT) + (size_t)l * D * D, T, D, D, D};
          if (l == 0) { pg8::EpiRes2<2, true> E{p->in[0], (bf16_t*)(ws + WS_XN), (bf16_t*)(ws + WS_H), (float*)(ws + WS_SS) + (size_t)(1 + 3 * l) * T * 32, nullptr};
            pg8::gemm_phase<pg8::EpiRes2<2, true>, pg8::StaticOrder, true, true, true>((PG8_LAS unsigned char*)shm, g, S, E, (const float*)(ws + WS_SSG)); }
          else { pg8::EpiRes2<2, false> E{nullptr, (bf16_t*)(ws + WS_XN), (bf16_t*)(ws + WS_H), (float*)(ws + WS_SS) + (size_t)(1 + 3 * l) * T * 32, nullptr};
            pg8::gemm_phase<pg8::EpiRes2<2, false>, pg8::StaticOrder, true, true, true>((PG8_LAS unsigned char*)shm, g, S, E, (const float*)(ws + WS_SSG)); } }
        GSYNC();
        { PP p = get_pp(); unsigned char* ws = p->ws;
          pg8::SplitOrder S{(int)gridDim.x, (int)bid_fresh()};
          pg8::Gemm g{(const bf16_t*)(ws + WS_XN), (const bf16_t*)(ws + WS_WXQ) + (size_t)l * 512 * D, T, 512, D, 512};
          pg8::EpiPart E{(bf16_t*)(ws + WS_QP)};
          pg8::gemm_phase<pg8::EpiPart, pg8::SplitOrder>((PG8_LAS unsigned char*)shm, g, S, E); }
        GSYNC();
        for (int rep = 0; rep < P9_REPS; ++rep) for (int it = bid_fresh(); it < 256; it += gridDim.x) cross_attn_unit(get_pp(), shm, it, l);
        GSYNC();
        { PP p = get_pp(); unsigned char* ws = p->ws;
          pg8::EpiRes2<2, false> E{nullptr, (bf16_t*)(ws + WS_XN), (bf16_t*)(ws + WS_H), (float*)(ws + WS_SS) + (size_t)(2 + 3 * l) * T * 32, nullptr};
          run_gemm(shm, (const bf16_t*)(ws + WS_OX), (const bf16_t*)(ws + WS_WXO) + (size_t)l * D * 512, T, D, 512, E); }
        GSYNC();
        { PP p = get_pp(); unsigned char* ws = p->ws;
          pg8::EpiBf16<1> E{(bf16_t*)(ws + WS_ACT), DFF, 1.0f, nullptr};
          run_gemm(shm, (const bf16_t*)(ws + WS_XN), (const bf16_t*)(ws + WS_WUP) + (size_t)l * DFF * D, T, DFF, D, E); }
        GSYNC();
        { PP p = get_pp(); unsigned char* ws = p->ws;
          pg8::EpiRes2<2, false> E{nullptr, (bf16_t*)(ws + WS_XN), (bf16_t*)(ws + WS_H), (float*)(ws + WS_SS) + (size_t)(3 + 3 * l) * T * 32, (const float*)(ws + WS_SS) + (size_t)(2 + 3 * l) * T * 32};
          run_gemm(shm, (const bf16_t*)(ws + WS_ACT), (const bf16_t*)(ws + WS_WDN) + (size_t)l * D * DFF, T, D, DFF, E); }
        GSYNC();
    }
    {
        PP p = get_pp(); const bf16_t* hb = (const bf16_t*)(p->ws + WS_XN); const bf16_t* hl = (const bf16_t*)(p->ws + WS_H); const float* gf = p->in[32]; float* outp = p->out;
        const int lane = tid_fresh() & 63, gw = bid_fresh() * 8 + (tid_fresh() >> 6), NGW = gridDim.x * 8;
        for (int r = gw; r < T; r += NGW) {
            float v[4][8]; float sq = 0.f;
#pragma unroll
            for (int j = 0; j < 4; ++j) { float a[8], b[8]; unpack8(*(const u32x4*)(hb + (size_t)r * D + (lane + 64 * j) * 8), a); unpack8(*(const u32x4*)(hl + (size_t)r * D + (lane + 64 * j) * 8), b);
#pragma unroll
                for (int e = 0; e < 8; ++e) { v[j][e] = a[e] + b[e]; sq += v[j][e] * v[j][e]; } }
            sq = wave_sum(sq);
            const float rs = 1.0f / sqrtf(sq * (1.0f / D) + EPS);
#pragma unroll
            for (int j = 0; j < 4; ++j) { const f32x4 g0 = *(const f32x4*)(gf + (lane + 64 * j) * 8), g1 = *(const f32x4*)(gf + (lane + 64 * j) * 8 + 4);
                float* o = outp + (size_t)r * D + (lane + 64 * j) * 8;
                *(f32x4*)o = (f32x4){v[j][0] * rs * g0[0], v[j][1] * rs * g0[1], v[j][2] * rs * g0[2], v[j][3] * rs * g0[3]};
                *(f32x4*)(o + 4) = (f32x4){v[j][4] * rs * g1[0], v[j][5] * rs * g1[1], v[j][6] * rs * g1[2], v[j][7] * rs * g1[3]}; }
        }
    }
}

extern "C" void kernel_launch(void* const* d_in, const int* in_sizes, int n_in, void* d_out, int out_size, void* d_ws, size_t ws_size, hipStream_t stream) {
    static int grid_blocks = 0;
    if (grid_blocks == 0) {
        if (n_in != 33 || ws_size < WS_END) { fprintf(stderr, "kernel_launch: unexpected n_in %d or ws_size %zu (need %zu)\n", n_in, ws_size, (size_t)WS_END); grid_blocks = -1; return; }
        int dev = 0, cus = 0, per_cu = 0;
        (void)hipGetDevice(&dev);
        (void)hipDeviceGetAttribute(&cus, hipDeviceAttributeMultiprocessorCount, dev);
        if (hipFuncSetAttribute((const void*)hymba_fwd, hipFuncAttributeMaxDynamicSharedMemorySize, LDS_BYTES) != hipSuccess) { fprintf(stderr, "kernel_launch: hipFuncSetAttribute failed\n"); }
        if (hipOccupancyMaxActiveBlocksPerMultiprocessor(&per_cu, (const void*)hymba_fwd, 512, LDS_BYTES) != hipSuccess || per_cu < 1) { fprintf(stderr, "kernel_launch: occupancy query says %d\n", per_cu); per_cu = 1; }
        (void)hipGetLastError();
        grid_blocks = cus * 1;
    }
    if (grid_blocks < 0) return;
    (void)hipMemsetAsync((unsigned char*)d_ws + WS_BAR, 0, 16384, stream);
    Params p{};
    for (int i = 0; i < 33; ++i) p.in[i] = (const float*)d_in[i];
    p.out = (float*)d_out; p.ws = (unsigned char*)d_ws;
    void* args[] = {&p};
    hipError_t e = hipLaunchCooperativeKernel((const void*)hymba_fwd, dim3(grid_blocks), dim3(512), args, LDS_BYTES, stream);
    if (e != hipSuccess) fprintf(stderr, "cooperative launch failed: %s (grid %d)\n", hipGetErrorString(e), grid_blocks);
}
```

```cpp
#include <hip/hip_runtime.h>
#include <hip/hip_cooperative_groups.h>
#include <cstdio>
#include <cstdint>
namespace cg = cooperative_groups;

#ifndef N_LAYERS_RUN
#define N_LAYERS_RUN 4
#endif
#ifndef GEMM_REPS
#define GEMM_REPS 1
#endif
#ifndef MIX_REPS
#define MIX_REPS 1
#endif
#ifndef NORM_REPS
#define NORM_REPS 1
#endif
#ifndef P3_REPS
#define P3_REPS 1
#endif
#ifndef P9_REPS
#define P9_REPS 1
#endif
#ifndef SYNC_REPS
#define SYNC_REPS 1
#endif
#define GSYNC() do { for (int _r = 0; _r < SYNC_REPS; ++_r) xcd_barrier(xbar); } while (0)
#ifndef P0_REPS
#define P0_REPS 1
#endif

typedef unsigned short bf16_t;
typedef short bf16x8 __attribute__((ext_vector_type(8)));
typedef short s16x4 __attribute__((ext_vector_type(4)));
typedef float f32x4 __attribute__((ext_vector_type(4)));
typedef unsigned u32x4 __attribute__((ext_vector_type(4)));
typedef unsigned u32x2 __attribute__((ext_vector_type(2)));

constexpr int T = 8192, D = 2048, SEQ = 2048, INW = 3584, DFF = 8192, DEPTH = 4;
constexpr float EPS = 1e-6f;

constexpr size_t SZ_WIN = (size_t)INW * D * 2, SZ_WOUT = (size_t)D * D * 2, SZ_WXQ = (size_t)512 * D * 2, SZ_WXO = (size_t)D * 512 * 2,
                 SZ_WUP = (size_t)DFF * D * 2, SZ_WDN = (size_t)D * DFF * 2, SZ_WSM = (size_t)1536 * 512 * 2;
constexpr size_t WS_WIN = 0;
constexpr size_t WS_WOUT = WS_WIN + 4 * SZ_WIN;
constexpr size_t WS_WXQ = WS_WOUT + 4 * SZ_WOUT;
constexpr size_t WS_WKV = WS_WXQ + 4 * SZ_WXQ;
constexpr size_t WS_WXO = WS_WKV + (size_t)4096 * D * 2;
constexpr size_t WS_WUP = WS_WXO + 4 * SZ_WXO;
constexpr size_t WS_WDN = WS_WUP + 4 * SZ_WUP;
constexpr size_t WS_WSM = WS_WDN + 4 * SZ_WDN;
constexpr size_t WS_H = WS_WSM + 4 * SZ_WSM;
constexpr size_t WS_XN = WS_H + (size_t)T * D * 4;
constexpr size_t WS_PROJ = WS_XN + (size_t)T * D * 2;
constexpr size_t PJ_UA = 0, PJ_UB = (size_t)T * 512, PJ_UC = (size_t)2 * T * 512, PJ_QKV = (size_t)T * 2048;
constexpr size_t WS_GPH = WS_PROJ + (size_t)T * INW * 2;
constexpr size_t WS_YCAT = WS_GPH + (size_t)3 * T * 512 * 2;
constexpr size_t WS_OB = WS_YCAT + (size_t)T * 1536 * 2;
constexpr size_t WS_LSE = WS_OB + (size_t)3 * T * 512 * 2;
constexpr size_t WS_YN = WS_LSE + (size_t)3 * T * 8 * 4;
constexpr size_t WS_QX = WS_YN + (size_t)T * D * 2;
constexpr size_t WS_OX = WS_QX + (size_t)T * 512 * 2;
constexpr size_t WS_KV = WS_OX + (size_t)T * 512 * 2;
constexpr size_t WS_MEMN = WS_KV + (size_t)1024 * 4096 * 2;
constexpr size_t WS_ACT = WS_MEMN + (size_t)1024 * D * 2;
constexpr size_t WS_CARRY = WS_ACT + (size_t)T * DFF * 2;
constexpr size_t WS_DUMMY = WS_CARRY + (size_t)128 * 32 * 64 * 2 * 4;
constexpr size_t WS_BAR = WS_DUMMY + (size_t)T * D * 4;
constexpr size_t WS_SS = WS_BAR + 16384;
constexpr size_t WS_QP = WS_SS + (size_t)13 * T * 32 * 4;
constexpr size_t WS_SSG = WS_QP + (size_t)4 * T * 512 * 4;
constexpr size_t WS_END = WS_SSG + (size_t)T * 32 * 4;

constexpr int LDS_BYTES = 160 * 1024;

struct Params {
    const float* in[33];
    float* out;
    unsigned char* ws;
};

typedef const __attribute__((address_space(4))) Params* PP;
__device__ __forceinline__ PP get_pp() { PP q = (PP)__builtin_amdgcn_kernarg_segment_ptr(); asm volatile("" : "+s"(q)); return q; }
__device__ __forceinline__ int tid_fresh() { int t = threadIdx.x; asm volatile("" : "+v"(t)); return t; }
__device__ __forceinline__ int bid_fresh() { int t = blockIdx.x; asm volatile("" : "+s"(t)); return t; }
__device__ __forceinline__ float bf2f(bf16_t v) { return __uint_as_float(((unsigned)v) << 16); }
__device__ __forceinline__ bf16_t f2bf(float f) { unsigned u = __float_as_uint(f); u += 0x7FFFu + ((u >> 16) & 1u); return (bf16_t)(u >> 16); }
typedef __bf16 hbf16x2 __attribute__((ext_vector_type(2)));
typedef float hf32x2 __attribute__((ext_vector_type(2)));
__device__ __forceinline__ unsigned pk2(float lo, float hi) { const hf32x2 v = {lo, hi}; return __builtin_bit_cast(unsigned, __builtin_convertvector(v, hbf16x2)); }
__device__ __forceinline__ float wave_sum(float v) {
#pragma unroll
    for (int o = 1; o < 64; o <<= 1) v += __shfl_xor(v, o);
    return v;
}
__device__ __forceinline__ void unpack8(const u32x4 v, float (&f)[8]) {
    f[0] = __uint_as_float(v.x << 16); f[1] = __uint_as_float(v.x & 0xffff0000u); f[2] = __uint_as_float(v.y << 16); f[3] = __uint_as_float(v.y & 0xffff0000u);
    f[4] = __uint_as_float(v.z << 16); f[5] = __uint_as_float(v.z & 0xffff0000u); f[6] = __uint_as_float(v.w << 16); f[7] = __uint_as_float(v.w & 0xffff0000u);
}
__device__ __forceinline__ float sigmoidf_(float x) { return 1.0f / (1.0f + __expf(-x)); }


#define XB_TMO      128
#define XB_XCNT(j)  (256  + 64 * (j))
#define XB_XSUB(j)  (1280 + 64 * (j))
#define XB_XGEN(j)  (2304 + 64 * (j))
#define XB_TOP      3328
#define XB_TOPGEN   3392
#define XCD_BAR_WORDS 3456
#define XB_SPIN_CAP (1u << 20)
#define LAS __attribute__((address_space(3)))
__device__ __forceinline__ unsigned xb_ld(unsigned* p)              { return __hip_atomic_load(p, __ATOMIC_RELAXED, __HIP_MEMORY_SCOPE_AGENT); }
__device__ __forceinline__ unsigned xb_add(unsigned* p, unsigned v) { return __hip_atomic_fetch_add(p, v, __ATOMIC_RELAXED, __HIP_MEMORY_SCOPE_AGENT); }
__device__ __forceinline__ unsigned xb_xcc_id() { return (unsigned)__builtin_amdgcn_s_getreg((3 << 11) | 20) & 0xFu; }
#define XB_SPIN(cond, bar) do { unsigned _sp = 0; while (cond) { __builtin_amdgcn_s_sleep(1); \
    if ((++_sp & 255u) == 0u) { if (xb_ld(&(bar)[XB_TMO])) break; if (_sp > XB_SPIN_CAP) { atomicAdd(&(bar)[XB_TMO], 1u); break; } } } } while (0)
struct XcdBarrier { unsigned* bar; unsigned x; volatile LAS unsigned* st; };
__device__ __forceinline__ XcdBarrier xcd_barrier_post(unsigned* bar, volatile LAS unsigned* st) {
    XcdBarrier b; b.bar = bar; b.x = xb_xcc_id(); b.st = st;
    if (threadIdx.x == 0) (void)xb_add(&bar[XB_XCNT(b.x)], 1u);
    return b;
}
__device__ __forceinline__ void xcd_barrier_complete(unsigned* bar, unsigned x, unsigned& nloc, unsigned& nx) {
    const unsigned G = gridDim.x * gridDim.y * gridDim.z;
    unsigned sum, cnt, mine, sp = 0u;
    for (;;) {
        sum = 0u; cnt = 0u; mine = 0u;
#pragma unroll
        for (unsigned j = 0; j < 16; ++j) { const unsigned c = xb_ld(&bar[XB_XCNT(j)]); sum += c; cnt += (c > 0u) ? 1u : 0u; mine = (j == x) ? c : mine; }
        if (sum == G) break;
        __builtin_amdgcn_s_sleep(1);
        if ((++sp & 255u) == 0u) { if (xb_ld(&bar[XB_TMO])) break; if (sp > XB_SPIN_CAP) { atomicAdd(&bar[XB_TMO], 1u); break; } }
    }
    nloc = mine > 0u ? mine : 1u; nx = cnt > 0u ? cnt : 1u;
}
__device__ __forceinline__ void xcd_barrier(const XcdBarrier& b) {
    asm volatile("s_waitcnt vmcnt(0)" ::: "memory");
    __syncthreads();
    if (threadIdx.x == 0) {
        unsigned* bar = b.bar;
        __builtin_amdgcn_s_waitcnt(0);
        unsigned nloc = b.st[0], nx = b.st[1];
        if (nloc == 0u) { xcd_barrier_complete(bar, b.x, nloc, nx); b.st[0] = nloc; b.st[1] = nx; }
        const unsigned old = xb_add(&bar[XB_XSUB(b.x)], 1u);
        const unsigned gen = old / nloc;
        if (old + 1u == (gen + 1u) * nloc) {
            __builtin_amdgcn_fence(__ATOMIC_RELEASE, "agent");
            asm volatile("s_waitcnt vmcnt(0)" ::: "memory");
            const unsigned og = xb_add(&bar[XB_TOP], 1u);
            const unsigned tg = og / nx;
            if (og + 1u == (tg + 1u) * nx) xb_add(&bar[XB_TOPGEN], 1u);
            else XB_SPIN(xb_ld(&bar[XB_TOPGEN]) == tg, bar);
            __builtin_amdgcn_fence(__ATOMIC_ACQUIRE, "agent");
            xb_add(&bar[XB_XGEN(b.x)], 1u);
            asm volatile("s_waitcnt vmcnt(0)" ::: "memory");
        } else {
            XB_SPIN(xb_ld(&bar[XB_XGEN(b.x)]) == gen, bar);
            __builtin_amdgcn_fence(__ATOMIC_ACQUIRE, "agent");
            asm volatile("s_waitcnt vmcnt(0)" ::: "memory");
        }
    }
    __syncthreads();
}

namespace pg8 {
#define PG8_LAS __attribute__((address_space(3)))
constexpr int BM = 256, BK = 64, HALF = 128, HTB = HALF * BK * 2, STAGE_BYTES = 8 * HTB, NXCD = 8, WGM = 8;
__host__ __device__ __forceinline__ int lds_byte(int r, int c) { const int st = (r >> 4) * 2 + (c >> 5), rr = r & 15, cc = c & 31, ob = rr * 64 + cc * 2; return st * 1024 + (ob ^ (((ob >> 9) & 1) << 5)); }
__host__ __device__ __forceinline__ void stage_rc(int b, int& R, int& C) { const int st = b / 1024, sb = b % 1024, swz = sb ^ (((sb >> 9) & 1) << 5); R = (st >> 1) * 16 + swz / 64; C = (st & 1) * 32 + (swz % 64) / 2; }
__host__ __device__ __forceinline__ int perm32(int rho) { const int n = rho >> 4, i = rho & 15; return 8 * (i >> 2) + 4 * n + (i & 3); }
struct Unit { int pm, pn; };
struct Gemm { const bf16_t* A; const bf16_t* Bt; int M, N, K; int Kloop; };
struct StaticOrder {
    int nM, nN, nwg, G, c;
    __device__ void init(int M, int N, int G_, int c_) { nM = M / BM; nN = N / BM; nwg = nM * nN; G = G_; c = c_; }
    __device__ bool next(int i, Unit& u) const {
        const long L = (long)i * G + c; if (L >= nwg) return false;
        int wgid = (int)L; { const int q = nwg / NXCD, r = nwg % NXCD, xcd = wgid % NXCD, off = wgid / NXCD; wgid = (xcd < r ? xcd * (q + 1) : r * (q + 1) + (xcd - r) * q) + off; }
        const int nig = WGM * nN, gid = wgid / nig, fm = gid * WGM, gsz = (nM - fm) < WGM ? (nM - fm) : WGM;
        u.pm = fm + ((wgid % nig) % gsz); u.pn = (wgid % nig) / gsz; return true;
    }
    __device__ __forceinline__ size_t a_extra(const Unit&) const { return 0; }
    __device__ __forceinline__ size_t b_extra(const Unit&) const { return 0; }
};
struct SmallOrder {
    int G, c;
    __device__ bool next(int i, Unit& u) const { const int L = i * G + c; if (L >= 192) return false; u.pm = L / 6; u.pn = L % 6; return true; }
    __device__ __forceinline__ size_t a_extra(const Unit& u) const { return (size_t)(u.pn >> 1) * ((size_t)T * 512 * 2); }
    __device__ __forceinline__ size_t b_extra(const Unit&) const { return 0; }
};
struct SplitOrder {
    int G, c;
    __device__ bool next(int i, Unit& u) const { const int L = i * G + c; if (L >= 256) return false; u.pm = L >> 3; u.pn = L & 7; return true; }
    __device__ __forceinline__ size_t a_extra(const Unit& u) const { return (size_t)(u.pn >> 1) * 512 * 2; }
    __device__ __forceinline__ size_t b_extra(const Unit& u) const { return (size_t)(u.pn >> 1) * 512 * 2 - (size_t)(u.pn & ~1) * ((size_t)256 * D * 2); }
};
__device__ __forceinline__ unsigned cvt_pk_bf16(float lo, float hi) { unsigned r; asm volatile("v_cvt_pk_bf16_f32 %0, %1, %2" : "=v"(r) : "v"(lo), "v"(hi)); return r; }

template <int ACT  > struct EpiBf16 {
    static constexpr bool PERM = true;
    bf16_t* O; int ldc; float scale; const float* ss;
    __device__ __forceinline__ void operator()(const f32x4 (&acc)[2][2][4][2], const Unit& u, int wr, int wc, int fr, int fq) const {
        const int row0 = u.pm * BM + wr * 64 + fr, col0 = u.pn * BM + wc * 32 + 8 * fq;
        float rsv[2][4];
        if (ss) {
            f32x4 p0[2][4], p1[2][4];
#pragma unroll
            for (int ai = 0; ai < 2; ++ai)
#pragma unroll
                for (int m = 0; m < 4; ++m) { const float* sp = ss + (size_t)(row0 + ai * HALF + m * 16) * 32 + fq * 8; p0[ai][m] = *(const f32x4*)sp; p1[ai][m] = *(const f32x4*)(sp + 4); }
#pragma unroll
            for (int ai = 0; ai < 2; ++ai)
#pragma unroll
                for (int m = 0; m < 4; ++m) { float t = ((p0[ai][m][0] + p0[ai][m][1]) + (p0[ai][m][2] + p0[ai][m][3])) + ((p1[ai][m][0] + p1[ai][m][1]) + (p1[ai][m][2] + p1[ai][m][3]));
                    t += __shfl_xor(t, 16); t += __shfl_xor(t, 32);
                    rsv[ai][m] = scale / sqrtf(t * (1.0f / D) + EPS); }
        } else {
#pragma unroll
            for (int ai = 0; ai < 2; ++ai)
#pragma unroll
                for (int m = 0; m < 4; ++m) rsv[ai][m] = scale;
        }
#pragma unroll
        for (int ai = 0; ai < 2; ++ai)
#pragma unroll
            for (int m = 0; m < 4; ++m) { const int row = row0 + ai * HALF + m * 16; bf16_t* rowp = O + (size_t)row * ldc + col0;
                const float rs = rsv[ai][m];
#pragma unroll
                for (int bj = 0; bj < 2; ++bj) { f32x4 v0 = acc[ai][bj][m][0] * rs, v1 = acc[ai][bj][m][1] * rs;
                    if (ACT == 1) {
#pragma unroll
                        for (int e = 0; e < 4; ++e) { float a = fmaxf(v0[e], 0.f), b = fmaxf(v1[e], 0.f); v0[e] = a * a; v1[e] = b * b; } }
                    u32x4 o; o.x = cvt_pk_bf16(v0[0], v0[1]); o.y = cvt_pk_bf16(v0[2], v0[3]); o.z = cvt_pk_bf16(v1[0], v1[1]); o.w = cvt_pk_bf16(v1[2], v1[3]);
                    *(u32x4*)(rowp + bj * HALF) = o; } }
    }
};
struct EpiWin {
    static constexpr bool PERM = true;
    bf16_t* P; const float* ss;
    __device__ __forceinline__ void operator()(const f32x4 (&acc)[2][2][4][2], const Unit& u, int wr, int wc, int fr, int fq) const {
        const int row0 = u.pm * BM + wr * 64 + fr;
        float rsv[2][4];
        {
            f32x4 p0[2][4], p1[2][4];
#pragma unroll
            for (int ai = 0; ai < 2; ++ai)
#pragma unroll
                for (int m = 0; m < 4; ++m) { const float* sp = ss + (size_t)(row0 + ai * HALF + m * 16) * 32 + fq * 8; p0[ai][m] = *(const f32x4*)sp; p1[ai][m] = *(const f32x4*)(sp + 4); }
#pragma unroll
            for (int ai = 0; ai < 2; ++ai)
#pragma unroll
                for (int m = 0; m < 4; ++m) { float t = ((p0[ai][m][0] + p0[ai][m][1]) + (p0[ai][m][2] + p0[ai][m][3])) + ((p1[ai][m][0] + p1[ai][m][1]) + (p1[ai][m][2] + p1[ai][m][3]));
                    t += __shfl_xor(t, 16); t += __shfl_xor(t, 32);
                    rsv[ai][m] = 1.0f / sqrtf(t * (1.0f / D) + EPS); }
        }
#pragma unroll
        for (int ai = 0; ai < 2; ++ai)
#pragma unroll
            for (int m = 0; m < 4; ++m) { const int row = row0 + ai * HALF + m * 16; const float rs = rsv[ai][m];
#pragma unroll
                for (int bj = 0; bj < 2; ++bj) { const f32x4 v0 = acc[ai][bj][m][0] * rs, v1 = acc[ai][bj][m][1] * rs;
                    u32x4 o; o.x = cvt_pk_bf16(v0[0], v0[1]); o.y = cvt_pk_bf16(v0[2], v0[3]); o.z = cvt_pk_bf16(v1[0], v1[1]); o.w = cvt_pk_bf16(v1[2], v1[3]);
                    bf16_t* dst;
                    if (u.pn < 4) { const int colg = u.pn * BM + bj * HALF + wc * 32 + 8 * fq; dst = P + (size_t)(colg >> 9) * ((size_t)T * 512) + (size_t)row * 512 + (colg & 511); }
                    else if (u.pn < 8) { const int colc = (u.pn - 4) * BM + bj * HALF + wc * 32 + 8 * fq; dst = P + PJ_UC + (size_t)row * 1024 + colc; }
                    else { const int which = (u.pn - 8) >> 1, hd = ((u.pn - 8) & 1) * 4 + 2 * bj + (wc >> 1), dim = 32 * (wc & 1) + 8 * fq, bb = row >> 11, ll = row & 2047;
                        dst = P + PJ_QKV + ((size_t)(((which * 4 + bb) * 8 + hd) * SEQ + ll)) * 64 + dim; }
                    *(u32x4*)dst = o; } }
    }
};
template <int MB  > struct EpiRes {
    static constexpr bool PERM = false;
    const float* Hin; float* Hout; bf16_t* Hb; float* ss; const float* ssin;
    __device__ __forceinline__ void operator()(const f32x4 (&acc)[2][2][4][2], const Unit& u, int wr, int wc, int fr, int fq) const {
        const int row0 = u.pm * BM + wr * 64 + fr, col0 = u.pn * BM + wc * 32 + 4 * fq;
        float rsc[2][4];
        if (ssin) {
#pragma unroll
            for (int ai = 0; ai < 2; ++ai) {
                f32x4 q0[4], q1[4];
#pragma unroll
                for (int m = 0; m < 4; ++m) { const float* sp = ssin + (size_t)(row0 + ai * HALF + m * 16) * 32 + fq * 8; q0[m] = *(const f32x4*)sp; q1[m] = *(const f32x4*)(sp + 4); }
#pragma unroll
                for (int m = 0; m < 4; ++m) { float t = ((q0[m][0] + q0[m][1]) + (q0[m][2] + q0[m][3])) + ((q1[m][0] + q1[m][1]) + (q1[m][2] + q1[m][3]));
                    t += __shfl_xor(t, 16); t += __shfl_xor(t, 32); rsc[ai][m] = 1.0f / (t * (1.0f / D) + EPS); }
                asm volatile("" ::: "memory");
            }
        } else {
#pragma unroll
            for (int ai = 0; ai < 2; ++ai)
#pragma unroll
                for (int m = 0; m < 4; ++m) rsc[ai][m] = 1.0f;
        }
#pragma unroll
        for (int ai = 0; ai < 2; ++ai)
#pragma unroll
        for (int mh = 0; mh < 4; mh += MB) {
            f32x4 hv[MB][2][2];
#pragma unroll
            for (int m = 0; m < MB; ++m)
#pragma unroll
                for (int bj = 0; bj < 2; ++bj)
#pragma unroll
                    for (int n = 0; n < 2; ++n) hv[m][bj][n] = *(const f32x4*)(Hin + (size_t)(row0 + ai * HALF + (mh + m) * 16) * D + col0 + bj * HALF + n * 16);
#pragma unroll
            for (int m = 0; m < MB; ++m) { const int row = row0 + ai * HALF + (mh + m) * 16; const size_t off = (size_t)row * D + col0; float sq = 0.f;
                const float rs1 = rsc[ai][mh + m];
#pragma unroll
                for (int bj = 0; bj < 2; ++bj)
#pragma unroll
                    for (int n = 0; n < 2; ++n) { const size_t idx = off + bj * HALF + n * 16; const f32x4 o = hv[m][bj][n] + acc[ai][bj][mh + m][n] * rs1;
                        *(f32x4*)(Hout + idx) = o; sq += o[0] * o[0] + o[1] * o[1] + o[2] * o[2] + o[3] * o[3];
                        if (Hb) { u32x2 w; w.x = cvt_pk_bf16(o[0], o[1]); w.y = cvt_pk_bf16(o[2], o[3]); *(u32x2*)(Hb + idx) = w; } }
                if (ss) { sq += __shfl_xor(sq, 16); sq += __shfl_xor(sq, 32); if (fq == 0) ss[(size_t)row * 32 + u.pn * 4 + wc] = sq; } }
        }
    }
    __device__ __forceinline__ void gs(const f32x4 (&acc)[2][2][4][2], const Unit& u, int wr, int wc, int fr, int fq, const PG8_LAS float* rtab) const {
        const int row0 = u.pm * BM + wr * 64 + fr, col0 = u.pn * BM + wc * 32 + 4 * fq;
#pragma unroll
        for (int ai = 0; ai < 2; ++ai)
#pragma unroll
        for (int mh = 0; mh < 4; mh += MB) {
            f32x4 hv[MB][2][2];
#pragma unroll
            for (int m = 0; m < MB; ++m)
#pragma unroll
                for (int bj = 0; bj < 2; ++bj)
#pragma unroll
                    for (int n = 0; n < 2; ++n) hv[m][bj][n] = *(const f32x4*)(Hin + (size_t)(row0 + ai * HALF + (mh + m) * 16) * D + col0 + bj * HALF + n * 16);
#pragma unroll
            for (int m = 0; m < MB; ++m) { const int rl = ai * HALF + wr * 64 + (mh + m) * 16 + fr, row = u.pm * BM + rl; const size_t off = (size_t)row * D + col0; float sq = 0.f;
                const float rs1 = rtab[3 * 256 + rl];
#pragma unroll
                for (int bj = 0; bj < 2; ++bj)
#pragma unroll
                    for (int n = 0; n < 2; ++n) { const size_t idx = off + bj * HALF + n * 16; const f32x4 o = hv[m][bj][n] + acc[ai][bj][mh + m][n] * rs1;
                        *(f32x4*)(Hout + idx) = o; sq += o[0] * o[0] + o[1] * o[1] + o[2] * o[2] + o[3] * o[3];
                        if (Hb) { u32x2 w; w.x = cvt_pk_bf16(o[0], o[1]); w.y = cvt_pk_bf16(o[2], o[3]); *(u32x2*)(Hb + idx) = w; } }
                if (ss) { sq += __shfl_xor(sq, 16); sq += __shfl_xor(sq, 32); if (fq == 0) ss[(size_t)row * 32 + u.pn * 4 + wc] = sq; } }
        }
    }
};
template <int MB  , bool F32IN> struct EpiRes2 {
    static constexpr bool PERM = true;
    const float* Xin; bf16_t* Hb; unsigned char* Hl; float* ss; const float* ssin;
    __device__ __forceinline__ void core(const f32x4 (&acc)[2][2][4][2], const Unit& u, int wr, int wc, int fr, int fq, const float (&rsc)[2][4]) const {
        const int row0 = u.pm * BM + wr * 64 + fr, col0 = u.pn * BM + wc * 32 + 8 * fq;
#pragma unroll
        for (int ai = 0; ai < 2; ++ai)
#pragma unroll
        for (int mh = 0; mh < 4; mh += MB) {
            u32x4 va[MB][2]; u32x2 vb[MB][2];
            f32x4 xa[MB][2], xb[MB][2];
#pragma unroll
            for (int m = 0; m < MB; ++m)
#pragma unroll
                for (int bj = 0; bj < 2; ++bj) { const size_t idx = (size_t)(row0 + ai * HALF + (mh + m) * 16) * D + col0 + bj * HALF;
                    if (F32IN) { xa[m][bj] = *(const f32x4*)(Xin + idx); xb[m][bj] = *(const f32x4*)(Xin + idx + 4); }
                    else { va[m][bj] = *(const u32x4*)(Hb + idx); vb[m][bj] = *(const u32x2*)(Hl + idx); } }
#pragma unroll
            for (int m = 0; m < MB; ++m) { const int row = row0 + ai * HALF + (mh + m) * 16; float sq = 0.f;
                const float rs1 = rsc[ai][mh + m];
#pragma unroll
                for (int bj = 0; bj < 2; ++bj) { const size_t idx = (size_t)row * D + col0 + bj * HALF;
                    unsigned hw[4]; int lw[2] = {0, 0};
#pragma unroll
                    for (int pq = 0; pq < 4; ++pq) {
                        float h0, h1;
                        if (F32IN) { h0 = (pq < 2) ? xa[m][bj][2 * pq] : xb[m][bj][2 * pq - 4]; h1 = (pq < 2) ? xa[m][bj][2 * pq + 1] : xb[m][bj][2 * pq - 3]; }
                        else { const unsigned a = va[m][bj][pq]; const int bw = (int)vb[m][bj][pq >> 1]; const hf32x2 lp = (pq & 1) ? __builtin_amdgcn_cvt_pk_f32_fp8(bw, true) : __builtin_amdgcn_cvt_pk_f32_fp8(bw, false);
                            h0 = __uint_as_float(a << 16) + lp.x * 0.00390625f; h1 = __uint_as_float(a & 0xffff0000u) + lp.y * 0.00390625f; }
                        const float o0 = h0 + acc[ai][bj][mh + m][pq >> 1][(2 * pq) & 3] * rs1, o1 = h1 + acc[ai][bj][mh + m][pq >> 1][(2 * pq + 1) & 3] * rs1;
                        sq += o0 * o0 + o1 * o1;
                        const unsigned hi = cvt_pk_bf16(o0, o1);
                        hw[pq] = hi;
                        const float r0 = __builtin_amdgcn_fmed3f((o0 - __uint_as_float(hi << 16)) * 256.0f, -448.0f, 448.0f), r1 = __builtin_amdgcn_fmed3f((o1 - __uint_as_float(hi & 0xffff0000u)) * 256.0f, -448.0f, 448.0f);
                        lw[pq >> 1] = (pq & 1) ? __builtin_amdgcn_cvt_pk_fp8_f32(r0, r1, lw[pq >> 1], true) : __builtin_amdgcn_cvt_pk_fp8_f32(r0, r1, lw[pq >> 1], false);
                    }
                    *(u32x4*)(Hb + idx) = (u32x4){hw[0], hw[1], hw[2], hw[3]}; *(u32x2*)(Hl + idx) = (u32x2){(unsigned)lw[0], (unsigned)lw[1]}; }
                sq += __shfl_xor(sq, 16); sq += __shfl_xor(sq, 32); if (fq == 0) ss[(size_t)row * 32 + u.pn * 4 + wc] = sq; }
        }
    }
    __device__ __forceinline__ void operator()(const f32x4 (&acc)[2][2][4][2], const Unit& u, int wr, int wc, int fr, int fq) const {
        const int row0 = u.pm * BM + wr * 64 + fr;
        float rsc[2][4];
        if (ssin) {
#pragma unroll
            for (int ai = 0; ai < 2; ++ai) {
                f32x4 q0[4], q1[4];
#pragma unroll
                for (int m = 0; m < 4; ++m) { const float* sp = ssin + (size_t)(row0 + ai * HALF + m * 16) * 32 + fq * 8; q0[m] = *(const f32x4*)sp; q1[m] = *(const f32x4*)(sp + 4); }
#pragma unroll
                for (int m = 0; m < 4; ++m) { float t = ((q0[m][0] + q0[m][1]) + (q0[m][2] + q0[m][3])) + ((q1[m][0] + q1[m][1]) + (q1[m][2] + q1[m][3]));
                    t += __shfl_xor(t, 16); t += __shfl_xor(t, 32); rsc[ai][m] = 1.0f / (t * (1.0f / D) + EPS); }
                asm volatile("" ::: "memory");
            }
        } else {
#pragma unroll
            for (int ai = 0; ai < 2; ++ai)
#pragma unroll
                for (int m = 0; m < 4; ++m) rsc[ai][m] = 1.0f;
        }
        core(acc, u, wr, wc, fr, fq, rsc);
    }
    __device__ __forceinline__ void gs(const f32x4 (&acc)[2][2][4][2], const Unit& u, int wr, int wc, int fr, int fq, const PG8_LAS float* rtab) const {
        float rsc[2][4];
#pragma unroll
        for (int ai = 0; ai < 2; ++ai)
#pragma unroll
            for (int m = 0; m < 4; ++m) rsc[ai][m] = rtab[3 * 256 + ai * HALF + wr * 64 + m * 16 + fr];
        core(acc, u, wr, wc, fr, fq, rsc);
    }
};
struct EpiPart {
    static constexpr bool PERM = true;
    bf16_t* Q;
    __device__ __forceinline__ void operator()(const f32x4 (&acc)[2][2][4][2], const Unit& u, int wr, int wc, int fr, int fq) const {
        const int row0 = u.pm * BM + wr * 64 + fr, col0 = (u.pn & 1) * BM + wc * 32 + 8 * fq;
        bf16_t* base = Q + (size_t)(u.pn >> 1) * ((size_t)T * 512);
#pragma unroll
        for (int ai = 0; ai < 2; ++ai)
#pragma unroll
            for (int m = 0; m < 4; ++m) { bf16_t* rowp = base + (size_t)(row0 + ai * HALF + m * 16) * 512 + col0;
#pragma unroll
                for (int bj = 0; bj < 2; ++bj) { const f32x4 v0 = acc[ai][bj][m][0], v1 = acc[ai][bj][m][1];
                    u32x4 o; o.x = cvt_pk_bf16(v0[0], v0[1]); o.y = cvt_pk_bf16(v0[2], v0[3]); o.z = cvt_pk_bf16(v1[0], v1[1]); o.w = cvt_pk_bf16(v1[2], v1[3]);
                    *(u32x4*)(rowp + bj * HALF) = o; } }
    }
};
struct EpiSmall {
    static constexpr bool PERM = true;
    bf16_t* Y; const bf16_t* Gm; const float* pscale; float* ssg;
    __device__ __forceinline__ void operator()(const f32x4 (&acc)[2][2][4][2], const Unit& u, int wr, int wc, int fr, int fq) const {
        const int kind = u.pn >> 1;
        const int row0 = u.pm * BM + wr * 64 + fr, colk = (u.pn & 1) * BM + wc * 32 + 8 * fq;
        f32x4 ps[2][2];
        if (kind == 1) {
#pragma unroll
            for (int bj = 0; bj < 2; ++bj) { ps[bj][0] = *(const f32x4*)(pscale + colk + bj * HALF); ps[bj][1] = *(const f32x4*)(pscale + colk + bj * HALF + 4); } }
#pragma unroll
        for (int ai = 0; ai < 2; ++ai) {
            u32x4 gv[4][2];
            if (kind == 0) {
#pragma unroll
                for (int m = 0; m < 4; ++m)
#pragma unroll
                    for (int bj = 0; bj < 2; ++bj) gv[m][bj] = *(const u32x4*)(Gm + (size_t)(row0 + ai * HALF + m * 16) * 512 + colk + bj * HALF); }
#pragma unroll
            for (int m = 0; m < 4; ++m) { const int row = row0 + ai * HALF + m * 16; float sq = 0.f;
#pragma unroll
                for (int bj = 0; bj < 2; ++bj) { f32x4 v0 = acc[ai][bj][m][0], v1 = acc[ai][bj][m][1]; const int c = colk + bj * HALF;
                    if (kind == 0) { const u32x4 g4 = gv[m][bj];
                        float g[8]; g[0] = __uint_as_float(g4.x << 16); g[1] = __uint_as_float(g4.x & 0xffff0000u); g[2] = __uint_as_float(g4.y << 16); g[3] = __uint_as_float(g4.y & 0xffff0000u);
                        g[4] = __uint_as_float(g4.z << 16); g[5] = __uint_as_float(g4.z & 0xffff0000u); g[6] = __uint_as_float(g4.w << 16); g[7] = __uint_as_float(g4.w & 0xffff0000u);
#pragma unroll
                        for (int e = 0; e < 4; ++e) { v0[e] = g[e] * sigmoidf_(v0[e]); v1[e] = g[4 + e] * sigmoidf_(v1[e]); } }
                    else if (kind == 1) { v0 = v0 * ps[bj][0]; v1 = v1 * ps[bj][1]; }
                    sq += (v0[0] * v0[0] + v0[1] * v0[1]) + (v0[2] * v0[2] + v0[3] * v0[3]) + (v1[0] * v1[0] + v1[1] * v1[1]) + (v1[2] * v1[2] + v1[3] * v1[3]);
                    u32x4 o; o.x = cvt_pk_bf16(v0[0], v0[1]); o.y = cvt_pk_bf16(v0[2], v0[3]); o.z = cvt_pk_bf16(v1[0], v1[1]); o.w = cvt_pk_bf16(v1[2], v1[3]);
                    *(u32x4*)(Y + (size_t)row * D + kind * 512 + c) = o; }
                sq += __shfl_xor(sq, 16); sq += __shfl_xor(sq, 32);
                if (fq == 0) ssg[(size_t)row * 32 + kind * 8 + (u.pn & 1) * 4 + wc] = sq; }
        }
    }
};

struct WinKvOrder {
    StaticOrder so; size_t a_delta, b_delta;
    __device__ bool next(int i, Unit& u) const {
        if (so.next(i, u)) return true;
        const int L = i * so.G + so.c - so.nwg; if (L >= 64) return false;
        u.pm = L & 3; u.pn = 14 + (L >> 2); return true;
    }
    __device__ __forceinline__ size_t a_extra(const Unit& u) const { return u.pn >= 14 ? a_delta : 0; }
    __device__ __forceinline__ size_t b_extra(const Unit& u) const { return u.pn >= 14 ? b_delta - (size_t)14 * ((size_t)256 * D * 2) : 0; }
};
struct EpiWinKv {
    static constexpr bool PERM = true;
    EpiWin win; EpiBf16<0> kv;
    __device__ __forceinline__ void operator()(const f32x4 (&acc)[2][2][4][2], const Unit& u, int wr, int wc, int fr, int fq) const {
        if (u.pn >= 14) { Unit v; v.pm = u.pm; v.pn = u.pn - 14; kv(acc, v, wr, wc, fr, fq); } else win(acc, u, wr, wc, fr, fq);
    }
};
template <class Epi, class Sched, bool ALIGN_EPI = true, bool SP2 = true, bool GS = false>
__device__ __forceinline__ void gemm_phase(PG8_LAS unsigned char* lds, const Gemm g, const Sched& S, const Epi& E, const float* gs_ss = nullptr) {
    const int tid = tid_fresh(), wid = __builtin_amdgcn_readfirstlane(tid >> 6), lane = tid & 63, wr = wid >> 2, wc = wid & 3, fr = lane & 15, fq = lane >> 4;
    const int K = g.K, nt = g.Kloop / BK;
    unsigned voffA[2], voffB[2];
#pragma unroll
    for (int i = 0; i < 2; ++i) { int R, C; stage_rc(tid * 16 + i * 8192, R, C); const int Rb = Epi::PERM ? ((R & ~31) + perm32(R & 31)) : R;
        voffA[i] = (unsigned)(R * K + C) * 2u; voffB[i] = (unsigned)(Rb * K + C) * 2u; }
    const size_t kstep = (size_t)(BK * 2);
    const size_t hstep = (size_t)HALF * K * 2;
    const size_t tstep = 2 * hstep;
    const unsigned ldsw = (unsigned)wid * 1024u;
    const int aoff = lds_byte(wr * 64 + fr, fq * 8), boff = lds_byte(wc * 32 + fr, fq * 8);
#define PG8_GS_BUILD(uu, par) do { if constexpr (GS) { const int _row = tid >> 1, _g0 = (tid & 1) * 2; \
        const float* _sp = gs_ss + ((size_t)((uu).pm * BM + _row)) * 32 + _g0 * 8; \
        const f32x4 _a0 = *(const f32x4*)_sp, _a1 = *(const f32x4*)(_sp + 4), _b0 = *(const f32x4*)(_sp + 8), _b1 = *(const f32x4*)(_sp + 12); \
        const float _s0 = ((_a0[0] + _a0[1]) + (_a0[2] + _a0[3])) + ((_a1[0] + _a1[1]) + (_a1[2] + _a1[3])), _s1 = ((_b0[0] + _b0[1]) + (_b0[2] + _b0[3])) + ((_b1[0] + _b1[1]) + (_b1[2] + _b1[3])); \
        PG8_LAS float* _t = (PG8_LAS float*)(lds + STAGE_BYTES + (par) * 4096); \
        _t[_g0 * 256 + _row] = 1.0f / sqrtf(_s0 * (1.0f / 512.0f) + EPS); _t[(_g0 + 1) * 256 + _row] = 1.0f / sqrtf(_s1 * (1.0f / 512.0f) + EPS); } } while (0)
#define PG8_GS_SCALE(gb, par) do { if constexpr (GS) { const PG8_LAS float* _t = (const PG8_LAS float*)(lds + STAGE_BYTES + (par) * 4096); \
        _Pragma("unroll") for (int _ai = 0; _ai < 2; ++_ai) _Pragma("unroll") for (int _m = 0; _m < 4; ++_m) { const int _rl = _ai * HALF + wr * 64 + _m * 16 + fr; \
            const float _f = _t[(gb) * 256 + _rl] / _t[((gb) + 1) * 256 + _rl]; \
            _Pragma("unroll") for (int _bj = 0; _bj < 2; ++_bj) _Pragma("unroll") for (int _n = 0; _n < 2; ++_n) acc[_ai][_bj][_m][_n] = acc[_ai][_bj][_m][_n] * _f; } } } while (0)
#define PG8_SA(b, h) (((b) * 2 + (h)) * HTB)
#define PG8_SB(b, h) ((4 + (b) * 2 + (h)) * HTB)
#define PG8_STAGE(bufoff, gbase, voff) do { _Pragma("unroll") for (int _i = 0; _i < 2; ++_i) \
        __builtin_amdgcn_global_load_lds((const unsigned*)((const char*)(gbase) + (voff)[_i]), (PG8_LAS unsigned*)(lds + (bufoff) + ldsw + _i * 8192), 16, 0, 0); } while (0)
#define PG8_LDA(dst, b, h) do { _Pragma("unroll") for (int m = 0; m < 4; ++m) _Pragma("unroll") for (int k = 0; k < 2; ++k) dst[m][k] = *(const PG8_LAS bf16x8*)(lds + PG8_SA(b, h) + aoff + m * 2048 + k * 1024); } while (0)
#define PG8_LDB(dst, b, h) do { _Pragma("unroll") for (int n = 0; n < 2; ++n) _Pragma("unroll") for (int k = 0; k < 2; ++k) dst[n][k] = *(const PG8_LAS bf16x8*)(lds + PG8_SB(b, h) + boff + n * 2048 + k * 1024); } while (0)
#define PG8_MMA(ai, bj, At, Bt) do { __builtin_amdgcn_s_setprio(1); _Pragma("unroll") for (int m = 0; m < 4; ++m) _Pragma("unroll") for (int n = 0; n < 2; ++n) _Pragma("unroll") for (int k = 0; k < 2; ++k) \
        acc[ai][bj][m][n] = __builtin_amdgcn_mfma_f32_16x16x32_bf16(Bt[n][k], At[m][k], acc[ai][bj][m][n], 0, 0, 0); __builtin_amdgcn_s_setprio(0); } while (0)
#define PG8_WAIT_V(n) asm volatile("s_waitcnt vmcnt(" #n ")" ::: "memory")
#define PG8_WAIT_L(n) asm volatile("s_waitcnt lgkmcnt(" #n ")" ::: "memory")
#define PG8_BAR __builtin_amdgcn_s_barrier()
#define PG8_SCHED __builtin_amdgcn_sched_barrier(0)
    Unit cur, nxt; int ui = 0;
    if (!S.next(0, cur)) return;
    f32x4 acc[2][2][4][2];
#pragma unroll
    for (int a = 0; a < 2; ++a)
#pragma unroll
        for (int b = 0; b < 2; ++b)
#pragma unroll
            for (int m = 0; m < 4; ++m)
#pragma unroll
                for (int n = 0; n < 2; ++n) acc[a][b][m][n] = (f32x4){0.f, 0.f, 0.f, 0.f};
    bf16x8 At[4][2], B0[2][2], B1[2][2];
    const char* cA = (const char*)g.A + S.a_extra(cur) + (size_t)cur.pm * tstep; const char* cB = (const char*)g.Bt + S.b_extra(cur) + (size_t)cur.pn * tstep;
    int gpar = 0;
    PG8_GS_BUILD(cur, 0);
    if constexpr (SP2) {
        PG8_STAGE(PG8_SB(0, 0), cB, voffB); PG8_STAGE(PG8_SB(0, 1), cB + hstep, voffB); PG8_STAGE(PG8_SA(0, 0), cA, voffA); PG8_STAGE(PG8_SA(0, 1), cA + hstep, voffA);
        if (wr == 1) PG8_BAR;
        PG8_WAIT_V(2); PG8_BAR;
        PG8_STAGE(PG8_SB(1, 0), cB + kstep, voffB); PG8_STAGE(PG8_SA(1, 0), cA + kstep, voffA); PG8_STAGE(PG8_SB(1, 1), cB + hstep + kstep, voffB);
        PG8_WAIT_V(6); PG8_BAR;
    } else {
        PG8_STAGE(PG8_SB(0, 0), cB, voffB); PG8_STAGE(PG8_SA(0, 0), cA, voffA); PG8_STAGE(PG8_SB(0, 1), cB + hstep, voffB); PG8_STAGE(PG8_SA(0, 1), cA + hstep, voffA);
        if (wr == 1) PG8_BAR;
        PG8_WAIT_V(4); PG8_BAR;
        PG8_STAGE(PG8_SB(1, 0), cB + kstep, voffB); PG8_STAGE(PG8_SA(1, 0), cA + kstep, voffA); PG8_STAGE(PG8_SB(1, 1), cB + hstep + kstep, voffB);
        PG8_WAIT_V(6); PG8_BAR;
    }
    for (;;) {
        const bool has_next = S.next(ui + 1, nxt);
        const char* nA = has_next ? (const char*)g.A + S.a_extra(nxt) + (size_t)nxt.pm * tstep : cA; const char* nB = has_next ? (const char*)g.Bt + S.b_extra(nxt) + (size_t)nxt.pn * tstep : cB;
        for (int t = 0; t < nt; t += 2) {
            const bool last = (t == nt - 2);
            const char* a1 = cA + (size_t)(t + 1) * kstep;
            const char* a2 = last ? nA : cA + (size_t)(t + 2) * kstep; const char* b2 = last ? nB : cB + (size_t)(t + 2) * kstep;
            const char* a3 = a2 + kstep; const char* b3 = b2 + kstep;
            if constexpr (SP2) {
            PG8_LDB(B0, 0, 0); PG8_LDB(B1, 0, 1); PG8_SCHED; PG8_LDA(At, 0, 0); PG8_STAGE(PG8_SA(1, 1), a1 + hstep, voffA);
            PG8_WAIT_V(8); PG8_WAIT_L(0); PG8_BAR; PG8_MMA(0, 0, At, B0); PG8_MMA(0, 1, At, B1); PG8_BAR; PG8_SCHED;
            PG8_LDA(At, 0, 1); PG8_STAGE(PG8_SB(0, 0), b2, voffB); PG8_STAGE(PG8_SB(0, 1), b2 + hstep, voffB); PG8_STAGE(PG8_SA(0, 0), a2, voffA);
            PG8_WAIT_V(8); PG8_WAIT_L(0); PG8_BAR; PG8_MMA(1, 0, At, B0); PG8_MMA(1, 1, At, B1); PG8_BAR; PG8_SCHED;
            PG8_LDB(B0, 1, 0); PG8_LDB(B1, 1, 1); PG8_SCHED; PG8_LDA(At, 1, 0); PG8_STAGE(PG8_SA(0, 1), a2 + hstep, voffA);
            PG8_WAIT_V(8); PG8_WAIT_L(0); PG8_BAR; PG8_MMA(0, 0, At, B0); PG8_MMA(0, 1, At, B1); PG8_BAR; PG8_SCHED;
            PG8_LDA(At, 1, 1); PG8_STAGE(PG8_SB(1, 0), b3, voffB); PG8_STAGE(PG8_SB(1, 1), b3 + hstep, voffB); PG8_STAGE(PG8_SA(1, 0), a3, voffA);
            PG8_WAIT_V(8); PG8_WAIT_L(0); PG8_BAR; PG8_MMA(1, 0, At, B0); PG8_MMA(1, 1, At, B1); PG8_BAR; PG8_SCHED;
            } else {
            PG8_LDB(B0, 0, 0); PG8_SCHED; PG8_LDA(At, 0, 0); PG8_STAGE(PG8_SA(1, 1), a1 + hstep, voffA);
            PG8_WAIT_L(8); PG8_BAR; PG8_WAIT_L(0); PG8_MMA(0, 0, At, B0); PG8_BAR; PG8_SCHED;
            PG8_LDB(B1, 0, 1); PG8_STAGE(PG8_SB(0, 0), b2, voffB);
            PG8_BAR; PG8_WAIT_L(0); PG8_MMA(0, 1, At, B1); PG8_BAR;
            PG8_LDA(At, 0, 1); PG8_STAGE(PG8_SA(0, 0), a2, voffA);
            PG8_BAR; PG8_WAIT_L(0); PG8_MMA(1, 0, At, B0); PG8_BAR; PG8_SCHED;
            PG8_STAGE(PG8_SB(0, 1), b2 + hstep, voffB);
            PG8_WAIT_V(6); PG8_BAR; PG8_MMA(1, 1, At, B1); PG8_BAR;
            PG8_LDB(B0, 1, 0); PG8_SCHED; PG8_LDA(At, 1, 0); PG8_STAGE(PG8_SA(0, 1), a2 + hstep, voffA);
            PG8_WAIT_L(8); PG8_BAR; PG8_WAIT_L(0); PG8_MMA(0, 0, At, B0); PG8_BAR; PG8_SCHED;
            PG8_LDB(B1, 1, 1); PG8_STAGE(PG8_SB(1, 0), b3, voffB);
            PG8_BAR; PG8_WAIT_L(0); PG8_MMA(0, 1, At, B1); PG8_BAR;
            PG8_LDA(At, 1, 1); PG8_STAGE(PG8_SA(1, 0), a3, voffA);
            PG8_BAR; PG8_WAIT_L(0); PG8_MMA(1, 0, At, B0); PG8_BAR; PG8_SCHED;
            PG8_STAGE(PG8_SB(1, 1), b3 + hstep, voffB);
            PG8_WAIT_V(6); PG8_BAR; PG8_MMA(1, 1, At, B1); PG8_BAR;
                    }
            if constexpr (GS) { if ((t & 7) == 6 && !last) { PG8_GS_SCALE(t >> 3, gpar); } }
        }
        if constexpr (ALIGN_EPI) { if (wr == 0) PG8_BAR; }
        if constexpr (GS) E.gs(acc, cur, wr, wc, fr, fq, (const PG8_LAS float*)(lds + STAGE_BYTES + gpar * 4096)); else E(acc, cur, wr, wc, fr, fq);
        if (!has_next) break;
#pragma unroll
        for (int a = 0; a < 2; ++a)
#pragma unroll
            for (int b = 0; b < 2; ++b)
#pragma unroll
                for (int m = 0; m < 4; ++m)
#pragma unroll
                    for (int n = 0; n < 2; ++n) acc[a][b][m][n] = (f32x4){0.f, 0.f, 0.f, 0.f};
        cur = nxt; cA = nA; cB = nB; ++ui;
        if constexpr (GS) { gpar ^= 1; PG8_GS_BUILD(cur, gpar); }
        if constexpr (ALIGN_EPI) { if (wr == 1) PG8_BAR; }
    }
    PG8_WAIT_V(0);
    if constexpr (!ALIGN_EPI) { if (wr == 0) PG8_BAR; }
    PG8_BAR;
#undef PG8_GS_BUILD
#undef PG8_GS_SCALE
#undef PG8_SA
#undef PG8_SB
#undef PG8_STAGE
#undef PG8_LDA
#undef PG8_LDB
#undef PG8_MMA
#undef PG8_WAIT_V
#undef PG8_WAIT_L
#undef PG8_BAR
#undef PG8_SCHED
}
}

template <class Epi>
__device__ __forceinline__ void run_gemm(unsigned char* shm, const bf16_t* A, const bf16_t* Bt, int M, int N, int K, const Epi& E) {
    pg8::StaticOrder S; S.init(M, N, (int)gridDim.x, (int)bid_fresh());
    pg8::Gemm g{A, Bt, M, N, K, K};
    pg8::gemm_phase<Epi, pg8::StaticOrder>((PG8_LAS unsigned char*)shm, g, S, E);
}

__device__ __forceinline__ void tconv_tile(const float* src, int N, int kb, int nb, bf16_t* dst, int ldd, float* tile, const float* kscale = nullptr) {
    const int tid = tid_fresh();
#pragma unroll
    for (int p = 0; p < 2; ++p) {
        const int r = (tid >> 4) + p * 32, c4 = tid & 15;
        f32x4 v = *(const f32x4*)(src + (size_t)(kb * 64 + r) * N + nb * 64 + c4 * 4);
        if (kscale) v = v * kscale[kb * 64 + r];
        float* t = tile + r * 65 + c4 * 4; t[0] = v[0]; t[1] = v[1]; t[2] = v[2]; t[3] = v[3];
    }
    __syncthreads();
    const int n = tid >> 3, k8 = tid & 7;
    const float* s = tile + (k8 * 8) * 65 + n;
    u32x4 o; o.x = pk2(s[0], s[65]); o.y = pk2(s[2 * 65], s[3 * 65]); o.z = pk2(s[4 * 65], s[5 * 65]); o.w = pk2(s[6 * 65], s[7 * 65]);
    *(u32x4*)(dst + (size_t)(nb * 64 + n) * ldd + kb * 64 + k8 * 8) = o;
    __syncthreads();
}

__device__ __forceinline__ void tconv_tile_w(const float* src, int N, int kb, int nb, bf16_t* dst, int ldd, float* tile, const float* kscale = nullptr) {
    const int tid = tid_fresh();
    f32x4 v[8];
#pragma unroll
    for (int p = 0; p < 8; ++p) { const int idx = tid + 512 * p, r = idx >> 6, c4 = idx & 63;
        v[p] = __builtin_nontemporal_load((const f32x4*)(src + (size_t)(kb * 64 + r) * N + nb * 256 + c4 * 4)); }
    if (kscale) {
#pragma unroll
        for (int p = 0; p < 8; ++p) v[p] = v[p] * kscale[kb * 64 + ((tid + 512 * p) >> 6)];
    }
#pragma unroll
    for (int p = 0; p < 8; ++p) { const int idx = tid + 512 * p, r = idx >> 6, c4 = idx & 63;
        float* t = tile + r * 257 + c4 * 4; t[0] = v[p][0]; t[1] = v[p][1]; t[2] = v[p][2]; t[3] = v[p][3]; }
    __syncthreads();
#pragma unroll
    for (int q = 0; q < 4; ++q) { const int id = tid + 512 * q, n = id >> 3, k8 = id & 7;
        const float* s = tile + (k8 * 8) * 257 + n;
        u32x4 o; o.x = pk2(s[0], s[257]); o.y = pk2(s[2 * 257], s[3 * 257]); o.z = pk2(s[4 * 257], s[5 * 257]); o.w = pk2(s[6 * 257], s[7 * 257]);
        *(u32x4*)(dst + (size_t)(nb * 256 + n) * ldd + kb * 64 + k8 * 8) = o; }
    __syncthreads();
}

__device__ __forceinline__ void rms_row_bf16(const float* x, const float* g, bf16_t* o, int lane) {
    f32x4 v[8]; float ss = 0.f;
#pragma unroll
    for (int j = 0; j < 8; ++j) { v[j] = ((const f32x4*)x)[lane + 64 * j]; ss += v[j][0] * v[j][0] + v[j][1] * v[j][1] + v[j][2] * v[j][2] + v[j][3] * v[j][3]; }
    ss = wave_sum(ss);
    const float rs = 1.0f / sqrtf(ss * (1.0f / D) + EPS);
#pragma unroll
    for (int j = 0; j < 8; ++j) { const f32x4 gg = ((const f32x4*)g)[lane + 64 * j];
        u32x2 w; w.x = pk2(v[j][0] * rs * gg[0], v[j][1] * rs * gg[1]); w.y = pk2(v[j][2] * rs * gg[2], v[j][3] * rs * gg[3]);
        ((u32x2*)o)[lane + 64 * j] = w; }
}
__device__ __forceinline__ void rms_row_f32(const float* x, const float* g, float* o, int lane) {
    f32x4 v[8]; float ss = 0.f;
#pragma unroll
    for (int j = 0; j < 8; ++j) { v[j] = ((const f32x4*)x)[lane + 64 * j]; ss += v[j][0] * v[j][0] + v[j][1] * v[j][1] + v[j][2] * v[j][2] + v[j][3] * v[j][3]; }
    ss = wave_sum(ss);
    const float rs = 1.0f / sqrtf(ss * (1.0f / D) + EPS);
#pragma unroll
    for (int j = 0; j < 8; ++j) { const f32x4 gg = ((const f32x4*)g)[lane + 64 * j]; ((f32x4*)o)[lane + 64 * j] = v[j] * rs * gg; }
}

__device__ __forceinline__ void phase_rms(const float* h, const float* g, bf16_t* xn, int nrows) {
    const int lane = tid_fresh() & 63, gw = bid_fresh() * 8 + (tid_fresh() >> 6), NGW = gridDim.x * 8;
    for (int r = gw; r < nrows; r += NGW) rms_row_bf16(h + (size_t)r * D, g, xn + (size_t)r * D, lane);
}

__device__ __forceinline__ void phase0(PP p, unsigned char* shm) {
    unsigned char* ws = p->ws;
    float* tile = (float*)shm;
    constexpr int C_IN = 32 * 14, C_OUT = 32 * 8, C_XQ = 32 * 2, C_XO = 8 * 8, C_UP = 32 * 32, C_DN = 128 * 8, C_GLU = 8 * 2, C_POOL = 16, C_PW = 8 * 2;
    constexpr int C_LAYER = C_IN + C_OUT + 3 * C_XQ + C_XO + C_UP + C_DN + C_GLU + C_POOL + C_PW;
    for (int it = bid_fresh(); it < DEPTH * C_LAYER; it += gridDim.x) {
        const int l = it / C_LAYER; int r = it % C_LAYER;
        if (r < C_IN) { tconv_tile_w(p->in[5] + (size_t)l * D * INW, INW, r / 14, r % 14, (bf16_t*)(ws + WS_WIN) + (size_t)l * INW * D, D, tile, p->in[4] + (size_t)l * D); continue; } r -= C_IN;
        if (r < C_OUT) { tconv_tile_w(p->in[23] + (size_t)l * D * D, D, r / 8, r % 8, (bf16_t*)(ws + WS_WOUT) + (size_t)l * D * D, D, tile, p->in[22] + (size_t)l * D); continue; } r -= C_OUT;
        if (r < C_XQ) { tconv_tile_w(p->in[25] + (size_t)l * D * 512, 512, r / 2, r % 2, (bf16_t*)(ws + WS_WXQ) + (size_t)l * 512 * D, D, tile, p->in[24] + (size_t)l * D); continue; } r -= C_XQ;
        if (r < C_XQ) { tconv_tile_w(p->in[26] + (size_t)l * D * 512, 512, r / 2, r % 2, (bf16_t*)(ws + WS_WKV) + (size_t)(l * 1024) * D, D, tile); continue; } r -= C_XQ;
        if (r < C_XQ) { tconv_tile_w(p->in[27] + (size_t)l * D * 512, 512, r / 2, r % 2, (bf16_t*)(ws + WS_WKV) + (size_t)(l * 1024 + 512) * D, D, tile); continue; } r -= C_XQ;
        if (r < C_XO) { tconv_tile_w(p->in[28] + (size_t)l * 512 * D, D, r / 8, r % 8, (bf16_t*)(ws + WS_WXO) + (size_t)l * D * 512, 512, tile); continue; } r -= C_XO;
        if (r < C_UP) { tconv_tile_w(p->in[30] + (size_t)l * D * DFF, DFF, r / 32, r % 32, (bf16_t*)(ws + WS_WUP) + (size_t)l * DFF * D, D, tile, p->in[29] + (size_t)l * D); continue; } r -= C_UP;
        if (r < C_DN) { tconv_tile_w(p->in[31] + (size_t)l * DFF * D, D, r / 8, r % 8, (bf16_t*)(ws + WS_WDN) + (size_t)l * D * DFF, DFF, tile); continue; } r -= C_DN;
        bf16_t* wsm = (bf16_t*)(ws + WS_WSM) + (size_t)l * 1536 * 512;
        if (r < C_GLU) { tconv_tile_w(p->in[14] + (size_t)l * 512 * 512, 512, r / 2, r % 2, wsm, 512, tile); continue; } r -= C_GLU;
        if (r < C_POOL) { const int gi = r >> 2, q = r & 3; tconv_tile(p->in[15] + (size_t)(l * 4 + gi) * 128 * 128, 128, q >> 1, q & 1, wsm + (size_t)(512 + gi * 128) * 512 + gi * 128, 512, tile); continue; } r -= C_POOL;
        tconv_tile_w(p->in[21] + (size_t)l * 512 * 512, 512, r / 2, r % 2, wsm + (size_t)1024 * 512, 512, tile);
    }
    {
        const int gt = bid_fresh() * 512 + tid_fresh(), NT = gridDim.x * 512;
        for (int i = gt; i < DEPTH * 512 * 64; i += NT) {
            const int l = i / (512 * 64), rr = (i / 64) % 512, ch = i % 64;
            if ((rr >> 7) != (ch >> 4)) { bf16_t* wsm = (bf16_t*)(ws + WS_WSM) + (size_t)l * 1536 * 512; *(u32x4*)(wsm + (size_t)(512 + rr) * 512 + ch * 8) = (u32x4){0u, 0u, 0u, 0u}; }
        }
    }
    phase_rms(p->in[1], p->in[3], (bf16_t*)(ws + WS_MEMN), 1024);
    {
        const int lane = tid_fresh() & 63, gw = bid_fresh() * 8 + (tid_fresh() >> 6), NGW = gridDim.x * 8;
        float* ssb = (float*)(ws + WS_SS);
        for (int r = gw; r < T; r += NGW) {
            const float* x = p->in[0] + (size_t)r * D; bf16_t* o = (bf16_t*)(ws + WS_XN) + (size_t)r * D; float sq = 0.f;
#pragma unroll
            for (int j = 0; j < 8; ++j) { const f32x4 v = ((const f32x4*)x)[lane + 64 * j]; sq += v[0] * v[0] + v[1] * v[1] + v[2] * v[2] + v[3] * v[3];
                u32x2 w; w.x = pk2(v[0], v[1]); w.y = pk2(v[2], v[3]); ((u32x2*)o)[lane + 64 * j] = w; }
            sq = wave_sum(sq);
            if (lane < 32) ssb[(size_t)r * 32 + lane] = (lane == 0) ? sq : 0.f;
        }
    }
}

constexpr int VS = 268;
template <int HD, bool DIL>
__device__ __forceinline__ void attn_compute(const bf16_t* Ks, const bf16_t* Vt, const bf16x8 (&qf)[HD / 32], int a, int quad, int fr,
                                             const float* biasT, int kmin, f32x4 (&oacc)[HD / 16], float& mx_out, float& den_out) {
    f32x4 s[16];
#pragma unroll
    for (int nt = 0; nt < 16; ++nt) {
        s[nt] = (f32x4){0.f, 0.f, 0.f, 0.f};
#pragma unroll
        for (int ks = 0; ks < HD / 32; ++ks) {
            const bf16x8 kf = *(const bf16x8*)(Ks + (16 * nt + fr) * (HD + 8) + quad * 8 + 32 * ks);
            s[nt] = __builtin_amdgcn_mfma_f32_16x16x32_bf16(kf, qf[ks], s[nt], 0, 0, 0);
        }
    }
    float mx = -3.0e38f;
    const float* tb = DIL ? (biasT + (127 - a + 4 * quad)) : nullptr;
#pragma unroll
    for (int nt = 0; nt < 16; ++nt)
#pragma unroll
        for (int j = 0; j < 4; ++j) {
            float v = s[nt][j];
            if (DIL) {
                v = v * 0.18033688011112042f + tb[16 * nt + j];
                if (nt < 8) v = kmin ? -1.0e30f : v;
            }
            s[nt][j] = v; mx = fmaxf(mx, v);
        }
    mx = fmaxf(mx, __shfl_xor(mx, 16)); mx = fmaxf(mx, __shfl_xor(mx, 32));
    float sum = 0.f;
#pragma unroll
    for (int nt = 0; nt < 16; ++nt)
#pragma unroll
        for (int j = 0; j < 4; ++j) { const float pv = __builtin_amdgcn_exp2f(s[nt][j] - mx); s[nt][j] = pv; sum += pv; }
    sum += __shfl_xor(sum, 16); sum += __shfl_xor(sum, 32);
#pragma unroll
    for (int dt = 0; dt < HD / 16; ++dt) oacc[dt] = (f32x4){0.f, 0.f, 0.f, 0.f};
#pragma unroll
    for (int k2 = 0; k2 < 8; ++k2) {
        u32x4 pp; pp.x = pk2(s[2 * k2][0], s[2 * k2][1]); pp.y = pk2(s[2 * k2][2], s[2 * k2][3]); pp.z = pk2(s[2 * k2 + 1][0], s[2 * k2 + 1][1]); pp.w = pk2(s[2 * k2 + 1][2], s[2 * k2 + 1][3]);
        const bf16x8 pf = __builtin_bit_cast(bf16x8, pp);
#pragma unroll
        for (int dt = 0; dt < HD / 16; ++dt) {
            const bf16_t* vp = Vt + (16 * dt + fr) * VS + 32 * k2 + quad * 4;
            const u32x2 lo = *(const u32x2*)vp, hi = *(const u32x2*)(vp + 16);
            u32x4 vv; vv.x = lo.x; vv.y = lo.y; vv.z = hi.x; vv.w = hi.y;
            oacc[dt] = __builtin_amdgcn_mfma_f32_16x16x32_bf16(__builtin_bit_cast(bf16x8, vv), pf, oacc[dt], 0, 0, 0);
        }
    }
    mx_out = mx; den_out = sum;
}

__device__ __forceinline__ void attn_band64(const bf16_t* Ks, const bf16_t* Vt, const bf16x8 (&qf)[2], int a, int w, int quad, int fr,
                                            const float* biasT, int kmin, f32x4 (&oacc)[4], float& mx_out, float& den_out) {
    f32x4 s[10];
#pragma unroll
    for (int i = 0; i < 10; ++i) {
        const int nt = (w + i) > 15 ? 15 : (w + i);
        s[i] = (f32x4){0.f, 0.f, 0.f, 0.f};
#pragma unroll
        for (int ks = 0; ks < 2; ++ks) {
            const bf16x8 kf = *(const bf16x8*)(Ks + (16 * nt + fr) * 72 + quad * 8 + 32 * ks);
            s[i] = __builtin_amdgcn_mfma_f32_16x16x32_bf16(kf, qf[ks], s[i], 0, 0, 0);
        }
    }
    float mx = -3.0e38f;
    const float* tb = biasT + (127 - a + 4 * quad + 16 * w);
#pragma unroll
    for (int i = 0; i < 10; ++i) {
        const bool dead = (kmin != 0) && ((w + i) < 8);
#pragma unroll
        for (int j = 0; j < 4; ++j) {
            float v = s[i][j] * 0.18033688011112042f + tb[16 * i + j];
            v = dead ? -1.0e30f : v;
            s[i][j] = v; mx = fmaxf(mx, v);
        }
    }
    mx = fmaxf(mx, __shfl_xor(mx, 16)); mx = fmaxf(mx, __shfl_xor(mx, 32));
    float sum = 0.f;
#pragma unroll
    for (int i = 0; i < 10; ++i)
#pragma unroll
        for (int j = 0; j < 4; ++j) { const float pv = __builtin_amdgcn_exp2f(s[i][j] - mx); s[i][j] = pv; sum += pv; }
    sum += __shfl_xor(sum, 16); sum += __shfl_xor(sum, 32);
#pragma unroll
    for (int dt = 0; dt < 4; ++dt) oacc[dt] = (f32x4){0.f, 0.f, 0.f, 0.f};
#pragma unroll
    for (int k2 = 0; k2 < 5; ++k2) {
        u32x4 pp; pp.x = pk2(s[2 * k2][0], s[2 * k2][1]); pp.y = pk2(s[2 * k2][2], s[2 * k2][3]); pp.z = pk2(s[2 * k2 + 1][0], s[2 * k2 + 1][1]); pp.w = pk2(s[2 * k2 + 1][2], s[2 * k2 + 1][3]);
        const bf16x8 pf = __builtin_bit_cast(bf16x8, pp);
        const int t0 = w + 2 * k2, t1 = (t0 + 1) > 15 ? 15 : (t0 + 1);
#pragma unroll
        for (int dt = 0; dt < 4; ++dt) {
            const bf16_t* vp = Vt + (16 * dt + fr) * VS + quad * 4;
            const u32x2 lo = *(const u32x2*)(vp + 16 * t0), hi = *(const u32x2*)(vp + 16 * t1);
            u32x4 vv; vv.x = lo.x; vv.y = lo.y; vv.z = hi.x; vv.w = hi.y;
            oacc[dt] = __builtin_amdgcn_mfma_f32_16x16x32_bf16(__builtin_bit_cast(bf16x8, vv), pf, oacc[dt], 0, 0, 0);
        }
    }
    mx_out = mx; den_out = sum;
}

__device__ __forceinline__ void vt_store_pair(bf16_t* Vt, int dim0, int bi, const u32x4 a, const u32x4 b) {
    unsigned* vd = (unsigned*)(Vt + dim0 * VS + bi);
    constexpr int RS = VS / 2;
    vd[0 * RS] = (a.x & 0xffffu) | (b.x << 16); vd[1 * RS] = (a.x >> 16) | (b.x & 0xffff0000u);
    vd[2 * RS] = (a.y & 0xffffu) | (b.y << 16); vd[3 * RS] = (a.y >> 16) | (b.y & 0xffff0000u);
    vd[4 * RS] = (a.z & 0xffffu) | (b.z << 16); vd[5 * RS] = (a.z >> 16) | (b.z & 0xffff0000u);
    vd[6 * RS] = (a.w & 0xffffu) | (b.w << 16); vd[7 * RS] = (a.w >> 16) | (b.w & 0xffff0000u);
}
__device__ __forceinline__ int t5_bucket(int n) {
    if (n < 16) return n;
    int b = 16;
    b += (n >= 22); b += (n >= 30); b += (n >= 40); b += (n >= 54); b += (n >= 73); b += (n >= 99); b += (n >= 134); b += (n >= 182);
    b += (n >= 246); b += (n >= 332); b += (n >= 450); b += (n >= 609); b += (n >= 825); b += (n >= 1117); b += (n >= 1513);
    return b;
}

constexpr int AT_KS = 0, AT_VT = 69632, AT_BIAS = 137216;
constexpr int DA_KS = 0, DA_VT = 36864, DA_BIAS = 36864 + 64 * VS * 2, DA_BUF = 73728;

struct DilUnit { int br, b, h, d, r, n; };
__device__ __forceinline__ DilUnit dil_decode(int u0) {
    const int u = (u0 & 7) * 192 + (u0 >> 3);
    DilUnit q; q.br = u / 512; const int rem = u % 512; q.b = rem / 128; q.h = (rem / 16) % 8; const int rn = rem % 16;
    q.d = (q.br == 0) ? 1 : (q.br == 1 ? 4 : 16); const int nbk = 16 / q.d; q.r = rn / nbk; q.n = rn % nbk; return q;
}
struct DilRegs { u32x4 kv[4], vv[4]; float bias; bf16x8 qf[2]; };
__device__ __forceinline__ void dil_issue(PP p, const DilUnit& q, DilRegs& R, int tid) {
    const bf16_t* proj = (const bf16_t*)(p->ws + WS_PROJ);
#pragma unroll
    for (int i = 0; i < 4; ++i) {
        const int bi = 2 * (tid >> 3) + (i & 1) + 128 * (i >> 1), ch = tid & 7, sp = 128 * (q.n - 1) + bi;
        R.kv[i] = (u32x4){0u, 0u, 0u, 0u}; R.vv[i] = R.kv[i];
        if (sp >= 0) { const size_t hp = ((size_t)((q.b * 8 + q.h) * SEQ + sp * q.d + q.r)) * 64 + ch * 8; R.kv[i] = *(const u32x4*)(proj + PJ_QKV + (size_t)1 * 4 * 8 * SEQ * 64 + hp); R.vv[i] = *(const u32x4*)(proj + PJ_QKV + (size_t)2 * 4 * 8 * SEQ * 64 + hp); }
    }
    { const int w = tid >> 6, lane = tid & 63, fr = lane & 15, quad = lane >> 4, a = 16 * w + fr;
      const size_t rowq = (size_t)(q.b * SEQ + (128 * q.n + a) * q.d + q.r);
      const bf16_t* qp = proj + PJ_QKV + ((size_t)((q.b * 8 + q.h) * SEQ) + (rowq - (size_t)q.b * SEQ)) * 64 + quad * 8;
      R.qf[0] = *(const bf16x8*)qp; R.qf[1] = *(const bf16x8*)(qp + 32); }
    R.bias = -1.0e30f;
    if (tid < 383) { const int sd = 255 - tid; if (sd >= 0 && sd <= 128) R.bias = p->in[2][t5_bucket(sd * q.d) * 8 + q.h] * 1.4426950408889634f; }
}
__device__ __forceinline__ void dil_stage(const DilRegs& R, unsigned char* buf, int tid) {
    bf16_t* Ks = (bf16_t*)(buf + DA_KS); bf16_t* Vt = (bf16_t*)(buf + DA_VT); float* biasT = (float*)(buf + DA_BIAS);
#pragma unroll
    for (int i = 0; i < 4; ++i) { const int bi = 2 * (tid >> 3) + (i & 1) + 128 * (i >> 1), ch = tid & 7; *(u32x4*)(Ks + bi * 72 + ch * 8) = R.kv[i]; }
#pragma unroll
    for (int i = 0; i < 4; i += 2) { const int bi = 2 * (tid >> 3) + 128 * (i >> 1), ch = tid & 7; vt_store_pair(Vt, ch * 8, bi, R.vv[i], R.vv[i + 1]); }
    if (tid < 383) biasT[tid] = R.bias;
}
__device__ __forceinline__ void dil_compute(PP p, const DilUnit& q, const unsigned char* buf, int tid, const bf16x8 (&qf)[2]) {
    const bf16_t* Ks = (const bf16_t*)(buf + DA_KS); const bf16_t* Vt = (const bf16_t*)(buf + DA_VT); const float* biasT = (const float*)(buf + DA_BIAS);
    const int w = tid >> 6, lane = tid & 63, fr = lane & 15, quad = lane >> 4;
    const int a = 16 * w + fr;
    const size_t rowq = (size_t)(q.b * SEQ + (128 * q.n + a) * q.d + q.r);
    f32x4 oacc[4]; float mx, den;
    attn_band64(Ks, Vt, qf, a, w, quad, fr, biasT, (q.n == 0) ? 128 : 0, oacc, mx, den);
    const float inv = 1.0f / den;
    bf16_t* ob = (bf16_t*)(p->ws + WS_OB) + ((size_t)q.br * T + rowq) * 512 + q.h * 64 + quad * 4;
#pragma unroll
    for (int dt = 0; dt < 4; ++dt) { u32x2 o; o.x = pk2(oacc[dt][0] * inv, oacc[dt][1] * inv); o.y = pk2(oacc[dt][2] * inv, oacc[dt][3] * inv); *(u32x2*)(ob + 16 * dt) = o; }
    if (quad == 0) ((float*)(p->ws + WS_LSE))[((size_t)q.br * T + rowq) * 8 + q.h] = mx * 0.6931471805599453f + __logf(den);
}
__device__ __forceinline__ void dil_attn_units(unsigned char* shm, int first, int stride) {
    const int tid = tid_fresh();
    if (first >= 1536) return;
    bf16x8 qcur[2];
    { PP p = get_pp(); DilRegs R; const DilUnit q = dil_decode(first); dil_issue(p, q, R, tid); dil_stage(R, shm, tid); qcur[0] = R.qf[0]; qcur[1] = R.qf[1]; }
    __syncthreads();
    int par = 0;
    for (int u = first; u < 1536; u += stride) {
        PP p = get_pp();
        const bool more = (u + stride) < 1536;
        DilRegs R; DilUnit qn = dil_decode(more ? u + stride : u);
        if (more) dil_issue(p, qn, R, tid);
        const DilUnit q = dil_decode(u);
        dil_compute(p, q, shm + par * DA_BUF, tid, qcur);
        if (more) { dil_stage(R, shm + (par ^ 1) * DA_BUF, tid); qcur[0] = R.qf[0]; qcur[1] = R.qf[1]; }
        __syncthreads();
        par ^= 1;
    }
}

__device__ __forceinline__ void cross_attn_unit(PP p, unsigned char* shm, int u, int l) {
    const bf16_t* kvb = (const bf16_t*)(p->ws + WS_KV);
    bf16_t* Ks = (bf16_t*)(shm + AT_KS); bf16_t* Vt = (bf16_t*)(shm + AT_VT);
    const int tid = tid_fresh(), w = tid >> 6, lane = tid & 63, fr = lane & 15, quad = lane >> 4;
    const int b = u / 64, xh = (u / 16) % 4, qt = u % 16;
    const size_t rowq = (size_t)(b * SEQ + qt * 128 + 16 * w + fr);
    float qs;
    { const float* sp = (const float*)(p->ws + WS_SS) + ((size_t)(1 + 3 * l) * T + rowq) * 32 + quad * 8;
      const f32x4 a0 = *(const f32x4*)sp, a1 = *(const f32x4*)(sp + 4);
      float t = ((a0[0] + a0[1]) + (a0[2] + a0[3])) + ((a1[0] + a1[1]) + (a1[2] + a1[3]));
      t += __shfl_xor(t, 16); t += __shfl_xor(t, 32);
      qs = (0.08838834764831845f * 1.4426950408889634f) / sqrtf(t * (1.0f / D) + EPS); }
    bf16x8 qf[4];
    const bf16_t* qp = (const bf16_t*)(p->ws + WS_QP) + rowq * 512 + xh * 128 + quad * 8;
#pragma unroll
    for (int ks = 0; ks < 4; ++ks) {
        float acc8[8], t8[8];
        unpack8(*(const u32x4*)(qp + 32 * ks), acc8);
#pragma unroll
        for (int sp = 1; sp < 4; ++sp) { unpack8(*(const u32x4*)(qp + (size_t)sp * T * 512 + 32 * ks), t8);
#pragma unroll
            for (int e = 0; e < 8; ++e) acc8[e] += t8[e]; }
        u32x4 pk; pk.x = pk2(acc8[0] * qs, acc8[1] * qs); pk.y = pk2(acc8[2] * qs, acc8[3] * qs); pk.z = pk2(acc8[4] * qs, acc8[5] * qs); pk.w = pk2(acc8[6] * qs, acc8[7] * qs);
        qf[ks] = __builtin_bit_cast(bf16x8, pk);
    }
    {
        u32x4 kq[8], vq[8];
#pragma unroll
        for (int i = 0; i < 8; ++i) { const int m = 2 * (tid >> 4) + (i & 1) + 64 * (i >> 1), ch = tid & 15;
            const bf16_t* rowp = kvb + (size_t)(b * 256 + m) * 4096 + l * 1024 + xh * 128 + ch * 8; kq[i] = *(const u32x4*)rowp; vq[i] = *(const u32x4*)(rowp + 512); }
#pragma unroll
        for (int i = 0; i < 8; ++i) { const int m = 2 * (tid >> 4) + (i & 1) + 64 * (i >> 1), ch = tid & 15; *(u32x4*)(Ks + m * 136 + ch * 8) = kq[i]; }
#pragma unroll
        for (int i = 0; i < 8; i += 2) { const int m = 2 * (tid >> 4) + 64 * (i >> 1), ch = tid & 15; vt_store_pair(Vt, ch * 8, m, vq[i], vq[i + 1]); }
    }
    __syncthreads();
    f32x4 oacc[8]; float mx, den;
    attn_compute<128, false>(Ks, Vt, qf, 0, quad, fr, nullptr, 0, oacc, mx, den);
    const float inv = 1.0f / den;
    bf16_t* ox = (bf16_t*)(p->ws + WS_OX) + rowq * 512 + xh * 128 + quad * 4;
#pragma unroll
    for (int dt = 0; dt < 8; ++dt) { u32x2 o; o.x = pk2(oacc[dt][0] * inv, oacc[dt][1] * inv); o.y = pk2(oacc[dt][2] * inv, oacc[dt][3] * inv); *(u32x2*)(ox + 16 * dt) = o; }
    __syncthreads();
}

typedef float f32x2 __attribute__((ext_vector_type(2)));
struct S5Lane { float ar, ai; f32x2 bb[16]; };
__device__ __forceinline__ void s5_lane_params(PP p, int l, int g, int n, S5Lane& q) {
    const int gi = (l * 32 + g) * 64 + n;
    const float lr = p->in[6][gi], li = p->in[7][gi], dt = expf(p->in[8][l * 32 + g]);
    const float mag = expf(lr * dt);
    float sn, cs; sincosf(li * dt, &sn, &cs);
    q.ar = mag * cs; q.ai = mag * sn;
    const float den = lr * lr + li * li, nr = q.ar - 1.0f, ni = q.ai;
    const float fr_ = (nr * lr + ni * li) / den, fi_ = (ni * lr - nr * li) / den;
    const f32x4* bre = (const f32x4*)(p->in[9] + (size_t)gi * 16); const f32x4* bim = (const f32x4*)(p->in[10] + (size_t)gi * 16);
#pragma unroll
    for (int c4 = 0; c4 < 4; ++c4) { const f32x4 br = bre[c4], bi = bim[c4];
#pragma unroll
        for (int e = 0; e < 4; ++e) { q.bb[c4 * 4 + e] = (f32x2){fr_ * br[e] - fi_ * bi[e], fr_ * bi[e] + fi_ * br[e]}; } }
}
__device__ __forceinline__ void s5_load_u(const bf16_t* proj, int b, int l0, int g, float* ub, int lane) {
    const bf16_t* src = proj + PJ_UA + (size_t)(b * SEQ + l0 + lane) * 512 + g * 16;
    const u32x4 a = *(const u32x4*)src, c = *(const u32x4*)(src + 8);
    f32x4* d = (f32x4*)(ub + lane * 16);
    d[0] = (f32x4){__uint_as_float(a.x << 16), __uint_as_float(a.x & 0xffff0000u), __uint_as_float(a.y << 16), __uint_as_float(a.y & 0xffff0000u)};
    d[1] = (f32x4){__uint_as_float(a.z << 16), __uint_as_float(a.z & 0xffff0000u), __uint_as_float(a.w << 16), __uint_as_float(a.w & 0xffff0000u)};
    d[2] = (f32x4){__uint_as_float(c.x << 16), __uint_as_float(c.x & 0xffff0000u), __uint_as_float(c.y << 16), __uint_as_float(c.y & 0xffff0000u)};
    d[3] = (f32x4){__uint_as_float(c.z << 16), __uint_as_float(c.z & 0xffff0000u), __uint_as_float(c.w << 16), __uint_as_float(c.w & 0xffff0000u)};
}
__device__ __forceinline__ void s5_step(const S5Lane& q, const float* urow, f32x2& x) {
    const f32x4* u4 = (const f32x4*)urow;
    f32x2 b0 = (f32x2){0.f, 0.f}, b1 = b0;
#pragma unroll
    for (int c4 = 0; c4 < 4; ++c4) { const f32x4 uv = u4[c4];
        b0 += q.bb[c4 * 4 + 0] * uv[0]; b1 += q.bb[c4 * 4 + 1] * uv[1]; b0 += q.bb[c4 * 4 + 2] * uv[2]; b1 += q.bb[c4 * 4 + 3] * uv[3]; }
    const f32x2 rot = (f32x2){-x.y, x.x};
    x = (x * q.ar + rot * q.ai) + (b0 + b1);
}
constexpr int S5_BBL = 0, S5_BUL = 4096, S5_XS = 4096 + 65536;
struct S5Frag { bf16x8 bfr[8]; };
__device__ __forceinline__ void s5_write_bbl(const S5Lane& q, bf16_t* bbL, int lane) {
    u32x4 re0, re1, im0, im1;
    re0.x = pk2(q.bb[0].x, q.bb[1].x); re0.y = pk2(q.bb[2].x, q.bb[3].x); re0.z = pk2(q.bb[4].x, q.bb[5].x); re0.w = pk2(q.bb[6].x, q.bb[7].x);
    re1.x = pk2(q.bb[8].x, q.bb[9].x); re1.y = pk2(q.bb[10].x, q.bb[11].x); re1.z = pk2(q.bb[12].x, q.bb[13].x); re1.w = pk2(q.bb[14].x, q.bb[15].x);
    im0.x = pk2(q.bb[0].y, q.bb[1].y); im0.y = pk2(q.bb[2].y, q.bb[3].y); im0.z = pk2(q.bb[4].y, q.bb[5].y); im0.w = pk2(q.bb[6].y, q.bb[7].y);
    im1.x = pk2(q.bb[8].y, q.bb[9].y); im1.y = pk2(q.bb[10].y, q.bb[11].y); im1.z = pk2(q.bb[12].y, q.bb[13].y); im1.w = pk2(q.bb[14].y, q.bb[15].y);
    *(u32x4*)(bbL + lane * 16) = re0; *(u32x4*)(bbL + lane * 16 + 8) = re1;
    *(u32x4*)(bbL + (64 + lane) * 16) = im0; *(u32x4*)(bbL + (64 + lane) * 16 + 8) = im1;
}
__device__ __forceinline__ void s5_load_frags(const bf16_t* bbL, S5Frag& f, int lane) {
    const int jj = lane & 15, quad = lane >> 4;
#pragma unroll
    for (int nt = 0; nt < 8; ++nt) { u32x4 v = (u32x4){0u, 0u, 0u, 0u}; if (quad < 2) v = *(const u32x4*)(bbL + (16 * nt + jj) * 16 + quad * 8); f.bfr[nt] = __builtin_bit_cast(bf16x8, v); }
}
__device__ __forceinline__ bf16x8 s5_ufrag(const bf16_t* proj, size_t row, int g, int lane) {
    const int tt = lane & 15, quad = lane >> 4;
    u32x4 v = (u32x4){0u, 0u, 0u, 0u};
    if (quad < 2) v = *(const u32x4*)(proj + PJ_UA + (row + tt) * 512 + g * 16 + quad * 8);
    return __builtin_bit_cast(bf16x8, v);
}
__device__ __forceinline__ void s5_bu16(const S5Frag& f, const bf16x8 uf, float* buL, int lane) {
    const int jj = lane & 15, quad = lane >> 4;
#pragma unroll
    for (int nt = 0; nt < 4; ++nt) {
        const f32x4 z = (f32x4){0.f, 0.f, 0.f, 0.f};
        const f32x4 dre = __builtin_amdgcn_mfma_f32_16x16x32_bf16(uf, f.bfr[nt], z, 0, 0, 0);
        const f32x4 dim = __builtin_amdgcn_mfma_f32_16x16x32_bf16(uf, f.bfr[nt + 4], z, 0, 0, 0);
#pragma unroll
        for (int r = 0; r < 4; ++r) *(f32x2*)(buL + ((4 * quad + r) * 64 + 16 * nt + jj) * 2) = (f32x2){dre[r], dim[r]};
    }
}
__device__ __forceinline__ void s5_rec(const S5Lane& q, f32x2 bu, f32x2& x) { const f32x2 rot = (f32x2){-x.y, x.x}; x = (x * q.ar + rot * q.ai) + bu; }

__device__ __forceinline__ void s5_pass1_item(PP p, unsigned char* shm, int item, int l) {
    const int tid = tid_fresh(), w = tid >> 6, lane = tid & 63;
    const int b = item / 128, g = (item / 4) % 32, jg = item % 4, j = jg * 8 + w;
    const bf16_t* proj = (const bf16_t*)(p->ws + WS_PROJ);
    bf16_t* bbL = (bf16_t*)(shm + S5_BBL); float* buL = (float*)(shm + S5_BUL) + w * 2048;
    S5Lane q; s5_lane_params(p, l, g, lane, q);
    const size_t row0 = (size_t)b * SEQ + j * 64;
    bf16x8 uf[4];
#pragma unroll
    for (int sc = 0; sc < 4; ++sc) uf[sc] = s5_ufrag(proj, row0 + sc * 16, g, lane);
    s5_write_bbl(q, bbL, lane);
    __syncthreads();
    S5Frag f; s5_load_frags(bbL, f, lane);
    f32x2 x = (f32x2){0.f, 0.f};
#pragma unroll
    for (int sc = 0; sc < 4; ++sc) {
        s5_bu16(f, uf[sc], buL, lane);
        __syncthreads();
#pragma unroll
        for (int t = 0; t < 16; ++t) s5_rec(q, *(const f32x2*)(buL + (t * 64 + lane) * 2), x);
        __syncthreads();
    }
    *(f32x2*)((float*)(p->ws + WS_CARRY) + ((size_t)((b * 32 + g) * 32 + j) * 64 + lane) * 2) = x;
}
__device__ __forceinline__ void s5_pass2_item(PP p, unsigned char* shm, int item, int l) {
    const int tid = tid_fresh(), w = tid >> 6, lane = tid & 63;
    const int b = item / 128, g = (item / 4) % 32, jg = item % 4, j = jg * 8 + w;
    const bf16_t* proj = (const bf16_t*)(p->ws + WS_PROJ);
    bf16_t* bbL = (bf16_t*)(shm + S5_BBL); float* buL = (float*)(shm + S5_BUL) + w * 2048; float* xs = (float*)(shm + S5_XS) + w * (16 * 132);
    const int cc = lane & 15, quad = lane >> 4;
    float cmr[32];
    { const float* src = ((quad < 2) ? p->in[11] : p->in[12]) + ((size_t)(l * 32 + g) * 16 + cc) * 64 + (quad & 1) * 32;
      const float sgn = (quad < 2) ? 1.0f : -1.0f;
#pragma unroll
      for (int i = 0; i < 8; ++i) { const f32x4 v = *(const f32x4*)(src + 4 * i); cmr[4 * i] = v[0] * sgn; cmr[4 * i + 1] = v[1] * sgn; cmr[4 * i + 2] = v[2] * sgn; cmr[4 * i + 3] = v[3] * sgn; } }
    S5Lane q; s5_lane_params(p, l, g, lane, q);
    const size_t row0 = (size_t)b * SEQ + j * 64;
    bf16x8 uf[4];
#pragma unroll
    for (int sc = 0; sc < 4; ++sc) uf[sc] = s5_ufrag(proj, row0 + sc * 16, g, lane);
    s5_write_bbl(q, bbL, lane);
    float pr = q.ar, pi = q.ai;
#pragma unroll
    for (int s = 0; s < 6; ++s) { const float nr = pr * pr - pi * pi, ni = 2.f * pr * pi; pr = nr; pi = ni; }
    f32x2 x = (f32x2){0.f, 0.f};
    const f32x2* carry = (const f32x2*)((const float*)(p->ws + WS_CARRY) + ((size_t)((b * 32 + g) * 32) * 64 + lane) * 2);
    for (int i0 = 0; i0 < j; i0 += 8) {
        f32x2 sv[8];
#pragma unroll
        for (int e = 0; e < 8; ++e) sv[e] = (i0 + e < j) ? carry[(size_t)(i0 + e) * 64] : (f32x2){0.f, 0.f};
#pragma unroll
        for (int e = 0; e < 8; ++e) if (i0 + e < j) { const f32x2 rot = (f32x2){-x.y, x.x}; x = (x * pr + rot * pi) + sv[e]; }
    }
    __syncthreads();
    S5Frag f; s5_load_frags(bbL, f, lane);
    const float dsk = p->in[13][(size_t)l * 512 + g * 16 + cc];
    bf16_t* Gout = (bf16_t*)(p->ws + WS_GPH);
    for (int sc = 0; sc < 4; ++sc) {
        s5_bu16(f, uf[sc], buL, lane);
        __syncthreads();
#pragma unroll
        for (int t = 0; t < 16; ++t) { s5_rec(q, *(const f32x2*)(buL + (t * 64 + lane) * 2), x); xs[t * 132 + lane] = x.x; xs[t * 132 + 64 + lane] = x.y; }
        __syncthreads();
        f32x4 y0 = (f32x4){0.f, 0.f, 0.f, 0.f}, y1 = y0;
        const f32x4* xrow = (const f32x4*)(xs + cc * 132 + quad * 32);
#pragma unroll
        for (int i = 0; i < 8; ++i) { const f32x4 xv = xrow[i];
            y0 = __builtin_amdgcn_mfma_f32_16x16x4f32(xv[0], cmr[4 * i + 0], y0, 0, 0, 0);
            y1 = __builtin_amdgcn_mfma_f32_16x16x4f32(xv[1], cmr[4 * i + 1], y1, 0, 0, 0);
            y0 = __builtin_amdgcn_mfma_f32_16x16x4f32(xv[2], cmr[4 * i + 2], y0, 0, 0, 0);
            y1 = __builtin_amdgcn_mfma_f32_16x16x4f32(xv[3], cmr[4 * i + 3], y1, 0, 0, 0); }
        const f32x4 y = y0 + y1;
#pragma unroll
        for (int r = 0; r < 4; ++r) { const int tl = sc * 16 + quad * 4 + r;
            const float v = y[r] + dsk * bf2f(proj[PJ_UA + (row0 + tl) * 512 + g * 16 + cc]);
            const float z = 0.7978845608028654f * (v + 0.044715f * v * v * v);
            const float th = 1.0f - 2.0f / (__expf(2.0f * z) + 1.0f);
            Gout[(row0 + tl) * 512 + g * 16 + cc] = f2bf(0.5f * v * (1.0f + th)); }
        __syncthreads();
    }
}

__device__ __forceinline__ void pool_item(PP p, unsigned char* shm, int item) {
    const bf16_t* proj = (const bf16_t*)(p->ws + WS_PROJ);
    bf16_t* P = (bf16_t*)(p->ws + WS_GPH) + (size_t)T * 512;
    float* ut = (float*)shm;
    const int tid = tid_fresh(), ch = tid, gi = ch >> 7, w = 2 << gi;
    const int row0 = item * 32, b = row0 / SEQ, l0 = row0 % SEQ;
#pragma unroll
    for (int i = 0; i < 6; ++i) {
        const int ci = tid + i * 512, rr = ci >> 6, c8 = ci & 63, ll = l0 - 16 + rr;
        u32x4 v = (u32x4){0u, 0u, 0u, 0u};
        if (ll >= 0) v = *(const u32x4*)(proj + PJ_UB + (size_t)(b * SEQ + ll) * 512 + c8 * 8);
        f32x4* d = (f32x4*)(ut + rr * 512 + c8 * 8);
        d[0] = (f32x4){__uint_as_float(v.x << 16), __uint_as_float(v.x & 0xffff0000u), __uint_as_float(v.y << 16), __uint_as_float(v.y & 0xffff0000u)};
        d[1] = (f32x4){__uint_as_float(v.z << 16), __uint_as_float(v.z & 0xffff0000u), __uint_as_float(v.w << 16), __uint_as_float(v.w & 0xffff0000u)};
    }
    __syncthreads();
    float sum = 0.f;
    for (int s = 1; s <= w; ++s) sum += ut[(16 - s) * 512 + ch];
    for (int t = 0; t < 32; ++t) {
        const int l = l0 + t;
        const float cur = ut[(16 + t) * 512 + ch];
        sum += cur - ut[(16 + t - w) * 512 + ch];
        const int cnt = (l + 1 < w) ? (l + 1) : w;
        P[(size_t)(row0 + t) * 512 + ch] = f2bf(sum / (float)cnt - cur);
    }
    __syncthreads();
}
constexpr int CV_HG = 0, CV_CV = 46 * 512 * 4;
__device__ __forceinline__ void conv_item(PP p, unsigned char* shm, int item, int l) {
    const bf16_t* proj = (const bf16_t*)(p->ws + WS_PROJ);
    bf16_t* HC = (bf16_t*)(p->ws + WS_GPH) + (size_t)2 * T * 512;
    float* hg = (float*)(shm + CV_HG); float* cv = (float*)(shm + CV_CV);
    const int tid = tid_fresh(), c = tid, row0 = item * 16, b = row0 / SEQ, l0 = row0 % SEQ;
#pragma unroll
    for (int i = 0; i < 6; ++i) {
        const int ci = tid + i * 512, rr = ci >> 6, c8 = ci & 63, ll = l0 - 30 + rr;
        if (rr < 46) {
            u32x4 v = (u32x4){0u, 0u, 0u, 0u}, gt = v;
            if (ll >= 0) { const bf16_t* rp = proj + PJ_UC + (size_t)(b * SEQ + ll) * 1024 + c8 * 8; v = *(const u32x4*)rp; gt = *(const u32x4*)(rp + 512); }
            float vf[8], gf[8];
            vf[0] = __uint_as_float(v.x << 16); vf[1] = __uint_as_float(v.x & 0xffff0000u); vf[2] = __uint_as_float(v.y << 16); vf[3] = __uint_as_float(v.y & 0xffff0000u);
            vf[4] = __uint_as_float(v.z << 16); vf[5] = __uint_as_float(v.z & 0xffff0000u); vf[6] = __uint_as_float(v.w << 16); vf[7] = __uint_as_float(v.w & 0xffff0000u);
            gf[0] = __uint_as_float(gt.x << 16); gf[1] = __uint_as_float(gt.x & 0xffff0000u); gf[2] = __uint_as_float(gt.y << 16); gf[3] = __uint_as_float(gt.y & 0xffff0000u);
            gf[4] = __uint_as_float(gt.z << 16); gf[5] = __uint_as_float(gt.z & 0xffff0000u); gf[6] = __uint_as_float(gt.w << 16); gf[7] = __uint_as_float(gt.w & 0xffff0000u);
            f32x4* d = (f32x4*)(hg + rr * 512 + c8 * 8);
            d[0] = (f32x4){vf[0] * sigmoidf_(gf[0]), vf[1] * sigmoidf_(gf[1]), vf[2] * sigmoidf_(gf[2]), vf[3] * sigmoidf_(gf[3])};
            d[1] = (f32x4){vf[4] * sigmoidf_(gf[4]), vf[5] * sigmoidf_(gf[5]), vf[6] * sigmoidf_(gf[6]), vf[7] * sigmoidf_(gf[7])};
        }
    }
    float wdw[31];
#pragma unroll
    for (int j = 0; j < 31; ++j) wdw[j] = p->in[17][((size_t)l * 31 + j) * 512 + c];
    const float bias = p->in[18][(size_t)l * 512 + c];
    __syncthreads();
    for (int t = 0; t < 16; ++t) {
        float acc = bias, acc2 = 0.f;
#pragma unroll
        for (int j = 0; j < 30; j += 2) { acc += wdw[j] * hg[(t + j) * 512 + c]; acc2 += wdw[j + 1] * hg[(t + j + 1) * 512 + c]; }
        acc += wdw[30] * hg[(t + 30) * 512 + c];
        cv[t * 512 + c] = acc + acc2;
    }
    __syncthreads();
    const int w = c >> 6, lane = c & 63;
    for (int tk = 0; tk < 2; ++tk) {
        const int t = w * 2 + tk;
        const f32x4 v0 = *(const f32x4*)(cv + t * 512 + lane * 8), v1 = *(const f32x4*)(cv + t * 512 + lane * 8 + 4);
        float s = v0[0] + v0[1] + v0[2] + v0[3] + v1[0] + v1[1] + v1[2] + v1[3];
        const float mean = wave_sum(s) * (1.0f / 512.0f);
        const f32x4 d0 = v0 - mean, d1 = v1 - mean;
        float s2 = d0[0] * d0[0] + d0[1] * d0[1] + d0[2] * d0[2] + d0[3] * d0[3] + d1[0] * d1[0] + d1[1] * d1[1] + d1[2] * d1[2] + d1[3] * d1[3];
        const float rstd = 1.0f / sqrtf(wave_sum(s2) * (1.0f / 512.0f) + EPS);
        const f32x4 g0 = *(const f32x4*)(p->in[19] + (size_t)l * 512 + lane * 8), g1 = *(const f32x4*)(p->in[19] + (size_t)l * 512 + lane * 8 + 4);
        const f32x4 b0 = *(const f32x4*)(p->in[20] + (size_t)l * 512 + lane * 8), b1 = *(const f32x4*)(p->in[20] + (size_t)l * 512 + lane * 8 + 4);
        float o[8];
#pragma unroll
        for (int e = 0; e < 4; ++e) { const float y0 = d0[e] * rstd * g0[e] + b0[e], y1 = d1[e] * rstd * g1[e] + b1[e]; o[e] = y0 * sigmoidf_(y0); o[4 + e] = y1 * sigmoidf_(y1); }
        u32x4 ov; ov.x = pk2(o[0], o[1]); ov.y = pk2(o[2], o[3]); ov.z = pk2(o[4], o[5]); ov.w = pk2(o[6], o[7]);
        *(u32x4*)(HC + (size_t)(row0 + t) * 512 + lane * 8) = ov;
    }
    __syncthreads();
}

struct CbTok { u32x4 ob[3]; float ls[3]; };
__device__ __forceinline__ void cb_load(CbTok& k, const bf16_t* ob, const float* lse, int t, int lane) {
#pragma unroll
    for (int g = 0; g < 3; ++g) { k.ob[g] = *(const u32x4*)(ob + ((size_t)g * T + t) * 512 + lane * 8); k.ls[g] = lse[((size_t)g * T + t) * 8 + (lane >> 3)]; }
}
__device__ __forceinline__ void phase_combine(PP p) {
    const int lane = tid_fresh() & 63, gw = bid_fresh() * 8 + (tid_fresh() >> 6), NGW = gridDim.x * 8;
    const bf16_t* ob = (const bf16_t*)(p->ws + WS_OB); const float* lse = (const float*)(p->ws + WS_LSE);
    bf16_t* y = (bf16_t*)(p->ws + WS_YN); float* ssg = (float*)(p->ws + WS_SSG);
    CbTok cur, nxt;
    if (gw < T) cb_load(cur, ob, lse, gw, lane);
    for (int t = gw; t < T; t += NGW) {
        const bool more = (t + NGW) < T;
        if (more) cb_load(nxt, ob, lse, t + NGW, lane);
        const float lm = fmaxf(cur.ls[0], fmaxf(cur.ls[1], cur.ls[2]));
        const float e0 = __expf(cur.ls[0] - lm), e1 = __expf(cur.ls[1] - lm), e2 = __expf(cur.ls[2] - lm), ei = 1.0f / (e0 + e1 + e2);
        float o0[8], o1[8], o2[8], v[8];
        unpack8(cur.ob[0], o0); unpack8(cur.ob[1], o1); unpack8(cur.ob[2], o2);
        float sq = 0.f;
#pragma unroll
        for (int e = 0; e < 8; ++e) { v[e] = (e0 * o0[e] + e1 * o1[e] + e2 * o2[e]) * ei; sq += v[e] * v[e]; }
        sq = wave_sum(sq);
        u32x4 ov; ov.x = pk2(v[0], v[1]); ov.y = pk2(v[2], v[3]); ov.z = pk2(v[4], v[5]); ov.w = pk2(v[6], v[7]);
        *(u32x4*)(y + (size_t)t * D + 1536 + lane * 8) = ov;
        if (lane < 8) ssg[(size_t)t * 32 + 24 + lane] = (lane == 0) ? sq : 0.f;
        if (more) cur = nxt;
    }
}

__global__ void __launch_bounds__(512, 2) hymba_fwd(Params p_unused) {
    extern __shared__ __attribute__((aligned(16))) unsigned char shm[];
    cg::grid_group grid = cg::this_grid();
    volatile LAS unsigned* xst = (volatile LAS unsigned*)(LAS unsigned char*)(shm + LDS_BYTES - 16);
    if (threadIdx.x == 0) { xst[0] = 0u; xst[1] = 0u; }
    __syncthreads();
    XcdBarrier xbar;
    { PP p = get_pp(); unsigned* barw = (unsigned*)(p->ws + WS_BAR); xbar = xcd_barrier_post(barw, xst);
      if (p->ws == nullptr) grid.sync(); }

    for (int rep = 0; rep < P0_REPS; ++rep) phase0(get_pp(), shm);
    GSYNC();

    for (int l = 0; l < N_LAYERS_RUN; ++l) {
        if (l == 0) { PP p = get_pp(); unsigned char* ws = p->ws;
          pg8::WinKvOrder S; S.so.init(T, INW, (int)gridDim.x, (int)bid_fresh()); S.a_delta = WS_MEMN - WS_XN; S.b_delta = WS_WKV - WS_WIN;
          pg8::Gemm g{(const bf16_t*)(ws + WS_XN), (const bf16_t*)(ws + WS_WIN), T, INW, D, D};
          pg8::EpiWinKv E{{(bf16_t*)(ws + WS_PROJ), (const float*)(ws + WS_SS)}, {(bf16_t*)(ws + WS_KV), 4096, 1.0f, nullptr}};
          pg8::gemm_phase<pg8::EpiWinKv, pg8::WinKvOrder>((PG8_LAS unsigned char*)shm, g, S, E); }
        else { PP p = get_pp(); unsigned char* ws = p->ws;
          pg8::EpiWin E{(bf16_t*)(ws + WS_PROJ), (const float*)(ws + WS_SS) + (size_t)(3 * l) * T * 32};
          run_gemm(shm, (const bf16_t*)(ws + WS_XN), (const bf16_t*)(ws + WS_WIN) + (size_t)l * INW * D, T, INW, D, E); }
        GSYNC();
        for (int rep = 0; rep < MIX_REPS; ++rep) {
            dil_attn_units(shm, bid_fresh(), (int)gridDim.x);
            int it0 = bid_fresh(); while (it0 < 1536) it0 += gridDim.x;
            for (int it = it0; it < 1536 + 512 + 256 + 512; it += gridDim.x) {
                PP p = get_pp();
                if (it < 2048) s5_pass1_item(p, shm, it - 1536, l);
                else if (it < 2304) pool_item(p, shm, it - 2048);
                else conv_item(p, shm, it - 2304, l);
            }
        }
        GSYNC();
        for (int rep = 0; rep < P3_REPS; ++rep) for (int it = bid_fresh(); it < 512; it += gridDim.x) s5_pass2_item(get_pp(), shm, it, l);
        for (int rep = 0; rep < NORM_REPS; ++rep) phase_combine(get_pp());
        GSYNC();
        { PP p = get_pp(); unsigned char* ws = p->ws;
          pg8::SmallOrder S{(int)gridDim.x, (int)bid_fresh()};
          pg8::Gemm g{(const bf16_t*)(ws + WS_GPH), (const bf16_t*)(ws + WS_WSM) + (size_t)l * 1536 * 512, T, 1536, 512, 512};
          pg8::EpiSmall E{(bf16_t*)(ws + WS_YN), (const bf16_t*)(ws + WS_GPH), p->in[16] + (size_t)l * 512, (float*)(ws + WS_SSG)};
          pg8::gemm_phase<pg8::EpiSmall, pg8::SmallOrder>((PG8_LAS unsigned char*)shm, g, S, E); }
        GSYNC();
        { PP p = get_pp(); unsigned char* ws = p->ws;
          pg8::StaticOrder S; S.init(T, D, (int)gridDim.x, (int)bid_fresh());
          pg8::Gemm g{(const bf16_t*)(ws + WS_YN), (const bf16_t*)(ws + WS_WOUT) + (size_t)l * D * D, T, D, D, D};
          if (l == 0) { pg8::EpiRes2<2, true> E{p->in[0], (bf16_t*)(ws + WS_XN), (unsigned char*)(ws + WS_H), (float*)(ws + WS_SS) + (size_t)(1 + 3 * l) * T * 32, nullptr};
            pg8::gemm_phase<pg8::EpiRes2<2, true>, pg8::StaticOrder, true, true, true>((PG8_LAS unsigned char*)shm, g, S, E, (const float*)(ws + WS_SSG)); }
          else { pg8::EpiRes2<2, false> E{nullptr, (bf16_t*)(ws + WS_XN), (unsigned char*)(ws + WS_H), (float*)(ws + WS_SS) + (size_t)(1 + 3 * l) * T * 32, nullptr};
            pg8::gemm_phase<pg8::EpiRes2<2, false>, pg8::StaticOrder, true, true, true>((PG8_LAS unsigned char*)shm, g, S, E, (const float*)(ws + WS_SSG)); } }
        GSYNC();
        { PP p = get_pp(); unsigned char* ws = p->ws;
          pg8::SplitOrder S{(int)gridDim.x, (int)bid_fresh()};
          pg8::Gemm g{(const bf16_t*)(ws + WS_XN), (const bf16_t*)(ws + WS_WXQ) + (size_t)l * 512 * D, T, 512, D, 512};
          pg8::EpiPart E{(bf16_t*)(ws + WS_QP)};
          pg8::gemm_phase<pg8::EpiPart, pg8::SplitOrder>((PG8_LAS unsigned char*)shm, g, S, E); }
        GSYNC();
        for (int rep = 0; rep < P9_REPS; ++rep) for (int it = bid_fresh(); it < 256; it += gridDim.x) cross_attn_unit(get_pp(), shm, it, l);
        GSYNC();
        { PP p = get_pp(); unsigned char* ws = p->ws;
          pg8::EpiRes2<2, false> E{nullptr, (bf16_t*)(ws + WS_XN), (unsigned char*)(ws + WS_H), (float*)(ws + WS_SS) + (size_t)(2 + 3 * l) * T * 32, nullptr};
          run_gemm(shm, (const bf16_t*)(ws + WS_OX), (const bf16_t*)(ws + WS_WXO) + (size_t)l * D * 512, T, D, 512, E); }
        GSYNC();
        { PP p = get_pp(); unsigned char* ws = p->ws;
          pg8::EpiBf16<1> E{(bf16_t*)(ws + WS_ACT), DFF, 1.0f, nullptr};
          run_gemm(shm, (const bf16_t*)(ws + WS_XN), (const bf16_t*)(ws + WS_WUP) + (size_t)l * DFF * D, T, DFF, D, E); }
        GSYNC();
        { PP p = get_pp(); unsigned char* ws = p->ws;
          pg8::EpiRes2<2, false> E{nullptr, (bf16_t*)(ws + WS_XN), (unsigned char*)(ws + WS_H), (float*)(ws + WS_SS) + (size_t)(3 + 3 * l) * T * 32, (const float*)(ws + WS_SS) + (size_t)(2 + 3 * l) * T * 32};
          run_gemm(shm, (const bf16_t*)(ws + WS_ACT), (const bf16_t*)(ws + WS_WDN) + (size_t)l * D * DFF, T, D, DFF, E); }
        GSYNC();
    }
    {
        PP p = get_pp(); const bf16_t* hb = (const bf16_t*)(p->ws + WS_XN); const unsigned char* hl = (const unsigned char*)(p->ws + WS_H); const float* gf = p->in[32]; float* outp = p->out;
        const int lane = tid_fresh() & 63, gw = bid_fresh() * 8 + (tid_fresh() >> 6), NGW = gridDim.x * 8;
        for (int r = gw; r < T; r += NGW) {
            float v[4][8]; float sq = 0.f;
#pragma unroll
            for (int j = 0; j < 4; ++j) { float a[8]; unpack8(*(const u32x4*)(hb + (size_t)r * D + (lane + 64 * j) * 8), a);
                const u32x2 b = *(const u32x2*)(hl + (size_t)r * D + (lane + 64 * j) * 8);
                const hf32x2 l01 = __builtin_amdgcn_cvt_pk_f32_fp8((int)b.x, false), l23 = __builtin_amdgcn_cvt_pk_f32_fp8((int)b.x, true), l45 = __builtin_amdgcn_cvt_pk_f32_fp8((int)b.y, false), l67 = __builtin_amdgcn_cvt_pk_f32_fp8((int)b.y, true);
                const float lo[8] = {l01.x, l01.y, l23.x, l23.y, l45.x, l45.y, l67.x, l67.y};
#pragma unroll
                for (int e = 0; e < 8; ++e) { v[j][e] = a[e] + lo[e] * 0.00390625f; sq += v[j][e] * v[j][e]; } }
            sq = wave_sum(sq);
            const float rs = 1.0f / sqrtf(sq * (1.0f / D) + EPS);
#pragma unroll
            for (int j = 0; j < 4; ++j) { const f32x4 g0 = *(const f32x4*)(gf + (lane + 64 * j) * 8), g1 = *(const f32x4*)(gf + (lane + 64 * j) * 8 + 4);
                float* o = outp + (size_t)r * D + (lane + 64 * j) * 8;
                *(f32x4*)o = (f32x4){v[j][0] * rs * g0[0], v[j][1] * rs * g0[1], v[j][2] * rs * g0[2], v[j][3] * rs * g0[3]};
                *(f32x4*)(o + 4) = (f32x4){v[j][4] * rs * g1[0], v[j][5] * rs * g1[1], v[j][6] * rs * g1[2], v[j][7] * rs * g1[3]}; }
        }
    }
}

extern "C" void kernel_launch(void* const* d_in, const int* in_sizes, int n_in, void* d_out, int out_size, void* d_ws, size_t ws_size, hipStream_t stream) {
    static int grid_blocks = 0;
    if (grid_blocks == 0) {
        if (n_in != 33 || ws_size < WS_END) { fprintf(stderr, "kernel_launch: unexpected n_in %d or ws_size %zu (need %zu)\n", n_in, ws_size, (size_t)WS_END); grid_blocks = -1; return; }
        int dev = 0, cus = 0, per_cu = 0;
        (void)hipGetDevice(&dev);
        (void)hipDeviceGetAttribute(&cus, hipDeviceAttributeMultiprocessorCount, dev);
        if (hipFuncSetAttribute((const void*)hymba_fwd, hipFuncAttributeMaxDynamicSharedMemorySize, LDS_BYTES) != hipSuccess) { fprintf(stderr, "kernel_launch: hipFuncSetAttribute failed\n"); }
        if (hipOccupancyMaxActiveBlocksPerMultiprocessor(&per_cu, (const void*)hymba_fwd, 512, LDS_BYTES) != hipSuccess || per_cu < 1) { fprintf(stderr, "kernel_launch: occupancy query says %d\n", per_cu); per_cu = 1; }
        (void)hipGetLastError();
        grid_blocks = cus * 1;
    }
    if (grid_blocks < 0) return;
    (void)hipMemsetAsync((unsigned char*)d_ws + WS_BAR, 0, 16384, stream);
    Params p{};
    for (int i = 0; i < 33; ++i) p.in[i] = (const float*)d_in[i];
    p.out = (float*)d_out; p.ws = (unsigned char*)d_ws;
    void* args[] = {&p};
    hipError_t e = hipLaunchCooperativeKernel((const void*)hymba_fwd, dim3(grid_blocks), dim3(512), args, LDS_BYTES, stream);
    if (e != hipSuccess) fprintf(stderr, "cooperative launch failed: %s (grid %d)\n", hipGetErrorString(e), grid_blocks);
}
```
